# Optimizing an MI355X kernel written in HIP

```python
import math
import jax, jax.numpy as jnp
from jax import lax
import numpy as np

D_MODEL = 1024
BATCH = 4
SEQ = 8192
DEPTH = 1

CHUNK = 64
Q_BLOCK = 128
N_MEM = 256
ROPE_THETA = 10000.0
EPS = 1e-6

DA_HEADS = 6
DA_QK_DIM = 64
DA_V_DIM = 2 * DA_QK_DIM
GDN_HEADS = 6
GDN_K_DIM = 128
GDN_V_DIM = 128
CONV_K = 4
CA_HEADS = 4
CA_DIM = 128
D_FF = 4 * D_MODEL
N_BRANCH = 3

DA_Q = DA_HEADS * 2 * DA_QK_DIM
DA_V = DA_HEADS * DA_V_DIM
GDN_K = GDN_HEADS * GDN_K_DIM
GDN_V = GDN_HEADS * GDN_V_DIM
CA_Q = CA_HEADS * CA_DIM
IN_SPLITS = (DA_Q, DA_Q, DA_V, GDN_K, GDN_K, GDN_V, GDN_V, GDN_HEADS, GDN_HEADS, CA_Q)
D_IN = sum(IN_SPLITS)

kernel_name = 'hybrid_diffattn_gdn_memxattn_gated_block'


def rms_norm(x, g):
    xf = x.astype(jnp.float32)
    y = xf * lax.rsqrt(jnp.mean(xf * xf, axis=-1, keepdims=True) + EPS)
    return (y * g.astype(jnp.float32)).astype(x.dtype)


def l2_norm(x):
    xf = x.astype(jnp.float32)
    return xf * lax.rsqrt(jnp.sum(xf * xf, axis=-1, keepdims=True) + EPS)


def rope(x, positions):
    d = x.shape[-1]
    half = d // 2
    inv = jnp.exp(-math.log(ROPE_THETA) * jnp.arange(half, dtype=jnp.float32) / half)
    ang = positions.astype(jnp.float32)[..., None] * inv
    ang = ang.reshape(ang.shape[:2] + (1,) * (x.ndim - 3) + (half,))
    cos, sin = jnp.cos(ang), jnp.sin(ang)
    xf = x.astype(jnp.float32)
    x1, x2 = xf[..., :half], xf[..., half:]
    return jnp.concatenate([x1 * cos - x2 * sin, x2 * cos + x1 * sin], axis=-1).astype(x.dtype)


def diff_attention(q, k, v, lam):
    B, S = q.shape[:2]
    qh = q.transpose(0, 2, 3, 1, 4)
    kh = k.transpose(0, 2, 3, 1, 4)
    vh = v.transpose(0, 2, 1, 3)
    key_chunk = jnp.arange(S) // CHUNK
    scale = DA_QK_DIM ** -0.5

    def block(i):
        start = i * Q_BLOCK
        qb = lax.dynamic_slice_in_dim(qh, start, Q_BLOCK, axis=3)
        s = jnp.einsum('bhmqd,bhmkd->bhmqk', qb, kh).astype(jnp.float32) * scale
        q_chunk = (start + jnp.arange(Q_BLOCK)) // CHUNK
        mask = key_chunk[None, :] <= q_chunk[:, None]
        p = jax.nn.softmax(jnp.where(mask, s, -jnp.inf), axis=-1)
        a = p[:, :, 0] - lam * p[:, :, 1]
        return jnp.einsum('bhqk,bhkd->bhqd', a.astype(vh.dtype), vh)

    o = lax.map(block, jnp.arange(S // Q_BLOCK))
    return o.transpose(1, 0, 3, 2, 4).reshape(B, S, DA_HEADS, DA_V_DIM)


def causal_depthwise_conv(x, w):
    C = x.shape[-1]
    return lax.conv_general_dilated(
        x, w[:, None, :].astype(x.dtype), window_strides=(1,),
        padding=[(CONV_K - 1, 0)], dimension_numbers=('NWC', 'WIO', 'NWC'),
        feature_group_count=C)


def gated_delta_chunked(q, k, v, log_alpha, beta):
    B, S, H, Dk = q.shape
    Dv = v.shape[-1]
    N = S // CHUNK

    def to_chunks(t):
        return t.astype(jnp.float32).reshape(B, N, CHUNK, H, -1).transpose(0, 3, 1, 2, 4)

    qc = to_chunks(q) * (Dk ** -0.5)
    kc = to_chunks(k)
    vc = to_chunks(v)
    g = jnp.cumsum(log_alpha.astype(jnp.float32).reshape(B, N, CHUNK, H).transpose(0, 3, 1, 2), axis=-1)
    bt = beta.astype(jnp.float32).reshape(B, N, CHUNK, H).transpose(0, 3, 1, 2)

    incl = jnp.tril(jnp.ones((CHUNK, CHUNK), dtype=bool))
    strict = jnp.tril(jnp.ones((CHUNK, CHUNK), dtype=bool), -1)
    gdiff = g[..., :, None] - g[..., None, :]
    decay = jnp.where(incl, jnp.exp(jnp.where(incl, gdiff, 0.0)), 0.0)

    kk = jnp.einsum('bhncd,bhnjd->bhncj', kc, kc)
    A = jnp.where(strict, bt[..., None] * kk * decay, 0.0)
    eye = jnp.eye(CHUNK, dtype=jnp.float32)
    T = lax.linalg.triangular_solve(A + eye, jnp.broadcast_to(eye, A.shape),
                                    left_side=True, lower=True, unit_diagonal=True)
    u = jnp.einsum('bhncj,bhnjd->bhncd', T, vc * bt[..., None])
    w = jnp.einsum('bhncj,bhnjd->bhncd', T, kc * (bt * jnp.exp(g))[..., None])
    qk = jnp.einsum('bhncd,bhnjd->bhncj', qc, kc) * decay
    q_dec = qc * jnp.exp(g)[..., None]
    k_dec = kc * jnp.exp(g[..., -1:] - g)[..., None]
    chunk_decay = jnp.exp(g[..., -1])

    def step(state, inp):
        u_i, w_i, qk_i, qd_i, kd_i, cd_i = inp
        v_new = u_i - jnp.einsum('bhcd,bhde->bhce', w_i, state)
        o = jnp.einsum('bhcd,bhde->bhce', qd_i, state) + jnp.einsum('bhcj,bhje->bhce', qk_i, v_new)
        state = state * cd_i[..., None, None] + jnp.einsum('bhcd,bhce->bhde', kd_i, v_new)
        return state, o

    xs = tuple(jnp.moveaxis(t, 2, 0) for t in (u, w, qk, q_dec, k_dec, chunk_decay))
    state0 = jnp.zeros((B, H, Dk, Dv), jnp.float32)
    _, o = lax.scan(step, state0, xs)
    return o.transpose(1, 0, 3, 2, 4).reshape(B, S, H, Dv).astype(q.dtype)


def setup_inputs(seed: int = 0) -> dict:
    key = jax.random.key(seed)
    ks = jax.random.split(key, 32)
    L, D = DEPTH, D_MODEL

    def nrm(k, shape, scale):
        return jax.random.normal(k, shape, jnp.float32) * scale

    def gain(k, n):
        return 1.0 + nrm(k, (L, n), 0.02)

    x = nrm(ks[0], (BATCH, SEQ, D), 1.0)
    mem = nrm(ks[1], (BATCH, N_MEM, D), 1.0)
    offsets = jax.random.randint(ks[2], (BATCH, 1), 0, 256) * CHUNK
    positions = (offsets + jnp.arange(SEQ, dtype=jnp.int32)[None, :]).astype(jnp.int32)
    a_log = jnp.log(jax.random.uniform(ks[3], (L, GDN_HEADS), jnp.float32, 1.0, 16.0))
    dt = jnp.exp(jax.random.uniform(ks[4], (L, GDN_HEADS), jnp.float32, math.log(1e-3), math.log(1e-1)))
    dt_bias = dt + jnp.log(-jnp.expm1(-dt))
    return {
        'x': x,
        'mem': mem,
        'positions': positions,
        'ln1_g': gain(ks[5], D),
        'w_in': nrm(ks[6], (L, D, D_IN), D ** -0.5),
        'w_gate': nrm(ks[7], (L, D, N_BRANCH * D), D ** -0.5),
        'b_gate': nrm(ks[8], (L, N_BRANCH * D), 0.1),
        'da_qnorm_g': gain(ks[9], DA_QK_DIM),
        'da_knorm_g': gain(ks[10], DA_QK_DIM),
        'da_lambda_q1': nrm(ks[11], (L, DA_QK_DIM), 0.1),
        'da_lambda_k1': nrm(ks[12], (L, DA_QK_DIM), 0.1),
        'da_lambda_q2': nrm(ks[13], (L, DA_QK_DIM), 0.1),
        'da_lambda_k2': nrm(ks[14], (L, DA_QK_DIM), 0.1),
        'da_subln_g': gain(ks[15], DA_V_DIM),
        'w_o_diff': nrm(ks[16], (L, DA_V, D), DA_V ** -0.5),
        'w_conv': nrm(ks[17], (L, CONV_K, 2 * GDN_K + GDN_V), CONV_K ** -0.5),
        'gdn_a_log': a_log,
        'gdn_dt_bias': dt_bias,
        'gdn_norm_g': gain(ks[18], GDN_V_DIM),
        'w_o_delta': nrm(ks[19], (L, GDN_V, D), GDN_V ** -0.5),
        'mem_norm_g': gain(ks[20], D),
        'w_mem_kv': nrm(ks[21], (L, D, 2 * CA_Q), D ** -0.5),
        'ca_qnorm_g': gain(ks[22], CA_DIM),
        'ca_knorm_g': gain(ks[23], CA_DIM),
        'w_o_cross': nrm(ks[24], (L, CA_Q, D), CA_Q ** -0.5),
        'w_out': nrm(ks[25], (L, D, D), D ** -0.5),
        'ln2_g': gain(ks[26], D),
        'w_mlp1': nrm(ks[27], (L, D, D_FF), D ** -0.5),
        'w_mlp2': nrm(ks[28], (L, D_FF, D), D_FF ** -0.5),
    }


def reference(x, mem, positions, ln1_g, w_in, w_gate, b_gate, da_qnorm_g, da_knorm_g,
              da_lambda_q1, da_lambda_k1, da_lambda_q2, da_lambda_k2, da_subln_g, w_o_diff,
              w_conv, gdn_a_log, gdn_dt_bias, gdn_norm_g, w_o_delta, mem_norm_g, w_mem_kv,
              ca_qnorm_g, ca_knorm_g, w_o_cross, w_out, ln2_g, w_mlp1, w_mlp2):
    B, S, _ = x.shape
    split_points = [int(p) for p in np.cumsum(IN_SPLITS)[:-1]]
    for l in range(DEPTH):
        h = rms_norm(x, ln1_g[l])
        proj = h @ w_in[l]
        (da_q, da_k, da_v, gd_q, gd_k, gd_v, gd_z, gd_b, gd_a, ca_q) = jnp.split(proj, split_points, axis=-1)
        gates = jax.nn.sigmoid((h @ w_gate[l] + b_gate[l]).astype(jnp.float32))
        gates = gates.astype(x.dtype).reshape(B, S, N_BRANCH, D_MODEL)

        qa = rope(rms_norm(da_q.reshape(B, S, DA_HEADS, 2, DA_QK_DIM), da_qnorm_g[l]), positions)
        ka = rope(rms_norm(da_k.reshape(B, S, DA_HEADS, 2, DA_QK_DIM), da_knorm_g[l]), positions)
        va = da_v.reshape(B, S, DA_HEADS, DA_V_DIM)
        lam_init = 0.8 - 0.6 * math.exp(-0.3 * l)
        lam = (jnp.exp(jnp.sum(da_lambda_q1[l].astype(jnp.float32) * da_lambda_k1[l].astype(jnp.float32)))
               - jnp.exp(jnp.sum(da_lambda_q2[l].astype(jnp.float32) * da_lambda_k2[l].astype(jnp.float32)))
               + lam_init)
        oa = diff_attention(qa, ka, va, lam)
        oa = rms_norm(oa, da_subln_g[l]) * (1.0 - lam_init)
        ya = oa.reshape(B, S, DA_V) @ w_o_diff[l]

        qkv = jax.nn.silu(causal_depthwise_conv(jnp.concatenate([gd_q, gd_k, gd_v], axis=-1), w_conv[l]))
        cq, ck, cv = jnp.split(qkv, [GDN_K, 2 * GDN_K], axis=-1)
        cq = l2_norm(cq.reshape(B, S, GDN_HEADS, GDN_K_DIM))
        ck = l2_norm(ck.reshape(B, S, GDN_HEADS, GDN_K_DIM))
        cv = cv.reshape(B, S, GDN_HEADS, GDN_V_DIM)
        beta = jax.nn.sigmoid(gd_b.astype(jnp.float32))
        log_alpha = -jnp.exp(gdn_a_log[l].astype(jnp.float32)) * jax.nn.softplus(
            gd_a.astype(jnp.float32) + gdn_dt_bias[l].astype(jnp.float32))
        ob = gated_delta_chunked(cq, ck, cv, log_alpha, beta).astype(x.dtype)
        ob = rms_norm(ob, gdn_norm_g[l]) * jax.nn.silu(gd_z.reshape(B, S, GDN_HEADS, GDN_V_DIM))
        yb = ob.reshape(B, S, GDN_V) @ w_o_delta[l]

        m = rms_norm(mem, mem_norm_g[l])
        mk, mv = jnp.split(m @ w_mem_kv[l], 2, axis=-1)
        kc = rms_norm(mk.reshape(B, N_MEM, CA_HEADS, CA_DIM), ca_knorm_g[l])
        vc = mv.reshape(B, N_MEM, CA_HEADS, CA_DIM)
        qc = rms_norm(ca_q.reshape(B, S, CA_HEADS, CA_DIM), ca_qnorm_g[l])
        sc = jnp.einsum('bshd,bmhd->bhsm', qc, kc).astype(jnp.float32) * (CA_DIM ** -0.5)
        pc = jax.nn.softmax(sc, axis=-1)
        oc = jnp.einsum('bhsm,bmhd->bshd', pc.astype(vc.dtype), vc)
        yc = oc.reshape(B, S, CA_Q) @ w_o_cross[l]

        mixed = gates[:, :, 0] * ya + gates[:, :, 1] * yb + gates[:, :, 2] * yc
        x = x + mixed @ w_out[l]

        h2 = rms_norm(x, ln2_g[l])
        x = x + jnp.square(jax.nn.relu(h2 @ w_mlp1[l])) @ w_mlp2[l]
    return x
```

```cpp
#include <hip/hip_runtime.h>
#include <hip/hip_cooperative_groups.h>
#include <cstdio>
#include <cstdint>
namespace cg = cooperative_groups;

constexpr int NB = 4, SEQ = 8192, DM = 1024, MTOK = NB * SEQ;
constexpr int NMEM = 256, MEMROWS = NB * NMEM;
constexpr int DIN = 5900, NGATE = 3072, DFF = 4096;
constexpr int NCOMB = 8960;
constexpr float EPS = 1e-6f;
constexpr float C2_DA = 0.125f * 1.4426950408889634f;
constexpr float C2_CA = 0.08838834764831845f * 1.4426950408889634f;
constexpr float LAM_INIT = 0.2f;

constexpr size_t MiB = (size_t)1 << 20;
constexpr size_t WS_W1T = 0, WS_WOD = 18 * MiB, WS_WODL = 20 * MiB, WS_WOC = 22 * MiB, WS_WOUT = 23 * MiB, WS_WM1 = 25 * MiB, WS_WM2 = 33 * MiB, WS_WMEM = 41 * MiB;
constexpr size_t WS_ROPEC = 43 * MiB, WS_ROPES = 47 * MiB, WS_BT = 51 * MiB, WS_LA = 52 * MiB, WS_MN = 53 * MiB, WS_MKV = 55 * MiB, WS_HALO = 57 * MiB;
constexpr size_t WS_ROWSS = 63 * MiB + 768 * 1024, WS_MISC = 63 * MiB + 960 * 1024;
constexpr size_t WS_GATES = 64 * MiB;
constexpr size_t WS_DAQ = 160 * MiB, WS_SEC = 48 * MiB;
constexpr size_t WS_DAK = WS_DAQ + WS_SEC, WS_DAV = WS_DAQ + 2 * WS_SEC, WS_GQ = WS_DAQ + 3 * WS_SEC, WS_GK = WS_DAQ + 4 * WS_SEC, WS_GV = WS_DAQ + 5 * WS_SEC, WS_GZ = WS_DAQ + 6 * WS_SEC;
constexpr size_t WS_MIXF = 208 * MiB, WS_MIXED = 336 * MiB, WS_X1B = 416 * MiB, WS_HMID = 160 * MiB;
constexpr size_t WS_NEED = 496 * MiB;
constexpr size_t OUT_HB = 0, OUT_CAQ = 72 * MiB;
namespace pg8 {
#define PG8_LAS __attribute__((address_space(3)))
typedef unsigned short bf16_t;
typedef short bf16x8 __attribute__((ext_vector_type(8)));
typedef float f32x4 __attribute__((ext_vector_type(4)));
typedef unsigned u32x4 __attribute__((ext_vector_type(4)));
constexpr int BM = 256, BK = 64, HALF = 128, HTB = HALF * BK * 2  , STAGE_BYTES = 8 * HTB, NXCD = 8, WGM = 8;

__host__ __device__ __forceinline__ int lds_byte(int r, int c) { const int st = (r >> 4) * 2 + (c >> 5), rr = r & 15, cc = c & 31, ob = rr * 64 + cc * 2; return st * 1024 + (ob ^ (((ob >> 9) & 1) << 5)); }
__host__ __device__ __forceinline__ void stage_rc(int b, int& R, int& C) { const int st = b / 1024, sb = b % 1024, swz = sb ^ (((sb >> 9) & 1) << 5); R = (st >> 1) * 16 + swz / 64; C = (st & 1) * 32 + (swz % 64) / 2; }
__host__ __device__ __forceinline__ int perm32(int rho) { const int n = rho >> 4, i = rho & 15; return 8 * (i >> 2) + 4 * n + (i & 3); }

struct Unit { int pm, pn; };
struct Gemm { const bf16_t* A; const bf16_t* Bt; int M, N, K; };

struct StaticOrder {
    int nM, nN, nwg, G, c;
    __host__ __device__ void init(int M, int N, int G_, int c_) { nM = M / BM; nN = N / BM; nwg = nM * nN; G = G_; c = c_; }
    __host__ __device__ bool next(int i, Unit& u) const {
        const long L = (long)i * G + c; if (L >= nwg) return false;
        int wgid = (int)L; { const int q = nwg / NXCD, r = nwg % NXCD, xcd = wgid % NXCD, off = wgid / NXCD; wgid = (xcd < r ? xcd * (q + 1) : r * (q + 1) + (xcd - r) * q) + off; }
        const int nig = WGM * nN, gid = wgid / nig, fm = gid * WGM, gsz = (nM - fm) < WGM ? (nM - fm) : WGM;
        u.pm = fm + ((wgid % nig) % gsz); u.pn = (wgid % nig) / gsz; return true;
    }
    __device__ __forceinline__ void a_ready(const Unit&) const {}
    __device__ __forceinline__ void done(const Unit&) const {}
};

__device__ __forceinline__ unsigned cvt_pk_bf16(float lo, float hi) { unsigned r; asm volatile("v_cvt_pk_bf16_f32 %0, %1, %2" : "=v"(r) : "v"(lo), "v"(hi)); return r; }
typedef unsigned u32x2 __attribute__((ext_vector_type(2)));
__device__ __forceinline__ u32x4 pack8(const f32x4 a, const f32x4 b) { u32x4 w; w.x = cvt_pk_bf16(a[0], a[1]); w.y = cvt_pk_bf16(a[2], a[3]); w.z = cvt_pk_bf16(b[0], b[1]); w.w = cvt_pk_bf16(b[2], b[3]); return w; }
__device__ __forceinline__ float sigm(float x) { return 1.0f / (1.0f + __expf(-x)); }

struct EpiPlain {
    static constexpr bool PERM = true, AFTER_DRAIN = false;
    bf16_t* O; int ldc;
    __device__ __forceinline__ void operator()(const f32x4 (&acc)[2][2][4][2], const Unit& u, int wr, int wc, int fr, int fq) const {
        const int row0 = u.pm * BM + wr * 64 + fr, col0 = u.pn * BM + wc * 32 + 8 * fq;
#pragma unroll
        for (int ai = 0; ai < 2; ++ai)
#pragma unroll
            for (int m = 0; m < 4; ++m) { bf16_t* rowp = O + (size_t)(row0 + ai * HALF + m * 16) * ldc + col0;
#pragma unroll
                for (int bj = 0; bj < 2; ++bj) *(u32x4*)(rowp + bj * HALF) = pack8(acc[ai][bj][m][0], acc[ai][bj][m][1]); }
    }
};

struct EpiP1 {
    static constexpr bool PERM = true, AFTER_DRAIN = false;
    unsigned char* ws; unsigned char* outb; const float* bgate;
    __device__ __forceinline__ void operator()(const f32x4 (&acc)[2][2][4][2], const Unit& u, int wr, int wc, int fr, int fq) const {
        const int pn = u.pn, row0 = u.pm * BM + wr * 64 + fr, cl0 = wc * 32 + 8 * fq;
        if (pn < 23) {
            bf16_t* base; int ldc, colt;
            if (pn < 21) { const int bi = pn / 3; base = (bf16_t*)(ws + WS_DAQ + (size_t)bi * WS_SEC); ldc = 768; colt = (pn - 3 * bi) * 256; }
            else { base = (bf16_t*)(outb + OUT_CAQ); ldc = 512; colt = (pn - 21) * 256; }
            const bool halo = (pn >= 9 && pn < 18);
            bf16_t* hb = (bf16_t*)(ws + WS_HALO);
#pragma unroll
            for (int ai = 0; ai < 2; ++ai)
#pragma unroll
                for (int m = 0; m < 4; ++m) { const int row = row0 + ai * HALF + m * 16; bf16_t* rowp = base + (size_t)row * ldc + colt + cl0;
#pragma unroll
                    for (int bj = 0; bj < 2; ++bj) { const u32x4 w = pack8(acc[ai][bj][m][0], acc[ai][bj][m][1]); *(u32x4*)(rowp + bj * HALF) = w;
                        if (halo && (row & 63) >= 61) *(u32x4*)(hb + ((size_t)(row >> 6) * 3 + ((row & 63) - 61)) * 2304 + (pn - 9) * 256 + bj * HALF + cl0) = w; } }
        } else {
            unsigned char* gb = ws + WS_GATES; const int colt = (pn - 23) * 256 + cl0;
            f32x4 bv[2][2];
#pragma unroll
            for (int bj = 0; bj < 2; ++bj)
#pragma unroll
                for (int n = 0; n < 2; ++n) bv[bj][n] = *(const f32x4*)(bgate + colt + bj * HALF + 4 * n);
#pragma unroll
            for (int ai = 0; ai < 2; ++ai)
#pragma unroll
                for (int m = 0; m < 4; ++m) { const int row = row0 + ai * HALF + m * 16; unsigned char* rowp = gb + (size_t)row * NGATE + colt;
#pragma unroll
                    for (int bj = 0; bj < 2; ++bj) { const f32x4 v0 = acc[ai][bj][m][0] + bv[bj][0], v1 = acc[ai][bj][m][1] + bv[bj][1];
                        unsigned q[8];
#pragma unroll
                        for (int i = 0; i < 4; ++i) { q[i] = (unsigned)__builtin_rintf(255.0f * sigm(v0[i])); q[4 + i] = (unsigned)__builtin_rintf(255.0f * sigm(v1[i])); }
                        u32x2 w; w.x = q[0] | (q[1] << 8) | (q[2] << 16) | (q[3] << 24); w.y = q[4] | (q[5] << 8) | (q[6] << 16) | (q[7] << 24);
                        *(u32x2*)(rowp + bj * HALF) = w; } }
        }
    }
};

template <int MODE> struct EpiGate {
    static constexpr bool PERM = true, AFTER_DRAIN = false;
    const unsigned char* gates; float* mixf; bf16_t* mixed; int br;
    __device__ __forceinline__ void operator()(const f32x4 (&acc)[2][2][4][2], const Unit& u, int wr, int wc, int fr, int fq) const {
        const int row0 = u.pm * BM + wr * 64 + fr, col0 = u.pn * BM + wc * 32 + 8 * fq;
#pragma unroll
        for (int ai = 0; ai < 2; ++ai)
#pragma unroll
            for (int m = 0; m < 4; ++m) { const int row = row0 + ai * HALF + m * 16;
#pragma unroll
                for (int bj = 0; bj < 2; ++bj) { const int col = col0 + bj * HALF;
                    const u32x2 gw = *(const u32x2*)(gates + (size_t)row * NGATE + br * 1024 + col);
                    f32x4 g0, g1;
#pragma unroll
                    for (int i = 0; i < 4; ++i) { g0[i] = (float)((gw.x >> (8 * i)) & 255u) * (1.0f / 255.0f); g1[i] = (float)((gw.y >> (8 * i)) & 255u) * (1.0f / 255.0f); }
                    f32x4 v0 = acc[ai][bj][m][0] * g0, v1 = acc[ai][bj][m][1] * g1;
                    float* mp = mixf + (size_t)row * DM + col;
                    if (MODE >= 1) { v0 = v0 + *(const f32x4*)mp; v1 = v1 + *(const f32x4*)(mp + 4); }
                    if (MODE <= 1) { *(f32x4*)mp = v0; *(f32x4*)(mp + 4) = v1; }
                    else *(u32x4*)(mixed + (size_t)row * DM + col) = pack8(v0, v1); } }
    }
};

struct EpiRes1 {
    static constexpr bool PERM = true, AFTER_DRAIN = false;
    const float* x; float* out; bf16_t* x1b; float* rowss;
    __device__ __forceinline__ void operator()(const f32x4 (&acc)[2][2][4][2], const Unit& u, int wr, int wc, int fr, int fq) const {
        const int row0 = u.pm * BM + wr * 64 + fr, col0 = u.pn * BM + wc * 32 + 8 * fq;
#pragma unroll
        for (int ai = 0; ai < 2; ++ai)
#pragma unroll
            for (int m = 0; m < 4; ++m) { const int row = row0 + ai * HALF + m * 16; float ss = 0.f;
#pragma unroll
                for (int bj = 0; bj < 2; ++bj) { const size_t off = (size_t)row * DM + col0 + bj * HALF;
                    const f32x4 v0 = acc[ai][bj][m][0] + *(const f32x4*)(x + off), v1 = acc[ai][bj][m][1] + *(const f32x4*)(x + off + 4);
                    *(f32x4*)(out + off) = v0; *(f32x4*)(out + off + 4) = v1; *(u32x4*)(x1b + off) = pack8(v0, v1);
                    ss += (v0[0] * v0[0] + v0[1] * v0[1]) + (v0[2] * v0[2] + v0[3] * v0[3]) + (v1[0] * v1[0] + v1[1] * v1[1]) + (v1[2] * v1[2] + v1[3] * v1[3]); }
                ss += __shfl_xor(ss, 16); ss += __shfl_xor(ss, 32);
                if (fq == 0) atomicAdd(rowss + row, ss); }
    }
};

struct EpiMlp1 {
    static constexpr bool PERM = true, AFTER_DRAIN = false;
    const float* rowss; bf16_t* O;
    __device__ __forceinline__ void operator()(const f32x4 (&acc)[2][2][4][2], const Unit& u, int wr, int wc, int fr, int fq) const {
        const int row0 = u.pm * BM + wr * 64 + fr, col0 = u.pn * BM + wc * 32 + 8 * fq;
#pragma unroll
        for (int ai = 0; ai < 2; ++ai)
#pragma unroll
            for (int m = 0; m < 4; ++m) { const int row = row0 + ai * HALF + m * 16; const float r = __builtin_amdgcn_rsqf(rowss[row] * (1.0f / 1024.0f) + EPS);
                bf16_t* rowp = O + (size_t)row * DFF + col0;
#pragma unroll
                for (int bj = 0; bj < 2; ++bj) { f32x4 v0 = acc[ai][bj][m][0] * r, v1 = acc[ai][bj][m][1] * r;
#pragma unroll
                    for (int i = 0; i < 4; ++i) { const float a = __builtin_fmaxf(v0[i], 0.f), b = __builtin_fmaxf(v1[i], 0.f); v0[i] = a * a; v1[i] = b * b; }
                    *(u32x4*)(rowp + bj * HALF) = pack8(v0, v1); } }
    }
};

struct EpiRes2 {
    static constexpr bool PERM = true, AFTER_DRAIN = false;
    float* out;
    __device__ __forceinline__ void operator()(const f32x4 (&acc)[2][2][4][2], const Unit& u, int wr, int wc, int fr, int fq) const {
        const int row0 = u.pm * BM + wr * 64 + fr, col0 = u.pn * BM + wc * 32 + 8 * fq;
#pragma unroll
        for (int ai = 0; ai < 2; ++ai)
#pragma unroll
            for (int m = 0; m < 4; ++m) { const int row = row0 + ai * HALF + m * 16;
#pragma unroll
                for (int bj = 0; bj < 2; ++bj) { const size_t off = (size_t)row * DM + col0 + bj * HALF;
                    *(f32x4*)(out + off) = acc[ai][bj][m][0] + *(const f32x4*)(out + off); *(f32x4*)(out + off + 4) = acc[ai][bj][m][1] + *(const f32x4*)(out + off + 4); } }
    }
};

template <class Epi, class Sched, bool ALIGN_EPI = false, bool SP2 = false>
__device__ __forceinline__ void gemm_phase(PG8_LAS unsigned char* lds, const Gemm g, const Sched& S, const Epi& E) {
    int tid_ = threadIdx.x; asm volatile("" : "+v"(tid_));
    const int tid = tid_, wid = __builtin_amdgcn_readfirstlane(tid >> 6), lane = tid & 63, wr = wid >> 2, wc = wid & 3, fr = lane & 15, fq = lane >> 4;
    const int K = g.K, nt = K / BK;
    unsigned voffA[2], voffB[2];
#pragma unroll
    for (int i = 0; i < 2; ++i) { int R, C; stage_rc(tid * 16 + i * 8192, R, C); const int Rb = Epi::PERM ? ((R & ~31) + perm32(R & 31)) : R;
        voffA[i] = (unsigned)(R * K + C) * 2u; voffB[i] = (unsigned)(Rb * K + C) * 2u; }
    const size_t kstep = (size_t)(BK * 2);
    const size_t hstep = (size_t)HALF * K * 2;
    const size_t tstep = 2 * hstep;
    const unsigned ldsw = (unsigned)wid * 1024u;
    const int aoff = lds_byte(wr * 64 + fr, fq * 8), boff = lds_byte(wc * 32 + fr, fq * 8);
#define PG8_SA(b, h) (((b) * 2 + (h)) * HTB)
#define PG8_SB(b, h) ((4 + (b) * 2 + (h)) * HTB)
#define PG8_STAGE(bufoff, gbase, voff) do { _Pragma("unroll") for (int _i = 0; _i < 2; ++_i) \
        __builtin_amdgcn_global_load_lds((const unsigned*)((const char*)(gbase) + (voff)[_i]), (PG8_LAS unsigned*)(lds + (bufoff) + ldsw + _i * 8192), 16, 0, 0); } while (0)
#define PG8_LDA(dst, b, h) do { _Pragma("unroll") for (int m = 0; m < 4; ++m) _Pragma("unroll") for (int k = 0; k < 2; ++k) dst[m][k] = *(const PG8_LAS bf16x8*)(lds + PG8_SA(b, h) + aoff + m * 2048 + k * 1024); } while (0)
#define PG8_LDB(dst, b, h) do { _Pragma("unroll") for (int n = 0; n < 2; ++n) _Pragma("unroll") for (int k = 0; k < 2; ++k) dst[n][k] = *(const PG8_LAS bf16x8*)(lds + PG8_SB(b, h) + boff + n * 2048 + k * 1024); } while (0)
#define PG8_MMA(ai, bj, At, Bt) do { __builtin_amdgcn_s_setprio(1); _Pragma("unroll") for (int m = 0; m < 4; ++m) _Pragma("unroll") for (int n = 0; n < 2; ++n) _Pragma("unroll") for (int k = 0; k < 2; ++k) \
        acc[ai][bj][m][n] = __builtin_amdgcn_mfma_f32_16x16x32_bf16(Bt[n][k], At[m][k], acc[ai][bj][m][n], 0, 0, 0); __builtin_amdgcn_s_setprio(0); } while (0)
#define PG8_WAIT_V(n) asm volatile("s_waitcnt vmcnt(" #n ")" ::: "memory")
#define PG8_WAIT_L(n) asm volatile("s_waitcnt lgkmcnt(" #n ")" ::: "memory")
#define PG8_BAR __builtin_amdgcn_s_barrier()
#define PG8_SCHED __builtin_amdgcn_sched_barrier(0)
    Unit cur, nxt; int ui = 0;
    if (!S.next(0, cur)) return;
    f32x4 acc[2][2][4][2];
#pragma unroll
    for (int a = 0; a < 2; ++a)
#pragma unroll
        for (int b = 0; b < 2; ++b)
#pragma unroll
            for (int m = 0; m < 4; ++m)
#pragma unroll
                for (int n = 0; n < 2; ++n) acc[a][b][m][n] = (f32x4){0.f, 0.f, 0.f, 0.f};
    bf16x8 At[4][2], B0[2][2], B1[2][2];
    const char* cA = (const char*)g.A + (size_t)cur.pm * tstep; const char* cB = (const char*)g.Bt + (size_t)cur.pn * tstep;
    S.a_ready(cur);
    if constexpr (SP2) {
        PG8_STAGE(PG8_SB(0, 0), cB, voffB); PG8_STAGE(PG8_SB(0, 1), cB + hstep, voffB); PG8_STAGE(PG8_SA(0, 0), cA, voffA); PG8_STAGE(PG8_SA(0, 1), cA + hstep, voffA);
        if (wr == 1) PG8_BAR;
        PG8_WAIT_V(2); PG8_BAR;
        PG8_STAGE(PG8_SB(1, 0), cB + kstep, voffB); PG8_STAGE(PG8_SA(1, 0), cA + kstep, voffA); PG8_STAGE(PG8_SB(1, 1), cB + hstep + kstep, voffB);
        PG8_WAIT_V(6); PG8_BAR;
    } else {
        PG8_STAGE(PG8_SB(0, 0), cB, voffB); PG8_STAGE(PG8_SA(0, 0), cA, voffA); PG8_STAGE(PG8_SB(0, 1), cB + hstep, voffB); PG8_STAGE(PG8_SA(0, 1), cA + hstep, voffA);
        if (wr == 1) PG8_BAR;
        PG8_WAIT_V(4); PG8_BAR;
        PG8_STAGE(PG8_SB(1, 0), cB + kstep, voffB); PG8_STAGE(PG8_SA(1, 0), cA + kstep, voffA); PG8_STAGE(PG8_SB(1, 1), cB + hstep + kstep, voffB);
        PG8_WAIT_V(6); PG8_BAR;
    }
    for (;;) {
        const bool has_next = S.next(ui + 1, nxt);
        const char* nA = has_next ? (const char*)g.A + (size_t)nxt.pm * tstep : cA; const char* nB = has_next ? (const char*)g.Bt + (size_t)nxt.pn * tstep : cB;
        for (int t = 0; t < nt; t += 2) {
            const bool last = (t == nt - 2);
            const char* a1 = cA + (size_t)(t + 1) * kstep;
            const char* a2 = last ? nA : cA + (size_t)(t + 2) * kstep; const char* b2 = last ? nB : cB + (size_t)(t + 2) * kstep;
            const char* a3 = a2 + kstep; const char* b3 = b2 + kstep;
            if (last && has_next) S.a_ready(nxt);
            if constexpr (SP2) {
            PG8_LDB(B0, 0, 0); PG8_LDB(B1, 0, 1); PG8_SCHED; PG8_LDA(At, 0, 0); PG8_STAGE(PG8_SA(1, 1), a1 + hstep, voffA);
            PG8_WAIT_V(8); PG8_WAIT_L(0); PG8_BAR; PG8_MMA(0, 0, At, B0); PG8_MMA(0, 1, At, B1); PG8_BAR; PG8_SCHED;
            PG8_LDA(At, 0, 1); PG8_STAGE(PG8_SB(0, 0), b2, voffB); PG8_STAGE(PG8_SB(0, 1), b2 + hstep, voffB); PG8_STAGE(PG8_SA(0, 0), a2, voffA);
            PG8_WAIT_V(8); PG8_WAIT_L(0); PG8_BAR; PG8_MMA(1, 0, At, B0); PG8_MMA(1, 1, At, B1); PG8_BAR; PG8_SCHED;
            PG8_LDB(B0, 1, 0); PG8_LDB(B1, 1, 1); PG8_SCHED; PG8_LDA(At, 1, 0); PG8_STAGE(PG8_SA(0, 1), a2 + hstep, voffA);
            PG8_WAIT_V(8); PG8_WAIT_L(0); PG8_BAR; PG8_MMA(0, 0, At, B0); PG8_MMA(0, 1, At, B1); PG8_BAR; PG8_SCHED;
            PG8_LDA(At, 1, 1); PG8_STAGE(PG8_SB(1, 0), b3, voffB); PG8_STAGE(PG8_SB(1, 1), b3 + hstep, voffB); PG8_STAGE(PG8_SA(1, 0), a3, voffA);
            PG8_WAIT_V(8); PG8_WAIT_L(0); PG8_BAR; PG8_MMA(1, 0, At, B0); PG8_MMA(1, 1, At, B1); PG8_BAR; PG8_SCHED;
            } else {
            PG8_LDB(B0, 0, 0); PG8_SCHED; PG8_LDA(At, 0, 0); PG8_STAGE(PG8_SA(1, 1), a1 + hstep, voffA);
            PG8_WAIT_L(8); PG8_BAR; PG8_WAIT_L(0); PG8_MMA(0, 0, At, B0); PG8_BAR; PG8_SCHED;
            PG8_LDB(B1, 0, 1); PG8_STAGE(PG8_SB(0, 0), b2, voffB);
            PG8_BAR; PG8_WAIT_L(0); PG8_MMA(0, 1, At, B1); PG8_BAR;
            PG8_LDA(At, 0, 1); PG8_STAGE(PG8_SA(0, 0), a2, voffA);
            PG8_BAR; PG8_WAIT_L(0); PG8_MMA(1, 0, At, B0); PG8_BAR; PG8_SCHED;
            PG8_STAGE(PG8_SB(0, 1), b2 + hstep, voffB);
            PG8_WAIT_V(6); PG8_BAR; PG8_MMA(1, 1, At, B1); PG8_BAR;
            PG8_LDB(B0, 1, 0); PG8_SCHED; PG8_LDA(At, 1, 0); PG8_STAGE(PG8_SA(0, 1), a2 + hstep, voffA);
            PG8_WAIT_L(8); PG8_BAR; PG8_WAIT_L(0); PG8_MMA(0, 0, At, B0); PG8_BAR; PG8_SCHED;
            PG8_LDB(B1, 1, 1); PG8_STAGE(PG8_SB(1, 0), b3, voffB);
            PG8_BAR; PG8_WAIT_L(0); PG8_MMA(0, 1, At, B1); PG8_BAR;
            PG8_LDA(At, 1, 1); PG8_STAGE(PG8_SA(1, 0), a3, voffA);
            PG8_BAR; PG8_WAIT_L(0); PG8_MMA(1, 0, At, B0); PG8_BAR; PG8_SCHED;
            PG8_STAGE(PG8_SB(1, 1), b3 + hstep, voffB);
            PG8_WAIT_V(6); PG8_BAR; PG8_MMA(1, 1, At, B1); PG8_BAR;
            }
        }
        if constexpr (ALIGN_EPI) { if (wr == 0) PG8_BAR; }
        if constexpr (!Epi::AFTER_DRAIN) { E(acc, cur, wr, wc, fr, fq); S.done(cur); }
        if (!has_next) break;
#pragma unroll
        for (int a = 0; a < 2; ++a)
#pragma unroll
            for (int b = 0; b < 2; ++b)
#pragma unroll
                for (int m = 0; m < 4; ++m)
#pragma unroll
                    for (int n = 0; n < 2; ++n) acc[a][b][m][n] = (f32x4){0.f, 0.f, 0.f, 0.f};
        cur = nxt; cA = nA; cB = nB; ++ui;
        if constexpr (ALIGN_EPI) { if (wr == 1) PG8_BAR; }
    }
    PG8_WAIT_V(0);
    if constexpr (!ALIGN_EPI) { if (wr == 0) PG8_BAR; }
    PG8_BAR;
    if constexpr (Epi::AFTER_DRAIN) { E.fused(acc, cur, wr, wc, fr, fq, lds, wid, lane); S.done(cur); }
#undef PG8_SA
#undef PG8_SB
#undef PG8_STAGE
#undef PG8_LDA
#undef PG8_LDB
#undef PG8_MMA
#undef PG8_WAIT_V
#undef PG8_WAIT_L
#undef PG8_BAR
#undef PG8_SCHED
}
}

#define LAS __attribute__((address_space(3)))
typedef unsigned short bf16;
typedef unsigned v4u __attribute__((ext_vector_type(4)));
typedef unsigned v2u __attribute__((ext_vector_type(2)));
typedef float f32x4 __attribute__((ext_vector_type(4)));
constexpr int NWAVES = 8, NTHR = 512;
constexpr int LDS_BYTES = 147456;

__device__ __forceinline__ unsigned f2bf(float f) { unsigned u = __builtin_bit_cast(unsigned, f); return (u + 0x7fffu + ((u >> 16) & 1u)) >> 16; }
__device__ __forceinline__ unsigned pk2(float lo, float hi) { return f2bf(lo) | (f2bf(hi) << 16); }
__device__ __forceinline__ float bflo(unsigned w) { return __builtin_bit_cast(float, w << 16); }
__device__ __forceinline__ float bfhi(unsigned w) { return __builtin_bit_cast(float, w & 0xffff0000u); }
__device__ __forceinline__ float bf2f(bf16 h) { return __builtin_bit_cast(float, (unsigned)h << 16); }
__device__ __forceinline__ float wave_sum(float v) {
#pragma unroll
    for (int o = 1; o < 64; o <<= 1) v += __shfl_xor(v, o);
    return v;
}
__device__ __forceinline__ float siluf(float x) { return x / (1.0f + __expf(-x)); }

struct Params { const void* in[29]; float* out; unsigned char* ws; int lo, hi; };
enum { I_X = 0, I_MEM, I_POS, I_LN1G, I_WIN, I_WGATE, I_BGATE, I_DAQN, I_DAKN, I_LQ1, I_LK1, I_LQ2, I_LK2, I_SUBLN, I_WODIFF, I_WCONV, I_ALOG, I_DTB, I_GDNN, I_WODELTA,
       I_MEMN, I_WMEMKV, I_CAQN, I_CAKN, I_WOCROSS, I_WOUT, I_LN2G, I_WMLP1, I_WMLP2 };

__device__ __forceinline__ void p0_transpose_item(const float* W, int ldw, int K, int src_col0, const float* kscale, bf16* WT, int dst_row0, int k0, float* scr, int lane) {
#pragma unroll 8
    for (int i = 0; i < 32; ++i) { const int kk = 2 * i + (lane >> 5); float v = W[(size_t)(k0 + kk) * ldw + src_col0 + (lane & 31)]; if (kscale) v *= kscale[k0 + kk]; scr[kk * 33 + (lane & 31)] = v; }
    __builtin_amdgcn_wave_barrier(); asm volatile("s_waitcnt lgkmcnt(0)" ::: "memory");
    const int c = lane & 7;
#pragma unroll
    for (int j = 0; j < 4; ++j) { const int n = (lane >> 3) + 8 * j; const float* s = scr + (8 * c) * 33 + n;
        v4u o; o.x = pk2(s[0 * 33], s[1 * 33]); o.y = pk2(s[2 * 33], s[3 * 33]); o.z = pk2(s[4 * 33], s[5 * 33]); o.w = pk2(s[6 * 33], s[7 * 33]);
        *(v4u*)(WT + (size_t)(dst_row0 + n) * K + k0 + 8 * c) = o; }
    asm volatile("s_waitcnt lgkmcnt(0)" ::: "memory"); __builtin_amdgcn_wave_barrier();
}

__device__ __forceinline__ void p0_prologue(const Params& P, unsigned char* lds, int tid, int lane, int wave) {
    const int G = gridDim.x, gw = blockIdx.x * NWAVES + wave, NGW = G * NWAVES;
    unsigned char* ws = P.ws;
    float* scr = (float*)(lds + wave * 8448);
    float* w12t = (float*)(lds + 73728);
    const float* w_in = (const float*)P.in[I_WIN];
    for (int i = tid; i < 12 * 1024; i += NTHR) { const int c = i >> 10, k = i & 1023; w12t[i] = w_in[(size_t)k * DIN + 5376 + c]; }
    {
        constexpr int I1 = 16 * 280, I2 = 12 * 32, I3 = 12 * 32, I4 = 8 * 32, I5 = 16 * 32, I6 = 16 * 128, I7 = 64 * 32, I8 = 16 * 32;
        constexpr int NITEMS = I1 + I2 + I3 + I4 + I5 + I6 + I7 + I8;
        for (int it = gw; it < NITEMS; it += NGW) {
            int r = it;
            if (r < I1) { const int kb = r / 280, g = r % 280, p0 = 32 * g;
                if (p0 < 5376) p0_transpose_item(w_in, DIN, 1024, p0, nullptr, (bf16*)(ws + WS_W1T), p0, 64 * kb, scr, lane);
                else if (p0 < 5888) p0_transpose_item(w_in, DIN, 1024, 5388 + (p0 - 5376), nullptr, (bf16*)(ws + WS_W1T), p0, 64 * kb, scr, lane);
                else p0_transpose_item((const float*)P.in[I_WGATE], NGATE, 1024, p0 - 5888, nullptr, (bf16*)(ws + WS_W1T), p0, 64 * kb, scr, lane);
                continue; } r -= I1;
            if (r < I2) { p0_transpose_item((const float*)P.in[I_WODIFF], 1024, 768, 32 * (r % 32), nullptr, (bf16*)(ws + WS_WOD), 32 * (r % 32), 64 * (r / 32), scr, lane); continue; } r -= I2;
            if (r < I3) { p0_transpose_item((const float*)P.in[I_WODELTA], 1024, 768, 32 * (r % 32), nullptr, (bf16*)(ws + WS_WODL), 32 * (r % 32), 64 * (r / 32), scr, lane); continue; } r -= I3;
            if (r < I4) { p0_transpose_item((const float*)P.in[I_WOCROSS], 1024, 512, 32 * (r % 32), nullptr, (bf16*)(ws + WS_WOC), 32 * (r % 32), 64 * (r / 32), scr, lane); continue; } r -= I4;
            if (r < I5) { p0_transpose_item((const float*)P.in[I_WOUT], 1024, 1024, 32 * (r % 32), nullptr, (bf16*)(ws + WS_WOUT), 32 * (r % 32), 64 * (r / 32), scr, lane); continue; } r -= I5;
            if (r < I6) { p0_transpose_item((const float*)P.in[I_WMLP1], DFF, 1024, 32 * (r % 128), (const float*)P.in[I_LN2G], (bf16*)(ws + WS_WM1), 32 * (r % 128), 64 * (r / 128), scr, lane); continue; } r -= I6;
            if (r < I7) { p0_transpose_item((const float*)P.in[I_WMLP2], 1024, DFF, 32 * (r % 32), nullptr, (bf16*)(ws + WS_WM2), 32 * (r % 32), 64 * (r / 32), scr, lane); continue; } r -= I7;
            p0_transpose_item((const float*)P.in[I_WMEMKV], 1024, 1024, 32 * (r % 32), nullptr, (bf16*)(ws + WS_WMEM), 32 * (r % 32), 64 * (r / 32), scr, lane);
        }
    }
    __syncthreads();
    {
        const float* x = (const float*)P.in[I_X]; const float* g1 = (const float*)P.in[I_LN1G];
        const float* alog = (const float*)P.in[I_ALOG]; const float* dtb = (const float*)P.in[I_DTB];
        bf16* HB = (bf16*)((unsigned char*)P.out + OUT_HB); float* BT = (float*)(ws + WS_BT); float* LA = (float*)(ws + WS_LA);
        f32x4 gv[4];
#pragma unroll
        for (int j = 0; j < 4; ++j) gv[j] = ((const f32x4*)g1)[lane + 64 * j];
        for (int m = gw; m < MTOK; m += NGW) {
            const f32x4* xr = (const f32x4*)(x + (size_t)m * DM) + lane;
            f32x4 v[4]; float s = 0.f;
#pragma unroll
            for (int j = 0; j < 4; ++j) { v[j] = xr[64 * j]; s += (v[j].x * v[j].x + v[j].y * v[j].y) + (v[j].z * v[j].z + v[j].w * v[j].w); }
            const float rstd = 1.0f / sqrtf(wave_sum(s) * (1.0f / DM) + EPS);
#pragma unroll
            for (int j = 0; j < 4; ++j) v[j] = (v[j] * rstd) * gv[j];
            unsigned long long* o8 = (unsigned long long*)(HB + (size_t)m * DM) + lane;
#pragma unroll
            for (int j = 0; j < 4; ++j) o8[64 * j] = (unsigned long long)pk2(v[j].x, v[j].y) | ((unsigned long long)pk2(v[j].z, v[j].w) << 32);
            float mine = 0.f;
#pragma unroll 1
            for (int c = 0; c < 12; ++c) { float p = 0.f;
#pragma unroll
                for (int j = 0; j < 4; ++j) { const f32x4 w = *(const f32x4*)(w12t + c * 1024 + 4 * lane + 256 * j); p += (v[j].x * w.x + v[j].y * w.y) + (v[j].z * w.z + v[j].w * w.w); }
                p = wave_sum(p); mine = (lane == c) ? p : mine; }
            if (lane < 6) BT[(size_t)m * 6 + lane] = 1.0f / (1.0f + expf(-mine));
            else if (lane < 12) { const int hh = lane - 6; const float z = mine + dtb[hh]; const float sp = (z > 20.f) ? z : log1pf(expf(z)); LA[(size_t)m * 6 + hh] = -expf(alog[hh]) * sp; }
        }
    }
    {
        const float* mem = (const float*)P.in[I_MEM]; const float* g = (const float*)P.in[I_MEMN]; bf16* MN = (bf16*)(ws + WS_MN);
        for (int m = gw; m < MEMROWS; m += NGW) {
            const f32x4* xr = (const f32x4*)(mem + (size_t)m * DM) + lane;
            f32x4 v[4]; float s = 0.f;
#pragma unroll
            for (int j = 0; j < 4; ++j) { v[j] = xr[64 * j]; s += (v[j].x * v[j].x + v[j].y * v[j].y) + (v[j].z * v[j].z + v[j].w * v[j].w); }
            const float rstd = 1.0f / sqrtf(wave_sum(s) * (1.0f / DM) + EPS);
            unsigned long long* o8 = (unsigned long long*)(MN + (size_t)m * DM) + lane;
#pragma unroll
            for (int j = 0; j < 4; ++j) { const f32x4 gg = ((const f32x4*)g)[lane + 64 * j]; const f32x4 y = (v[j] * rstd) * gg; o8[64 * j] = (unsigned long long)pk2(y.x, y.y) | ((unsigned long long)pk2(y.z, y.w) << 32); }
        }
    }
    {
        const int* pos = (const int*)P.in[I_POS]; float* RC = (float*)(ws + WS_ROPEC); float* RS = (float*)(ws + WS_ROPES); float* rowss = (float*)(ws + WS_ROWSS);
        const int gt = blockIdx.x * NTHR + tid, NGT = G * NTHR;
        for (int i = gt; i < MTOK * 32; i += NGT) { const int row = i >> 5, j = i & 31;
            const float inv = expf((-9.210340371976184f * (float)j) / 32.0f); const float ang = (float)pos[row] * inv;
            double rev = (double)ang * 0.15915494309189535; rev -= rint(rev); const float rf = (float)rev;
            RC[i] = __builtin_amdgcn_cosf(rf); RS[i] = __builtin_amdgcn_sinf(rf); }
        for (int i = gt; i < MTOK; i += NGT) rowss[i] = 0.f;
        if (blockIdx.x == 0 && wave == 0) {
            const float a = ((const float*)P.in[I_LQ1])[lane] * ((const float*)P.in[I_LK1])[lane], b = ((const float*)P.in[I_LQ2])[lane] * ((const float*)P.in[I_LK2])[lane];
            const float sa = wave_sum(a), sb = wave_sum(b);
            if (lane == 0) ((float*)(ws + WS_MISC))[0] = expf(sa) - expf(sb) + LAM_INIT;
        }
    }
}

__device__ __forceinline__ void p2a_qknorm_rope(const Params& P, int lane, int wave) {
    const int gw = blockIdx.x * NWAVES + wave, NGW = gridDim.x * NWAVES;
    unsigned char* ws = P.ws; const float* RC = (const float*)(ws + WS_ROPEC); const float* RS = (const float*)(ws + WS_ROPES);
    const float* qg = (const float*)P.in[I_DAQN]; const float* kg = (const float*)P.in[I_DAKN];
    const int j = lane & 31;
    for (int row = gw; row < MTOK; row += NGW) {
        const float c = RC[(size_t)row * 32 + j], s = RS[(size_t)row * 32 + j];
#pragma unroll 4
        for (int i = 0; i < 12; ++i) { const int group = 2 * i + (lane >> 5); const bool isk = group >= 12; const int gg = isk ? group - 12 : group;
            bf16* p = (bf16*)(ws + (isk ? WS_DAK : WS_DAQ)) + (size_t)row * 768 + gg * 64 + j;
            const float x1 = bf2f(p[0]), x2 = bf2f(p[32]); float ss = x1 * x1 + x2 * x2;
#pragma unroll
            for (int o = 1; o < 32; o <<= 1) ss += __shfl_xor(ss, o);
            const float sc = 1.0f / sqrtf(ss * (1.0f / 64.0f) + EPS); const float* g = isk ? kg : qg;
            const float y1 = x1 * sc * g[j], y2 = x2 * sc * g[j + 32];
            float o1 = y1 * c - y2 * s, o2 = y2 * c + y1 * s;
            if (!isk) { o1 *= C2_DA; o2 *= C2_DA; }
            p[0] = (bf16)f2bf(o1); p[32] = (bf16)f2bf(o2); }
    }
}

template <bool CROSS>
__device__ __forceinline__ void attn_naive_unit(const Params& P, unsigned char* lds, int tid, int b, int h, int qc) {
    constexpr int NMAP = CROSS ? 1 : 2, DQ = CROSS ? 128 : 64;
    float* Qs = (float*)lds;
    float* Ks = Qs + 64 * 128;
    float* Vs = Ks + 64 * 129;
    float* As = Vs + 64 * 128;
    unsigned char* ws = P.ws;
    const int r = tid >> 3, c8 = tid & 7;
    const int ntiles = CROSS ? 4 : qc + 1;
    const size_t qrow = (size_t)b * SEQ + (size_t)qc * 64 + r;
    bf16* Qg; const bf16* Kg; const bf16* Vg; int ldq, ldk; size_t krow0;
    if (CROSS) { Qg = (bf16*)((unsigned char*)P.out + OUT_CAQ) + qrow * 512 + h * 128; ldq = 512; Kg = (const bf16*)(ws + WS_MKV) + h * 128; Vg = Kg + 512; ldk = 1024; krow0 = (size_t)b * NMEM; }
    else { Qg = (bf16*)(ws + WS_DAQ) + qrow * 768 + h * 128; ldq = 768; Kg = (const bf16*)(ws + WS_DAK) + h * 128; Vg = (const bf16*)(ws + WS_DAV) + h * 128; ldk = 768; krow0 = (size_t)b * SEQ; }
    (void)ldq;
    const float lam = CROSS ? 0.f : ((const float*)(ws + WS_MISC))[0];
    __syncthreads();
    {
        const v4u a = *(const v4u*)(Qg + c8 * 16), c = *(const v4u*)(Qg + c8 * 16 + 8);
        float q[16] = { bflo(a.x), bfhi(a.x), bflo(a.y), bfhi(a.y), bflo(a.z), bfhi(a.z), bflo(a.w), bfhi(a.w), bflo(c.x), bfhi(c.x), bflo(c.y), bfhi(c.y), bflo(c.z), bfhi(c.z), bflo(c.w), bfhi(c.w) };
        if (CROSS) { float ss = 0.f;
#pragma unroll
            for (int i = 0; i < 16; ++i) ss += q[i] * q[i];
            ss += __shfl_xor(ss, 1); ss += __shfl_xor(ss, 2); ss += __shfl_xor(ss, 4);
            const float sc = C2_CA / sqrtf(ss * (1.0f / 128.0f) + EPS); const float* g = (const float*)P.in[I_CAQN] + c8 * 16;
#pragma unroll
            for (int i = 0; i < 16; ++i) q[i] = q[i] * sc * g[i]; }
#pragma unroll
        for (int i = 0; i < 16; ++i) Qs[r * 128 + c8 * 16 + i] = q[i];
    }
    float mrun[NMAP], lrun[NMAP];
#pragma unroll
    for (int mp = 0; mp < NMAP; ++mp) { mrun[mp] = -1e30f; lrun[mp] = 0.f; }
    float o[16];
#pragma unroll
    for (int i = 0; i < 16; ++i) o[i] = 0.f;
    for (int pass = 0; pass < 2; ++pass) {
        for (int kt = 0; kt < ntiles; ++kt) {
            __syncthreads();
            {
                const size_t kr = krow0 + (size_t)kt * 64 + r;
                const v4u a = *(const v4u*)(Kg + kr * ldk + c8 * 16), c = *(const v4u*)(Kg + kr * ldk + c8 * 16 + 8);
                float k[16] = { bflo(a.x), bfhi(a.x), bflo(a.y), bfhi(a.y), bflo(a.z), bfhi(a.z), bflo(a.w), bfhi(a.w), bflo(c.x), bfhi(c.x), bflo(c.y), bfhi(c.y), bflo(c.z), bfhi(c.z), bflo(c.w), bfhi(c.w) };
                if (CROSS) { float ss = 0.f;
#pragma unroll
                    for (int i = 0; i < 16; ++i) ss += k[i] * k[i];
                    ss += __shfl_xor(ss, 1); ss += __shfl_xor(ss, 2); ss += __shfl_xor(ss, 4);
                    const float sc = 1.0f / sqrtf(ss * (1.0f / 128.0f) + EPS); const float* g = (const float*)P.in[I_CAKN] + c8 * 16;
#pragma unroll
                    for (int i = 0; i < 16; ++i) k[i] = k[i] * sc * g[i]; }
#pragma unroll
                for (int i = 0; i < 16; ++i) Ks[r * 129 + c8 * 16 + i] = k[i];
                if (pass == 1) {
                    const v4u va = *(const v4u*)(Vg + kr * ldk + c8 * 16), vc = *(const v4u*)(Vg + kr * ldk + c8 * 16 + 8);
                    float* vd = Vs + r * 128 + c8 * 16;
                    vd[0] = bflo(va.x); vd[1] = bfhi(va.x); vd[2] = bflo(va.y); vd[3] = bfhi(va.y); vd[4] = bflo(va.z); vd[5] = bfhi(va.z); vd[6] = bflo(va.w); vd[7] = bfhi(va.w);
                    vd[8] = bflo(vc.x); vd[9] = bfhi(vc.x); vd[10] = bflo(vc.y); vd[11] = bfhi(vc.y); vd[12] = bflo(vc.z); vd[13] = bfhi(vc.z); vd[14] = bflo(vc.w); vd[15] = bfhi(vc.w);
                }
            }
            __syncthreads();
            float sc[NMAP][8];
#pragma unroll
            for (int mp = 0; mp < NMAP; ++mp) {
#pragma unroll
                for (int i = 0; i < 8; ++i) sc[mp][i] = 0.f;
                for (int d = 0; d < DQ; ++d) { const float q = Qs[r * 128 + mp * DQ + d];
#pragma unroll
                    for (int i = 0; i < 8; ++i) sc[mp][i] += q * Ks[(c8 + 8 * i) * 129 + mp * DQ + d]; }
            }
            if (pass == 0) {
#pragma unroll
                for (int mp = 0; mp < NMAP; ++mp) { float tm = sc[mp][0];
#pragma unroll
                    for (int i = 1; i < 8; ++i) tm = fmaxf(tm, sc[mp][i]);
                    tm = fmaxf(tm, __shfl_xor(tm, 1)); tm = fmaxf(tm, __shfl_xor(tm, 2)); tm = fmaxf(tm, __shfl_xor(tm, 4));
                    const float mn = fmaxf(mrun[mp], tm); float ps = 0.f;
#pragma unroll
                    for (int i = 0; i < 8; ++i) ps += exp2f(sc[mp][i] - mn);
                    ps += __shfl_xor(ps, 1); ps += __shfl_xor(ps, 2); ps += __shfl_xor(ps, 4);
                    lrun[mp] = lrun[mp] * exp2f(mrun[mp] - mn) + ps; mrun[mp] = mn; }
            } else {
#pragma unroll
                for (int i = 0; i < 8; ++i) { float a = exp2f(sc[0][i] - mrun[0]) / lrun[0];
                    if (!CROSS) a -= lam * (exp2f(sc[NMAP - 1][i] - mrun[NMAP - 1]) / lrun[NMAP - 1]);
                    As[r * 65 + c8 + 8 * i] = a; }
                __syncthreads();
                for (int key = 0; key < 64; ++key) { const float a = As[r * 65 + key]; const float* vv = Vs + key * 128 + c8 * 16;
#pragma unroll
                    for (int i = 0; i < 16; ++i) o[i] += a * vv[i]; }
            }
        }
    }
    if (!CROSS) { float ss = 0.f;
#pragma unroll
        for (int i = 0; i < 16; ++i) ss += o[i] * o[i];
        ss += __shfl_xor(ss, 1); ss += __shfl_xor(ss, 2); ss += __shfl_xor(ss, 4);
        const float sc = (1.0f - LAM_INIT) / sqrtf(ss * (1.0f / 128.0f) + EPS); const float* g = (const float*)P.in[I_SUBLN] + c8 * 16;
#pragma unroll
        for (int i = 0; i < 16; ++i) o[i] = o[i] * sc * g[i]; }
    v4u w0, w1; w0.x = pk2(o[0], o[1]); w0.y = pk2(o[2], o[3]); w0.z = pk2(o[4], o[5]); w0.w = pk2(o[6], o[7]); w1.x = pk2(o[8], o[9]); w1.y = pk2(o[10], o[11]); w1.z = pk2(o[12], o[13]); w1.w = pk2(o[14], o[15]);
    *(v4u*)(Qg + c8 * 16) = w0; *(v4u*)(Qg + c8 * 16 + 8) = w1;
}

__device__ __forceinline__ void gdn_naive_unit(const Params& P, unsigned char* lds, int tid, int lane, int wave, int b, int hh) {
    float* X = (float*)lds;
    float* Os = X + 64 * 384;
    unsigned char* ws = P.ws;
    const float* wconv = (const float*)P.in[I_WCONV]; const float* BT = (const float*)(ws + WS_BT); const float* LA = (const float*)(ws + WS_LA);
    const float* gng = (const float*)P.in[I_GDNN];
    const int el = lane & 15, dg = lane >> 4, e = wave * 16 + el;
    float S[32];
#pragma unroll
    for (int i = 0; i < 32; ++i) S[i] = 0.f;
    for (int ch = 0; ch < SEQ / 64; ++ch) {
        const int t0 = ch * 64;
        __syncthreads();
        for (int idx = tid; idx < 64 * 384; idx += NTHR) { const int t = idx / 384, c = idx - t * 384, sec = c >> 7, cc = c & 127;
            const bf16* src = (const bf16*)(ws + WS_GQ + (size_t)sec * WS_SEC) + hh * 128 + cc; const float* wc = wconv + sec * 768 + hh * 128 + cc;
            float acc = 0.f;
#pragma unroll
            for (int tap = 0; tap < 4; ++tap) { const int tt = t0 + t - 3 + tap; if (tt >= 0) acc += wc[tap * 2304] * bf2f(src[((size_t)b * SEQ + tt) * 768]); }
            X[idx] = siluf(acc); }
        __syncthreads();
        {
            const int rr = tid >> 2, c4 = tid & 3, t = rr & 63, sec = rr >> 6; float* p = X + t * 384 + sec * 128 + c4 * 32; float ss = 0.f;
#pragma unroll
            for (int i = 0; i < 32; ++i) ss += p[i] * p[i];
            ss += __shfl_xor(ss, 1); ss += __shfl_xor(ss, 2);
            const float sc = (sec == 0 ? 0.08838834764831845f : 1.0f) / sqrtf(ss + EPS);
#pragma unroll
            for (int i = 0; i < 32; ++i) p[i] *= sc;
        }
        __syncthreads();
        for (int tl = 0; tl < 64; ++tl) { const size_t row = (size_t)b * SEQ + t0 + tl;
            const float beta = BT[row * 6 + hh], alpha = expf(LA[row * 6 + hh]);
            const float* xr = X + tl * 384; const float v = xr[256 + e];
            float kk[32], ks = 0.f;
#pragma unroll
            for (int i = 0; i < 32; ++i) { kk[i] = xr[128 + dg * 32 + i]; ks += kk[i] * S[i]; }
            ks += __shfl_xor(ks, 16); ks += __shfl_xor(ks, 32);
            const float cf = beta * (v - alpha * ks); float oo = 0.f;
#pragma unroll
            for (int i = 0; i < 32; ++i) { S[i] = alpha * S[i] + kk[i] * cf; oo += xr[dg * 32 + i] * S[i]; }
            oo += __shfl_xor(oo, 16); oo += __shfl_xor(oo, 32);
            if (dg == 0) Os[tl * 128 + e] = oo; }
        __syncthreads();
        {
            const int r = tid >> 3, c8 = tid & 7; const float* op = Os + r * 128 + c8 * 16; float ss = 0.f;
#pragma unroll
            for (int i = 0; i < 16; ++i) ss += op[i] * op[i];
            ss += __shfl_xor(ss, 1); ss += __shfl_xor(ss, 2); ss += __shfl_xor(ss, 4);
            const float sc = 1.0f / sqrtf(ss * (1.0f / 128.0f) + EPS);
            bf16* zp = (bf16*)(ws + WS_GZ) + ((size_t)b * SEQ + t0 + r) * 768 + hh * 128 + c8 * 16;
            const v4u za = *(const v4u*)zp, zc = *(const v4u*)(zp + 8);
            const float z[16] = { bflo(za.x), bfhi(za.x), bflo(za.y), bfhi(za.y), bflo(za.z), bfhi(za.z), bflo(za.w), bfhi(za.w), bflo(zc.x), bfhi(zc.x), bflo(zc.y), bfhi(zc.y), bflo(zc.z), bfhi(zc.z), bflo(zc.w), bfhi(zc.w) };
            float y[16];
#pragma unroll
            for (int i = 0; i < 16; ++i) y[i] = op[i] * sc * gng[c8 * 16 + i] * siluf(z[i]);
            v4u w0, w1; w0.x = pk2(y[0], y[1]); w0.y = pk2(y[2], y[3]); w0.z = pk2(y[4], y[5]); w0.w = pk2(y[6], y[7]); w1.x = pk2(y[8], y[9]); w1.y = pk2(y[10], y[11]); w1.z = pk2(y[12], y[13]); w1.w = pk2(y[14], y[15]);
            *(v4u*)zp = w0; *(v4u*)(zp + 8) = w1;
        }
    }
}

constexpr int NPHASE = 8;
__global__ void __launch_bounds__(NTHR, 2) mega_fwd(Params P) {
    extern __shared__ __attribute__((aligned(16))) unsigned char lds[];
    cg::grid_group grid = cg::this_grid();
    const int G = gridDim.x;
    unsigned char* ws = P.ws; unsigned char* outb = (unsigned char*)P.out;
    PG8_LAS unsigned char* lds3 = (PG8_LAS unsigned char*)lds;
    const int lo = P.lo, hi = P.hi;
#define IN(k) (lo <= (k) && (k) < hi)
#define SEAM(k) do { if (IN(k) && IN((k) + 1)) grid.sync(); } while (0)

#define LAUNDER() int tid = threadIdx.x; asm volatile("" : "+v"(tid)); const int lane = tid & 63, wave = __builtin_amdgcn_readfirstlane(tid >> 6); (void)lane; (void)wave
    if (IN(0)) { LAUNDER(); p0_prologue(P, lds, tid, lane, wave); __syncthreads(); }
    SEAM(0);
    if (IN(1)) {
        { pg8::Gemm g{(const pg8::bf16_t*)(outb + OUT_HB), (const pg8::bf16_t*)(ws + WS_W1T), MTOK, NCOMB, DM}; pg8::StaticOrder S; S.init(MTOK, NCOMB, G, (int)blockIdx.x);
          pg8::EpiP1 E{ws, outb, (const float*)P.in[I_BGATE]};
          pg8::gemm_phase<pg8::EpiP1, pg8::StaticOrder, true, true>(lds3, g, S, E); }
        { pg8::Gemm g{(const pg8::bf16_t*)(ws + WS_MN), (const pg8::bf16_t*)(ws + WS_WMEM), MEMROWS, 1024, DM}; pg8::StaticOrder S; S.init(MEMROWS, 1024, G, (int)blockIdx.x);
          pg8::EpiPlain E{(pg8::bf16_t*)(ws + WS_MKV), 1024};
          pg8::gemm_phase<pg8::EpiPlain, pg8::StaticOrder, true, true>(lds3, g, S, E); }
    }
    SEAM(1);
    if (IN(2)) { LAUNDER(); p2a_qknorm_rope(P, lane, wave); }
    SEAM(2);
    if (IN(3)) {
        LAUNDER();
        if ((int)blockIdx.x < 24 && G > 24) gdn_naive_unit(P, lds, tid, lane, wave, (int)blockIdx.x / 6, (int)blockIdx.x % 6);
        else { const int first = (G > 24) ? (int)blockIdx.x - 24 : (int)blockIdx.x, stride = (G > 24) ? G - 24 : G;
            if (G <= 24) for (int u = (int)blockIdx.x; u < 24; u += G) gdn_naive_unit(P, lds, tid, lane, wave, u / 6, u % 6);
            for (int u = first; u < 24 * 128; u += stride) { const int qc = 127 - u / 24, bh = u % 24; attn_naive_unit<false>(P, lds, tid, bh / 6, bh % 6, qc); } }
        for (int u = (int)blockIdx.x; u < NB * 4 * 128; u += G) { const int qc = u & 127, bh = u >> 7; attn_naive_unit<true>(P, lds, tid, bh >> 2, bh & 3, qc); }
        __syncthreads();
    }
    SEAM(3);
    if (IN(4)) {
        pg8::StaticOrder S; S.init(MTOK, DM, G, (int)blockIdx.x);
        const unsigned char* gates = ws + WS_GATES; float* mixf = (float*)(ws + WS_MIXF); pg8::bf16_t* mixed = (pg8::bf16_t*)(ws + WS_MIXED);
        { pg8::Gemm g{(const pg8::bf16_t*)(ws + WS_DAQ), (const pg8::bf16_t*)(ws + WS_WOD), MTOK, DM, 768}; pg8::EpiGate<0> E{gates, mixf, mixed, 0};
          pg8::gemm_phase<pg8::EpiGate<0>, pg8::StaticOrder, true, true>(lds3, g, S, E); }
        { pg8::Gemm g{(const pg8::bf16_t*)(ws + WS_GZ), (const pg8::bf16_t*)(ws + WS_WODL), MTOK, DM, 768}; pg8::EpiGate<1> E{gates, mixf, mixed, 1};
          pg8::gemm_phase<pg8::EpiGate<1>, pg8::StaticOrder, true, true>(lds3, g, S, E); }
        { pg8::Gemm g{(const pg8::bf16_t*)(outb + OUT_CAQ), (const pg8::bf16_t*)(ws + WS_WOC), MTOK, DM, 512}; pg8::EpiGate<2> E{gates, mixf, mixed, 2};
          pg8::gemm_phase<pg8::EpiGate<2>, pg8::StaticOrder, true, true>(lds3, g, S, E); }
    }
    SEAM(4);
    if (IN(5)) {
        pg8::Gemm g{(const pg8::bf16_t*)(ws + WS_MIXED), (const pg8::bf16_t*)(ws + WS_WOUT), MTOK, DM, DM}; pg8::StaticOrder S; S.init(MTOK, DM, G, (int)blockIdx.x);
        pg8::EpiRes1 E{(const float*)P.in[I_X], P.out, (pg8::bf16_t*)(ws + WS_X1B), (float*)(ws + WS_ROWSS)};
        pg8::gemm_phase<pg8::EpiRes1, pg8::StaticOrder, true, true>(lds3, g, S, E);
    }
    SEAM(5);
    if (IN(6)) {
        pg8::Gemm g{(const pg8::bf16_t*)(ws + WS_X1B), (const pg8::bf16_t*)(ws + WS_WM1), MTOK, DFF, DM}; pg8::StaticOrder S; S.init(MTOK, DFF, G, (int)blockIdx.x);
        pg8::EpiMlp1 E{(const float*)(ws + WS_ROWSS), (pg8::bf16_t*)(ws + WS_HMID)};
        pg8::gemm_phase<pg8::EpiMlp1, pg8::StaticOrder, true, true>(lds3, g, S, E);
    }
    SEAM(6);
    if (IN(7)) {
        pg8::Gemm g{(const pg8::bf16_t*)(ws + WS_HMID), (const pg8::bf16_t*)(ws + WS_WM2), MTOK, DM, DFF}; pg8::StaticOrder S; S.init(MTOK, DM, G, (int)blockIdx.x);
        pg8::EpiRes2 E{P.out};
        pg8::gemm_phase<pg8::EpiRes2, pg8::StaticOrder, true, true>(lds3, g, S, E);
    }
#undef IN
#undef SEAM
}

#ifndef MK_SPLIT
#define MK_SPLIT 0
#endif
extern "C" void kernel_launch(void* const* d_in, const int* in_sizes, int n_in, void* d_out, int out_size, void* d_ws, size_t ws_size, hipStream_t stream) {
    static int grid = 0;
    if (grid == 0) {
        if (n_in != 29 || in_sizes[0] != MTOK * DM || out_size != MTOK * DM || ws_size < WS_NEED) {
            fprintf(stderr, "kernel_launch: unexpected problem: n_in %d in0 %d out %d ws %zu (need %zu)\n", n_in, n_in > 0 ? in_sizes[0] : -1, out_size, ws_size, (size_t)WS_NEED); grid = -1; return; }
        int dev = 0, cus = 0, per_cu = 0;
        hipGetDevice(&dev); hipDeviceGetAttribute(&cus, hipDeviceAttributeMultiprocessorCount, dev);
        if (hipFuncSetAttribute((const void*)mega_fwd, hipFuncAttributeMaxDynamicSharedMemorySize, LDS_BYTES) != hipSuccess) { fprintf(stderr, "kernel_launch: hipFuncSetAttribute failed\n"); grid = -1; return; }
        if (hipOccupancyMaxActiveBlocksPerMultiprocessor(&per_cu, (const void*)mega_fwd, NTHR, LDS_BYTES) != hipSuccess || per_cu < 1) { fprintf(stderr, "kernel_launch: occupancy query says %d\n", per_cu); per_cu = 1; }
        (void)hipGetLastError();
        grid = cus * 1;
        fprintf(stderr, "kernel_launch: cus %d per_cu %d grid %d ws %zu\n", cus, per_cu, grid, ws_size);
    }
    if (grid < 0) return;
    Params p{};
    for (int i = 0; i < 29; ++i) p.in[i] = d_in[i];
    p.out = (float*)d_out; p.ws = (unsigned char*)d_ws;
#if MK_SPLIT
    for (int ph = 0; ph < NPHASE; ++ph) { p.lo = ph; p.hi = ph + 1; hipLaunchKernelGGL(mega_fwd, dim3(grid), dim3(NTHR), LDS_BYTES, stream, p); }
#else
    p.lo = 0; p.hi = NPHASE;
    void* args[] = { &p };
    hipError_t e = hipLaunchCooperativeKernel((const void*)mega_fwd, dim3(grid), dim3(NTHR), args, LDS_BYTES, stream);
    if (e != hipSuccess) fprintf(stderr, "kernel_launch: cooperative launch failed: %s (grid %d)\n", hipGetErrorString(e), grid);
#endif
}
```

```cpp
#include <hip/hip_runtime.h>
#include <hip/hip_cooperative_groups.h>
#include <cstdio>
#include <cstdint>
namespace cg = cooperative_groups;

constexpr int NB = 4, SEQ = 8192, DM = 1024, MTOK = NB * SEQ;
constexpr int NMEM = 256, MEMROWS = NB * NMEM;
constexpr int DIN = 5900, NGATE = 3072, DFF = 4096;
constexpr int NCOMB = 8960;
constexpr float EPS = 1e-6f;
constexpr float C2_DA = 0.125f * 1.4426950408889634f;
constexpr float C2_CA = 0.08838834764831845f * 1.4426950408889634f;
constexpr float LAM_INIT = 0.2f;

constexpr size_t MiB = (size_t)1 << 20;
constexpr size_t WS_W1T = 0, WS_WOD = 18 * MiB, WS_WODL = 20 * MiB, WS_WOC = 22 * MiB, WS_WOUT = 23 * MiB, WS_WM1 = 25 * MiB, WS_WM2 = 33 * MiB, WS_WMEM = 41 * MiB;
constexpr size_t WS_ROPEC = 43 * MiB, WS_ROPES = 47 * MiB, WS_BT = 51 * MiB, WS_LA = 52 * MiB, WS_MN = 53 * MiB, WS_MKV = 55 * MiB, WS_HALO = 57 * MiB;
constexpr size_t WS_ROWSS = 63 * MiB + 768 * 1024, WS_MISC = 63 * MiB + 960 * 1024;
constexpr size_t WS_GATES = 64 * MiB;
constexpr size_t WS_DAQ = 160 * MiB, WS_SEC = 48 * MiB;
constexpr size_t WS_DAK = WS_DAQ + WS_SEC, WS_DAV = WS_DAQ + 2 * WS_SEC, WS_GQ = WS_DAQ + 3 * WS_SEC, WS_GK = WS_DAQ + 4 * WS_SEC, WS_GV = WS_DAQ + 5 * WS_SEC, WS_GZ = WS_DAQ + 6 * WS_SEC;
constexpr size_t WS_MIXF = 208 * MiB, WS_MIXED = 336 * MiB, WS_X1B = 416 * MiB, WS_HMID = 160 * MiB;
constexpr size_t WS_NEED = 496 * MiB;
constexpr size_t OUT_HB = 0, OUT_CAQ = 72 * MiB;
namespace pg8 {
#define PG8_LAS __attribute__((address_space(3)))
typedef unsigned short bf16_t;
typedef short bf16x8 __attribute__((ext_vector_type(8)));
typedef float f32x4 __attribute__((ext_vector_type(4)));
typedef unsigned u32x4 __attribute__((ext_vector_type(4)));
constexpr int BM = 256, BK = 64, HALF = 128, HTB = HALF * BK * 2  , STAGE_BYTES = 8 * HTB, NXCD = 8, WGM = 8;

__host__ __device__ __forceinline__ int lds_byte(int r, int c) { const int st = (r >> 4) * 2 + (c >> 5), rr = r & 15, cc = c & 31, ob = rr * 64 + cc * 2; return st * 1024 + (ob ^ (((ob >> 9) & 1) << 5)); }
__host__ __device__ __forceinline__ void stage_rc(int b, int& R, int& C) { const int st = b / 1024, sb = b % 1024, swz = sb ^ (((sb >> 9) & 1) << 5); R = (st >> 1) * 16 + swz / 64; C = (st & 1) * 32 + (swz % 64) / 2; }
__host__ __device__ __forceinline__ int perm32(int rho) { const int n = rho >> 4, i = rho & 15; return 8 * (i >> 2) + 4 * n + (i & 3); }

struct Unit { int pm, pn; };
struct Gemm { const bf16_t* A; const bf16_t* Bt; int M, N, K; };

struct StaticOrder {
    int nM, nN, nwg, G, c;
    __host__ __device__ void init(int M, int N, int G_, int c_) { nM = M / BM; nN = N / BM; nwg = nM * nN; G = G_; c = c_; }
    __host__ __device__ bool next(int i, Unit& u) const {
        const long L = (long)i * G + c; if (L >= nwg) return false;
        int wgid = (int)L; { const int q = nwg / NXCD, r = nwg % NXCD, xcd = wgid % NXCD, off = wgid / NXCD; wgid = (xcd < r ? xcd * (q + 1) : r * (q + 1) + (xcd - r) * q) + off; }
        const int nig = WGM * nN, gid = wgid / nig, fm = gid * WGM, gsz = (nM - fm) < WGM ? (nM - fm) : WGM;
        u.pm = fm + ((wgid % nig) % gsz); u.pn = (wgid % nig) / gsz; return true;
    }
    __device__ __forceinline__ void a_ready(const Unit&) const {}
    __device__ __forceinline__ void done(const Unit&) const {}
};

__device__ __forceinline__ unsigned cvt_pk_bf16(float lo, float hi) { unsigned r; asm volatile("v_cvt_pk_bf16_f32 %0, %1, %2" : "=v"(r) : "v"(lo), "v"(hi)); return r; }
typedef unsigned u32x2 __attribute__((ext_vector_type(2)));
__device__ __forceinline__ u32x4 pack8(const f32x4 a, const f32x4 b) { u32x4 w; w.x = cvt_pk_bf16(a[0], a[1]); w.y = cvt_pk_bf16(a[2], a[3]); w.z = cvt_pk_bf16(b[0], b[1]); w.w = cvt_pk_bf16(b[2], b[3]); return w; }
__device__ __forceinline__ float sigm(float x) { return 1.0f / (1.0f + __expf(-x)); }

struct EpiPlain {
    static constexpr bool PERM = true, AFTER_DRAIN = false;
    bf16_t* O; int ldc;
    __device__ __forceinline__ void operator()(const f32x4 (&acc)[2][2][4][2], const Unit& u, int wr, int wc, int fr, int fq) const {
        const int row0 = u.pm * BM + wr * 64 + fr, col0 = u.pn * BM + wc * 32 + 8 * fq;
#pragma unroll
        for (int ai = 0; ai < 2; ++ai)
#pragma unroll
            for (int m = 0; m < 4; ++m) { bf16_t* rowp = O + (size_t)(row0 + ai * HALF + m * 16) * ldc + col0;
#pragma unroll
                for (int bj = 0; bj < 2; ++bj) *(u32x4*)(rowp + bj * HALF) = pack8(acc[ai][bj][m][0], acc[ai][bj][m][1]); }
    }
};

struct EpiP1 {
    static constexpr bool PERM = true, AFTER_DRAIN = false;
    unsigned char* ws; unsigned char* outb; const float* bgate;
    __device__ __forceinline__ void operator()(const f32x4 (&acc)[2][2][4][2], const Unit& u, int wr, int wc, int fr, int fq) const {
        const int pn = u.pn, row0 = u.pm * BM + wr * 64 + fr, cl0 = wc * 32 + 8 * fq;
        if (pn < 23) {
            bf16_t* base; int ldc, colt;
            if (pn < 21) { const int bi = pn / 3; base = (bf16_t*)(ws + WS_DAQ + (size_t)bi * WS_SEC); ldc = 768; colt = (pn - 3 * bi) * 256; }
            else { base = (bf16_t*)(outb + OUT_CAQ); ldc = 512; colt = (pn - 21) * 256; }
            const bool halo = (pn >= 9 && pn < 18);
            bf16_t* hb = (bf16_t*)(ws + WS_HALO);
#pragma unroll
            for (int ai = 0; ai < 2; ++ai)
#pragma unroll
                for (int m = 0; m < 4; ++m) { const int row = row0 + ai * HALF + m * 16; bf16_t* rowp = base + (size_t)row * ldc + colt + cl0;
#pragma unroll
                    for (int bj = 0; bj < 2; ++bj) { const u32x4 w = pack8(acc[ai][bj][m][0], acc[ai][bj][m][1]); *(u32x4*)(rowp + bj * HALF) = w;
                        if (halo && (row & 63) >= 61) *(u32x4*)(hb + ((size_t)(row >> 6) * 3 + ((row & 63) - 61)) * 2304 + (pn - 9) * 256 + bj * HALF + cl0) = w; } }
        } else {
            unsigned char* gb = ws + WS_GATES; const int colt = (pn - 23) * 256 + cl0;
            f32x4 bv[2][2];
#pragma unroll
            for (int bj = 0; bj < 2; ++bj)
#pragma unroll
                for (int n = 0; n < 2; ++n) bv[bj][n] = *(const f32x4*)(bgate + colt + bj * HALF + 4 * n);
#pragma unroll
            for (int ai = 0; ai < 2; ++ai)
#pragma unroll
                for (int m = 0; m < 4; ++m) { const int row = row0 + ai * HALF + m * 16; unsigned char* rowp = gb + (size_t)row * NGATE + colt;
#pragma unroll
                    for (int bj = 0; bj < 2; ++bj) { const f32x4 v0 = acc[ai][bj][m][0] + bv[bj][0], v1 = acc[ai][bj][m][1] + bv[bj][1];
                        unsigned q[8];
#pragma unroll
                        for (int i = 0; i < 4; ++i) { q[i] = (unsigned)__builtin_rintf(255.0f * sigm(v0[i])); q[4 + i] = (unsigned)__builtin_rintf(255.0f * sigm(v1[i])); }
                        u32x2 w; w.x = q[0] | (q[1] << 8) | (q[2] << 16) | (q[3] << 24); w.y = q[4] | (q[5] << 8) | (q[6] << 16) | (q[7] << 24);
                        *(u32x2*)(rowp + bj * HALF) = w; } }
        }
    }
};

template <int MODE> struct EpiGate {
    static constexpr bool PERM = true, AFTER_DRAIN = false;
    const unsigned char* gates; float* mixf; bf16_t* mixed; int br;
    __device__ __forceinline__ void operator()(const f32x4 (&acc)[2][2][4][2], const Unit& u, int wr, int wc, int fr, int fq) const {
        const int row0 = u.pm * BM + wr * 64 + fr, col0 = u.pn * BM + wc * 32 + 8 * fq;
#pragma unroll
        for (int ai = 0; ai < 2; ++ai)
#pragma unroll
            for (int m = 0; m < 4; ++m) { const int row = row0 + ai * HALF + m * 16;
#pragma unroll
                for (int bj = 0; bj < 2; ++bj) { const int col = col0 + bj * HALF;
                    const u32x2 gw = *(const u32x2*)(gates + (size_t)row * NGATE + br * 1024 + col);
                    f32x4 g0, g1;
#pragma unroll
                    for (int i = 0; i < 4; ++i) { g0[i] = (float)((gw.x >> (8 * i)) & 255u) * (1.0f / 255.0f); g1[i] = (float)((gw.y >> (8 * i)) & 255u) * (1.0f / 255.0f); }
                    f32x4 v0 = acc[ai][bj][m][0] * g0, v1 = acc[ai][bj][m][1] * g1;
                    float* mp = mixf + (size_t)row * DM + col;
                    if (MODE >= 1) { v0 = v0 + *(const f32x4*)mp; v1 = v1 + *(const f32x4*)(mp + 4); }
                    if (MODE <= 1) { *(f32x4*)mp = v0; *(f32x4*)(mp + 4) = v1; }
                    else *(u32x4*)(mixed + (size_t)row * DM + col) = pack8(v0, v1); } }
    }
};

struct EpiRes1 {
    static constexpr bool PERM = true, AFTER_DRAIN = false;
    const float* x; float* out; bf16_t* x1b; float* rowss;
    __device__ __forceinline__ void operator()(const f32x4 (&acc)[2][2][4][2], const Unit& u, int wr, int wc, int fr, int fq) const {
        const int row0 = u.pm * BM + wr * 64 + fr, col0 = u.pn * BM + wc * 32 + 8 * fq;
#pragma unroll
        for (int ai = 0; ai < 2; ++ai)
#pragma unroll
            for (int m = 0; m < 4; ++m) { const int row = row0 + ai * HALF + m * 16; float ss = 0.f;
#pragma unroll
                for (int bj = 0; bj < 2; ++bj) { const size_t off = (size_t)row * DM + col0 + bj * HALF;
                    const f32x4 v0 = acc[ai][bj][m][0] + *(const f32x4*)(x + off), v1 = acc[ai][bj][m][1] + *(const f32x4*)(x + off + 4);
                    *(f32x4*)(out + off) = v0; *(f32x4*)(out + off + 4) = v1; *(u32x4*)(x1b + off) = pack8(v0, v1);
                    ss += (v0[0] * v0[0] + v0[1] * v0[1]) + (v0[2] * v0[2] + v0[3] * v0[3]) + (v1[0] * v1[0] + v1[1] * v1[1]) + (v1[2] * v1[2] + v1[3] * v1[3]); }
                ss += __shfl_xor(ss, 16); ss += __shfl_xor(ss, 32);
                if (fq == 0) atomicAdd(rowss + row, ss); }
    }
};

struct EpiMlp1 {
    static constexpr bool PERM = true, AFTER_DRAIN = false;
    const float* rowss; bf16_t* O;
    __device__ __forceinline__ void operator()(const f32x4 (&acc)[2][2][4][2], const Unit& u, int wr, int wc, int fr, int fq) const {
        const int row0 = u.pm * BM + wr * 64 + fr, col0 = u.pn * BM + wc * 32 + 8 * fq;
#pragma unroll
        for (int ai = 0; ai < 2; ++ai)
#pragma unroll
            for (int m = 0; m < 4; ++m) { const int row = row0 + ai * HALF + m * 16; const float r = __builtin_amdgcn_rsqf(rowss[row] * (1.0f / 1024.0f) + EPS);
                bf16_t* rowp = O + (size_t)row * DFF + col0;
#pragma unroll
                for (int bj = 0; bj < 2; ++bj) { f32x4 v0 = acc[ai][bj][m][0] * r, v1 = acc[ai][bj][m][1] * r;
#pragma unroll
                    for (int i = 0; i < 4; ++i) { const float a = __builtin_fmaxf(v0[i], 0.f), b = __builtin_fmaxf(v1[i], 0.f); v0[i] = a * a; v1[i] = b * b; }
                    *(u32x4*)(rowp + bj * HALF) = pack8(v0, v1); } }
    }
};

struct EpiRes2 {
    static constexpr bool PERM = true, AFTER_DRAIN = false;
    float* out;
    __device__ __forceinline__ void operator()(const f32x4 (&acc)[2][2][4][2], const Unit& u, int wr, int wc, int fr, int fq) const {
        const int row0 = u.pm * BM + wr * 64 + fr, col0 = u.pn * BM + wc * 32 + 8 * fq;
#pragma unroll
        for (int ai = 0; ai < 2; ++ai)
#pragma unroll
            for (int m = 0; m < 4; ++m) { const int row = row0 + ai * HALF + m * 16;
#pragma unroll
                for (int bj = 0; bj < 2; ++bj) { const size_t off = (size_t)row * DM + col0 + bj * HALF;
                    *(f32x4*)(out + off) = acc[ai][bj][m][0] + *(const f32x4*)(out + off); *(f32x4*)(out + off + 4) = acc[ai][bj][m][1] + *(const f32x4*)(out + off + 4); } }
    }
};

template <class Epi, class Sched, bool ALIGN_EPI = false, bool SP2 = false>
__device__ __forceinline__ void gemm_phase(PG8_LAS unsigned char* lds, const Gemm g, const Sched& S, const Epi& E) {
    int tid_ = threadIdx.x; asm volatile("" : "+v"(tid_));
    const int tid = tid_, wid = __builtin_amdgcn_readfirstlane(tid >> 6), lane = tid & 63, wr = wid >> 2, wc = wid & 3, fr = lane & 15, fq = lane >> 4;
    const int K = g.K, nt = K / BK;
    unsigned voffA[2], voffB[2];
#pragma unroll
    for (int i = 0; i < 2; ++i) { int R, C; stage_rc(tid * 16 + i * 8192, R, C); const int Rb = Epi::PERM ? ((R & ~31) + perm32(R & 31)) : R;
        voffA[i] = (unsigned)(R * K + C) * 2u; voffB[i] = (unsigned)(Rb * K + C) * 2u; }
    const size_t kstep = (size_t)(BK * 2);
    const size_t hstep = (size_t)HALF * K * 2;
    const size_t tstep = 2 * hstep;
    const unsigned ldsw = (unsigned)wid * 1024u;
    const int aoff = lds_byte(wr * 64 + fr, fq * 8), boff = lds_byte(wc * 32 + fr, fq * 8);
#define PG8_SA(b, h) (((b) * 2 + (h)) * HTB)
#define PG8_SB(b, h) ((4 + (b) * 2 + (h)) * HTB)
#define PG8_STAGE(bufoff, gbase, voff) do { _Pragma("unroll") for (int _i = 0; _i < 2; ++_i) \
        __builtin_amdgcn_global_load_lds((const unsigned*)((const char*)(gbase) + (voff)[_i]), (PG8_LAS unsigned*)(lds + (bufoff) + ldsw + _i * 8192), 16, 0, 0); } while (0)
#define PG8_LDA(dst, b, h) do { _Pragma("unroll") for (int m = 0; m < 4; ++m) _Pragma("unroll") for (int k = 0; k < 2; ++k) dst[m][k] = *(const PG8_LAS bf16x8*)(lds + PG8_SA(b, h) + aoff + m * 2048 + k * 1024); } while (0)
#define PG8_LDB(dst, b, h) do { _Pragma("unroll") for (int n = 0; n < 2; ++n) _Pragma("unroll") for (int k = 0; k < 2; ++k) dst[n][k] = *(const PG8_LAS bf16x8*)(lds + PG8_SB(b, h) + boff + n * 2048 + k * 1024); } while (0)
#define PG8_MMA(ai, bj, At, Bt) do { __builtin_amdgcn_s_setprio(1); _Pragma("unroll") for (int m = 0; m < 4; ++m) _Pragma("unroll") for (int n = 0; n < 2; ++n) _Pragma("unroll") for (int k = 0; k < 2; ++k) \
        acc[ai][bj][m][n] = __builtin_amdgcn_mfma_f32_16x16x32_bf16(Bt[n][k], At[m][k], acc[ai][bj][m][n], 0, 0, 0); __builtin_amdgcn_s_setprio(0); } while (0)
#define PG8_WAIT_V(n) asm volatile("s_waitcnt vmcnt(" #n ")" ::: "memory")
#define PG8_WAIT_L(n) asm volatile("s_waitcnt lgkmcnt(" #n ")" ::: "memory")
#define PG8_BAR __builtin_amdgcn_s_barrier()
#define PG8_SCHED __builtin_amdgcn_sched_barrier(0)
    Unit cur, nxt; int ui = 0;
    if (!S.next(0, cur)) return;
    f32x4 acc[2][2][4][2];
#pragma unroll
    for (int a = 0; a < 2; ++a)
#pragma unroll
        for (int b = 0; b < 2; ++b)
#pragma unroll
            for (int m = 0; m < 4; ++m)
#pragma unroll
                for (int n = 0; n < 2; ++n) acc[a][b][m][n] = (f32x4){0.f, 0.f, 0.f, 0.f};
    bf16x8 At[4][2], B0[2][2], B1[2][2];
    const char* cA = (const char*)g.A + (size_t)cur.pm * tstep; const char* cB = (const char*)g.Bt + (size_t)cur.pn * tstep;
    S.a_ready(cur);
    if constexpr (SP2) {
        PG8_STAGE(PG8_SB(0, 0), cB, voffB); PG8_STAGE(PG8_SB(0, 1), cB + hstep, voffB); PG8_STAGE(PG8_SA(0, 0), cA, voffA); PG8_STAGE(PG8_SA(0, 1), cA + hstep, voffA);
        if (wr == 1) PG8_BAR;
        PG8_WAIT_V(2); PG8_BAR;
        PG8_STAGE(PG8_SB(1, 0), cB + kstep, voffB); PG8_STAGE(PG8_SA(1, 0), cA + kstep, voffA); PG8_STAGE(PG8_SB(1, 1), cB + hstep + kstep, voffB);
        PG8_WAIT_V(6); PG8_BAR;
    } else {
        PG8_STAGE(PG8_SB(0, 0), cB, voffB); PG8_STAGE(PG8_SA(0, 0), cA, voffA); PG8_STAGE(PG8_SB(0, 1), cB + hstep, voffB); PG8_STAGE(PG8_SA(0, 1), cA + hstep, voffA);
        if (wr == 1) PG8_BAR;
        PG8_WAIT_V(4); PG8_BAR;
        PG8_STAGE(PG8_SB(1, 0), cB + kstep, voffB); PG8_STAGE(PG8_SA(1, 0), cA + kstep, voffA); PG8_STAGE(PG8_SB(1, 1), cB + hstep + kstep, voffB);
        PG8_WAIT_V(6); PG8_BAR;
    }
    for (;;) {
        const bool has_next = S.next(ui + 1, nxt);
        const char* nA = has_next ? (const char*)g.A + (size_t)nxt.pm * tstep : cA; const char* nB = has_next ? (const char*)g.Bt + (size_t)nxt.pn * tstep : cB;
        for (int t = 0; t < nt; t += 2) {
            const bool last = (t == nt - 2);
            const char* a1 = cA + (size_t)(t + 1) * kstep;
            const char* a2 = last ? nA : cA + (size_t)(t + 2) * kstep; const char* b2 = last ? nB : cB + (size_t)(t + 2) * kstep;
            const char* a3 = a2 + kstep; const char* b3 = b2 + kstep;
            if (last && has_next) S.a_ready(nxt);
            if constexpr (SP2) {
            PG8_LDB(B0, 0, 0); PG8_LDB(B1, 0, 1); PG8_SCHED; PG8_LDA(At, 0, 0); PG8_STAGE(PG8_SA(1, 1), a1 + hstep, voffA);
            PG8_WAIT_V(8); PG8_WAIT_L(0); PG8_BAR; PG8_MMA(0, 0, At, B0); PG8_MMA(0, 1, At, B1); PG8_BAR; PG8_SCHED;
            PG8_LDA(At, 0, 1); PG8_STAGE(PG8_SB(0, 0), b2, voffB); PG8_STAGE(PG8_SB(0, 1), b2 + hstep, voffB); PG8_STAGE(PG8_SA(0, 0), a2, voffA);
            PG8_WAIT_V(8); PG8_WAIT_L(0); PG8_BAR; PG8_MMA(1, 0, At, B0); PG8_MMA(1, 1, At, B1); PG8_BAR; PG8_SCHED;
            PG8_LDB(B0, 1, 0); PG8_LDB(B1, 1, 1); PG8_SCHED; PG8_LDA(At, 1, 0); PG8_STAGE(PG8_SA(0, 1), a2 + hstep, voffA);
            PG8_WAIT_V(8); PG8_WAIT_L(0); PG8_BAR; PG8_MMA(0, 0, At, B0); PG8_MMA(0, 1, At, B1); PG8_BAR; PG8_SCHED;
            PG8_LDA(At, 1, 1); PG8_STAGE(PG8_SB(1, 0), b3, voffB); PG8_STAGE(PG8_SB(1, 1), b3 + hstep, voffB); PG8_STAGE(PG8_SA(1, 0), a3, voffA);
            PG8_WAIT_V(8); PG8_WAIT_L(0); PG8_BAR; PG8_MMA(1, 0, At, B0); PG8_MMA(1, 1, At, B1); PG8_BAR; PG8_SCHED;
            } else {
            PG8_LDB(B0, 0, 0); PG8_SCHED; PG8_LDA(At, 0, 0); PG8_STAGE(PG8_SA(1, 1), a1 + hstep, voffA);
            PG8_WAIT_L(8); PG8_BAR; PG8_WAIT_L(0); PG8_MMA(0, 0, At, B0); PG8_BAR; PG8_SCHED;
            PG8_LDB(B1, 0, 1); PG8_STAGE(PG8_SB(0, 0), b2, voffB);
            PG8_BAR; PG8_WAIT_L(0); PG8_MMA(0, 1, At, B1); PG8_BAR;
            PG8_LDA(At, 0, 1); PG8_STAGE(PG8_SA(0, 0), a2, voffA);
            PG8_BAR; PG8_WAIT_L(0); PG8_MMA(1, 0, At, B0); PG8_BAR; PG8_SCHED;
            PG8_STAGE(PG8_SB(0, 1), b2 + hstep, voffB);
            PG8_WAIT_V(6); PG8_BAR; PG8_MMA(1, 1, At, B1); PG8_BAR;
            PG8_LDB(B0, 1, 0); PG8_SCHED; PG8_LDA(At, 1, 0); PG8_STAGE(PG8_SA(0, 1), a2 + hstep, voffA);
            PG8_WAIT_L(8); PG8_BAR; PG8_WAIT_L(0); PG8_MMA(0, 0, At, B0); PG8_BAR; PG8_SCHED;
            PG8_LDB(B1, 1, 1); PG8_STAGE(PG8_SB(1, 0), b3, voffB);
            PG8_BAR; PG8_WAIT_L(0); PG8_MMA(0, 1, At, B1); PG8_BAR;
            PG8_LDA(At, 1, 1); PG8_STAGE(PG8_SA(1, 0), a3, voffA);
            PG8_BAR; PG8_WAIT_L(0); PG8_MMA(1, 0, At, B0); PG8_BAR; PG8_SCHED;
            PG8_STAGE(PG8_SB(1, 1), b3 + hstep, voffB);
            PG8_WAIT_V(6); PG8_BAR; PG8_MMA(1, 1, At, B1); PG8_BAR;
            }
        }
        if constexpr (ALIGN_EPI) { if (wr == 0) PG8_BAR; }
        if constexpr (!Epi::AFTER_DRAIN) { E(acc, cur, wr, wc, fr, fq); S.done(cur); }
        if (!has_next) break;
#pragma unroll
        for (int a = 0; a < 2; ++a)
#pragma unroll
            for (int b = 0; b < 2; ++b)
#pragma unroll
                for (int m = 0; m < 4; ++m)
#pragma unroll
                    for (int n = 0; n < 2; ++n) acc[a][b][m][n] = (f32x4){0.f, 0.f, 0.f, 0.f};
        cur = nxt; cA = nA; cB = nB; ++ui;
        if constexpr (ALIGN_EPI) { if (wr == 1) PG8_BAR; }
    }
    PG8_WAIT_V(0);
    if constexpr (!ALIGN_EPI) { if (wr == 0) PG8_BAR; }
    PG8_BAR;
    if constexpr (Epi::AFTER_DRAIN) { E.fused(acc, cur, wr, wc, fr, fq, lds, wid, lane); S.done(cur); }
#undef PG8_SA
#undef PG8_SB
#undef PG8_STAGE
#undef PG8_LDA
#undef PG8_LDB
#undef PG8_MMA
#undef PG8_WAIT_V
#undef PG8_WAIT_L
#undef PG8_BAR
#undef PG8_SCHED
}
}

#define LAS __attribute__((address_space(3)))
typedef unsigned short bf16;
typedef unsigned v4u __attribute__((ext_vector_type(4)));
typedef unsigned v2u __attribute__((ext_vector_type(2)));
typedef float f32x4 __attribute__((ext_vector_type(4)));
constexpr int NWAVES = 8, NTHR = 512;
constexpr int LDS_BYTES = 147456;

__device__ __forceinline__ unsigned f2bf(float f) { unsigned u = __builtin_bit_cast(unsigned, f); return (u + 0x7fffu + ((u >> 16) & 1u)) >> 16; }
__device__ __forceinline__ unsigned pk2(float lo, float hi) { return f2bf(lo) | (f2bf(hi) << 16); }
__device__ __forceinline__ float bflo(unsigned w) { return __builtin_bit_cast(float, w << 16); }
__device__ __forceinline__ float bfhi(unsigned w) { return __builtin_bit_cast(float, w & 0xffff0000u); }
__device__ __forceinline__ float bf2f(bf16 h) { return __builtin_bit_cast(float, (unsigned)h << 16); }
__device__ __forceinline__ float wave_sum(float v) {
#pragma unroll
    for (int o = 1; o < 64; o <<= 1) v += __shfl_xor(v, o);
    return v;
}
__device__ __forceinline__ float siluf(float x) { return x / (1.0f + __expf(-x)); }

struct Params { const void* in[29]; float* out; unsigned char* ws; int lo, hi; };
enum { I_X = 0, I_MEM, I_POS, I_LN1G, I_WIN, I_WGATE, I_BGATE, I_DAQN, I_DAKN, I_LQ1, I_LK1, I_LQ2, I_LK2, I_SUBLN, I_WODIFF, I_WCONV, I_ALOG, I_DTB, I_GDNN, I_WODELTA,
       I_MEMN, I_WMEMKV, I_CAQN, I_CAKN, I_WOCROSS, I_WOUT, I_LN2G, I_WMLP1, I_WMLP2 };

__device__ __forceinline__ void p0_transpose_item(const float* W, int ldw, int K, int src_col0, const float* kscale, bf16* WT, int dst_row0, int k0, float* scr, int lane) {
#pragma unroll 8
    for (int i = 0; i < 32; ++i) { const int kk = 2 * i + (lane >> 5); float v = W[(size_t)(k0 + kk) * ldw + src_col0 + (lane & 31)]; if (kscale) v *= kscale[k0 + kk]; scr[kk * 33 + (lane & 31)] = v; }
    __builtin_amdgcn_wave_barrier(); asm volatile("s_waitcnt lgkmcnt(0)" ::: "memory");
    const int c = lane & 7;
#pragma unroll
    for (int j = 0; j < 4; ++j) { const int n = (lane >> 3) + 8 * j; const float* s = scr + (8 * c) * 33 + n;
        v4u o; o.x = pk2(s[0 * 33], s[1 * 33]); o.y = pk2(s[2 * 33], s[3 * 33]); o.z = pk2(s[4 * 33], s[5 * 33]); o.w = pk2(s[6 * 33], s[7 * 33]);
        *(v4u*)(WT + (size_t)(dst_row0 + n) * K + k0 + 8 * c) = o; }
    asm volatile("s_waitcnt lgkmcnt(0)" ::: "memory"); __builtin_amdgcn_wave_barrier();
}

__device__ __forceinline__ void p0_prologue(const Params& P, unsigned char* lds, int tid, int lane, int wave) {
    const int G = gridDim.x, gw = blockIdx.x * NWAVES + wave, NGW = G * NWAVES;
    unsigned char* ws = P.ws;
    float* scr = (float*)(lds + wave * 8448);
    float* w12t = (float*)(lds + 73728);
    const float* w_in = (const float*)P.in[I_WIN];
    for (int i = tid; i < 12 * 1024; i += NTHR) { const int c = i >> 10, k = i & 1023; w12t[i] = w_in[(size_t)k * DIN + 5376 + c]; }
    {
        constexpr int I1 = 16 * 280, I2 = 12 * 32, I3 = 12 * 32, I4 = 8 * 32, I5 = 16 * 32, I6 = 16 * 128, I7 = 64 * 32, I8 = 16 * 32;
        constexpr int NITEMS = I1 + I2 + I3 + I4 + I5 + I6 + I7 + I8;
        for (int it = gw; it < NITEMS; it += NGW) {
            int r = it;
            if (r < I1) { const int kb = r / 280, g = r % 280, p0 = 32 * g;
                if (p0 < 5376) p0_transpose_item(w_in, DIN, 1024, p0, nullptr, (bf16*)(ws + WS_W1T), p0, 64 * kb, scr, lane);
                else if (p0 < 5888) p0_transpose_item(w_in, DIN, 1024, 5388 + (p0 - 5376), nullptr, (bf16*)(ws + WS_W1T), p0, 64 * kb, scr, lane);
                else p0_transpose_item((const float*)P.in[I_WGATE], NGATE, 1024, p0 - 5888, nullptr, (bf16*)(ws + WS_W1T), p0, 64 * kb, scr, lane);
                continue; } r -= I1;
            if (r < I2) { p0_transpose_item((const float*)P.in[I_WODIFF], 1024, 768, 32 * (r % 32), nullptr, (bf16*)(ws + WS_WOD), 32 * (r % 32), 64 * (r / 32), scr, lane); continue; } r -= I2;
            if (r < I3) { p0_transpose_item((const float*)P.in[I_WODELTA], 1024, 768, 32 * (r % 32), nullptr, (bf16*)(ws + WS_WODL), 32 * (r % 32), 64 * (r / 32), scr, lane); continue; } r -= I3;
            if (r < I4) { p0_transpose_item((const float*)P.in[I_WOCROSS], 1024, 512, 32 * (r % 32), nullptr, (bf16*)(ws + WS_WOC), 32 * (r % 32), 64 * (r / 32), scr, lane); continue; } r -= I4;
            if (r < I5) { p0_transpose_item((const float*)P.in[I_WOUT], 1024, 1024, 32 * (r % 32), nullptr, (bf16*)(ws + WS_WOUT), 32 * (r % 32), 64 * (r / 32), scr, lane); continue; } r -= I5;
            if (r < I6) { p0_transpose_item((const float*)P.in[I_WMLP1], DFF, 1024, 32 * (r % 128), (const float*)P.in[I_LN2G], (bf16*)(ws + WS_WM1), 32 * (r % 128), 64 * (r / 128), scr, lane); continue; } r -= I6;
            if (r < I7) { p0_transpose_item((const float*)P.in[I_WMLP2], 1024, DFF, 32 * (r % 32), nullptr, (bf16*)(ws + WS_WM2), 32 * (r % 32), 64 * (r / 32), scr, lane); continue; } r -= I7;
            p0_transpose_item((const float*)P.in[I_WMEMKV], 1024, 1024, 32 * (r % 32), nullptr, (bf16*)(ws + WS_WMEM), 32 * (r % 32), 64 * (r / 32), scr, lane);
        }
    }
    __syncthreads();
    {
        const float* x = (const float*)P.in[I_X]; const float* g1 = (const float*)P.in[I_LN1G];
        const float* alog = (const float*)P.in[I_ALOG]; const float* dtb = (const float*)P.in[I_DTB];
        bf16* HB = (bf16*)((unsigned char*)P.out + OUT_HB); float* BT = (float*)(ws + WS_BT); float* LA = (float*)(ws + WS_LA);
        f32x4 gv[4];
#pragma unroll
        for (int j = 0; j < 4; ++j) gv[j] = ((const f32x4*)g1)[lane + 64 * j];
        for (int m = gw; m < MTOK; m += NGW) {
            const f32x4* xr = (const f32x4*)(x + (size_t)m * DM) + lane;
            f32x4 v[4]; float s = 0.f;
#pragma unroll
            for (int j = 0; j < 4; ++j) { v[j] = xr[64 * j]; s += (v[j].x * v[j].x + v[j].y * v[j].y) + (v[j].z * v[j].z + v[j].w * v[j].w); }
            const float rstd = 1.0f / sqrtf(wave_sum(s) * (1.0f / DM) + EPS);
#pragma unroll
            for (int j = 0; j < 4; ++j) v[j] = (v[j] * rstd) * gv[j];
            unsigned long long* o8 = (unsigned long long*)(HB + (size_t)m * DM) + lane;
#pragma unroll
            for (int j = 0; j < 4; ++j) o8[64 * j] = (unsigned long long)pk2(v[j].x, v[j].y) | ((unsigned long long)pk2(v[j].z, v[j].w) << 32);
            float mine = 0.f;
#pragma unroll 1
            for (int c = 0; c < 12; ++c) { float p = 0.f;
#pragma unroll
                for (int j = 0; j < 4; ++j) { const f32x4 w = *(const f32x4*)(w12t + c * 1024 + 4 * lane + 256 * j); p += (v[j].x * w.x + v[j].y * w.y) + (v[j].z * w.z + v[j].w * w.w); }
                p = wave_sum(p); mine = (lane == c) ? p : mine; }
            if (lane < 6) BT[(size_t)m * 6 + lane] = 1.0f / (1.0f + expf(-mine));
            else if (lane < 12) { const int hh = lane - 6; const float z = mine + dtb[hh]; const float sp = (z > 20.f) ? z : log1pf(expf(z)); LA[(size_t)m * 6 + hh] = -expf(alog[hh]) * sp; }
        }
    }
    {
        const float* mem = (const float*)P.in[I_MEM]; const float* g = (const float*)P.in[I_MEMN]; bf16* MN = (bf16*)(ws + WS_MN);
        for (int m = gw; m < MEMROWS; m += NGW) {
            const f32x4* xr = (const f32x4*)(mem + (size_t)m * DM) + lane;
            f32x4 v[4]; float s = 0.f;
#pragma unroll
            for (int j = 0; j < 4; ++j) { v[j] = xr[64 * j]; s += (v[j].x * v[j].x + v[j].y * v[j].y) + (v[j].z * v[j].z + v[j].w * v[j].w); }
            const float rstd = 1.0f / sqrtf(wave_sum(s) * (1.0f / DM) + EPS);
            unsigned long long* o8 = (unsigned long long*)(MN + (size_t)m * DM) + lane;
#pragma unroll
            for (int j = 0; j < 4; ++j) { const f32x4 gg = ((const f32x4*)g)[lane + 64 * j]; const f32x4 y = (v[j] * rstd) * gg; o8[64 * j] = (unsigned long long)pk2(y.x, y.y) | ((unsigned long long)pk2(y.z, y.w) << 32); }
        }
    }
    {
        const int* pos = (const int*)P.in[I_POS]; float* RC = (float*)(ws + WS_ROPEC); float* RS = (float*)(ws + WS_ROPES); float* rowss = (float*)(ws + WS_ROWSS);
        const int gt = blockIdx.x * NTHR + tid, NGT = G * NTHR;
        for (int i = gt; i < MTOK * 32; i += NGT) { const int row = i >> 5, j = i & 31;
            const float inv = expf((-9.210340371976184f * (float)j) / 32.0f); const float ang = (float)pos[row] * inv;
            double rev = (double)ang * 0.15915494309189535; rev -= rint(rev); const float rf = (float)rev;
            RC[i] = __builtin_amdgcn_cosf(rf); RS[i] = __builtin_amdgcn_sinf(rf); }
        for (int i = gt; i < MTOK; i += NGT) rowss[i] = 0.f;
        if (blockIdx.x == 0 && wave == 0) {
            const float a = ((const float*)P.in[I_LQ1])[lane] * ((const float*)P.in[I_LK1])[lane], b = ((const float*)P.in[I_LQ2])[lane] * ((const float*)P.in[I_LK2])[lane];
            const float sa = wave_sum(a), sb = wave_sum(b);
            if (lane == 0) { ((float*)(ws + WS_MISC))[0] = expf(sa) - expf(sb) + LAM_INIT; ((int*)(ws + WS_MISC))[1] = 0; }
        }
    }
}

__device__ __forceinline__ void p2a_qknorm_rope(const Params& P, int lane, int wave) {
    const int gw = blockIdx.x * NWAVES + wave, NGW = gridDim.x * NWAVES;
    unsigned char* ws = P.ws; const float* RC = (const float*)(ws + WS_ROPEC); const float* RS = (const float*)(ws + WS_ROPES);
    const float* qg = (const float*)P.in[I_DAQN]; const float* kg = (const float*)P.in[I_DAKN];
    {
        const float* g = (const float*)P.in[I_CAKN];
        for (int it = gw; it < MEMROWS * 4; it += NGW) { unsigned* p = (unsigned*)((bf16*)(ws + WS_MKV) + (size_t)(it >> 2) * 1024 + (it & 3) * 128) + lane;
            const unsigned w = *p; float a = bflo(w), c = bfhi(w); const float ss = wave_sum(a * a + c * c); const float sc = 1.0f / sqrtf(ss * (1.0f / 128.0f) + EPS);
            *p = pk2(a * sc * g[2 * lane], c * sc * g[2 * lane + 1]); }
    }
    const int j = lane & 31;
    for (int row = gw; row < MTOK; row += NGW) {
        const float c = RC[(size_t)row * 32 + j], s = RS[(size_t)row * 32 + j];
#pragma unroll 4
        for (int i = 0; i < 12; ++i) { const int group = 2 * i + (lane >> 5); const bool isk = group >= 12; const int gg = isk ? group - 12 : group;
            bf16* p = (bf16*)(ws + (isk ? WS_DAK : WS_DAQ)) + (size_t)row * 768 + gg * 64 + j;
            const float x1 = bf2f(p[0]), x2 = bf2f(p[32]); float ss = x1 * x1 + x2 * x2;
#pragma unroll
            for (int o = 1; o < 32; o <<= 1) ss += __shfl_xor(ss, o);
            const float sc = 1.0f / sqrtf(ss * (1.0f / 64.0f) + EPS); const float* g = isk ? kg : qg;
            const float y1 = x1 * sc * g[j], y2 = x2 * sc * g[j + 32];
            float o1 = y1 * c - y2 * s, o2 = y2 * c + y1 * s;
            if (!isk) { o1 *= C2_DA; o2 *= C2_DA; }
            p[0] = (bf16)f2bf(o1); p[32] = (bf16)f2bf(o2); }
    }
}

template <bool CROSS>
__device__ __forceinline__ void attn_naive_unit(const Params& P, unsigned char* lds, int tid, int b, int h, int qc) {
    constexpr int NMAP = CROSS ? 1 : 2, DQ = CROSS ? 128 : 64;
    float* Qs = (float*)lds;
    float* Ks = Qs + 64 * 128;
    float* Vs = Ks + 64 * 129;
    float* As = Vs + 64 * 128;
    unsigned char* ws = P.ws;
    const int r = tid >> 3, c8 = tid & 7;
    const int ntiles = CROSS ? 4 : qc + 1;
    const size_t qrow = (size_t)b * SEQ + (size_t)qc * 64 + r;
    bf16* Qg; const bf16* Kg; const bf16* Vg; int ldq, ldk; size_t krow0;
    if (CROSS) { Qg = (bf16*)((unsigned char*)P.out + OUT_CAQ) + qrow * 512 + h * 128; ldq = 512; Kg = (const bf16*)(ws + WS_MKV) + h * 128; Vg = Kg + 512; ldk = 1024; krow0 = (size_t)b * NMEM; }
    else { Qg = (bf16*)(ws + WS_DAQ) + qrow * 768 + h * 128; ldq = 768; Kg = (const bf16*)(ws + WS_DAK) + h * 128; Vg = (const bf16*)(ws + WS_DAV) + h * 128; ldk = 768; krow0 = (size_t)b * SEQ; }
    (void)ldq;
    const float lam = CROSS ? 0.f : ((const float*)(ws + WS_MISC))[0];
    __syncthreads();
    {
        const v4u a = *(const v4u*)(Qg + c8 * 16), c = *(const v4u*)(Qg + c8 * 16 + 8);
        float q[16] = { bflo(a.x), bfhi(a.x), bflo(a.y), bfhi(a.y), bflo(a.z), bfhi(a.z), bflo(a.w), bfhi(a.w), bflo(c.x), bfhi(c.x), bflo(c.y), bfhi(c.y), bflo(c.z), bfhi(c.z), bflo(c.w), bfhi(c.w) };
        if (CROSS) { float ss = 0.f;
#pragma unroll
            for (int i = 0; i < 16; ++i) ss += q[i] * q[i];
            ss += __shfl_xor(ss, 1); ss += __shfl_xor(ss, 2); ss += __shfl_xor(ss, 4);
            const float sc = C2_CA / sqrtf(ss * (1.0f / 128.0f) + EPS); const float* g = (const float*)P.in[I_CAQN] + c8 * 16;
#pragma unroll
            for (int i = 0; i < 16; ++i) q[i] = q[i] * sc * g[i]; }
#pragma unroll
        for (int i = 0; i < 16; ++i) Qs[r * 128 + c8 * 16 + i] = q[i];
    }
    float mrun[NMAP], lrun[NMAP];
#pragma unroll
    for (int mp = 0; mp < NMAP; ++mp) { mrun[mp] = -1e30f; lrun[mp] = 0.f; }
    float o[16];
#pragma unroll
    for (int i = 0; i < 16; ++i) o[i] = 0.f;
    for (int pass = 0; pass < 2; ++pass) {
        for (int kt = 0; kt < ntiles; ++kt) {
            __syncthreads();
            {
                const size_t kr = krow0 + (size_t)kt * 64 + r;
                const v4u a = *(const v4u*)(Kg + kr * ldk + c8 * 16), c = *(const v4u*)(Kg + kr * ldk + c8 * 16 + 8);
                float k[16] = { bflo(a.x), bfhi(a.x), bflo(a.y), bfhi(a.y), bflo(a.z), bfhi(a.z), bflo(a.w), bfhi(a.w), bflo(c.x), bfhi(c.x), bflo(c.y), bfhi(c.y), bflo(c.z), bfhi(c.z), bflo(c.w), bfhi(c.w) };
                if (CROSS) { float ss = 0.f;
#pragma unroll
                    for (int i = 0; i < 16; ++i) ss += k[i] * k[i];
                    ss += __shfl_xor(ss, 1); ss += __shfl_xor(ss, 2); ss += __shfl_xor(ss, 4);
                    const float sc = 1.0f / sqrtf(ss * (1.0f / 128.0f) + EPS); const float* g = (const float*)P.in[I_CAKN] + c8 * 16;
#pragma unroll
                    for (int i = 0; i < 16; ++i) k[i] = k[i] * sc * g[i]; }
#pragma unroll
                for (int i = 0; i < 16; ++i) Ks[r * 129 + c8 * 16 + i] = k[i];
                if (pass == 1) {
                    const v4u va = *(const v4u*)(Vg + kr * ldk + c8 * 16), vc = *(const v4u*)(Vg + kr * ldk + c8 * 16 + 8);
                    float* vd = Vs + r * 128 + c8 * 16;
                    vd[0] = bflo(va.x); vd[1] = bfhi(va.x); vd[2] = bflo(va.y); vd[3] = bfhi(va.y); vd[4] = bflo(va.z); vd[5] = bfhi(va.z); vd[6] = bflo(va.w); vd[7] = bfhi(va.w);
                    vd[8] = bflo(vc.x); vd[9] = bfhi(vc.x); vd[10] = bflo(vc.y); vd[11] = bfhi(vc.y); vd[12] = bflo(vc.z); vd[13] = bfhi(vc.z); vd[14] = bflo(vc.w); vd[15] = bfhi(vc.w);
                }
            }
            __syncthreads();
            float sc[NMAP][8];
#pragma unroll
            for (int mp = 0; mp < NMAP; ++mp) {
#pragma unroll
                for (int i = 0; i < 8; ++i) sc[mp][i] = 0.f;
                for (int d = 0; d < DQ; ++d) { const float q = Qs[r * 128 + mp * DQ + d];
#pragma unroll
                    for (int i = 0; i < 8; ++i) sc[mp][i] += q * Ks[(c8 + 8 * i) * 129 + mp * DQ + d]; }
            }
            if (pass == 0) {
#pragma unroll
                for (int mp = 0; mp < NMAP; ++mp) { float tm = sc[mp][0];
#pragma unroll
                    for (int i = 1; i < 8; ++i) tm = fmaxf(tm, sc[mp][i]);
                    tm = fmaxf(tm, __shfl_xor(tm, 1)); tm = fmaxf(tm, __shfl_xor(tm, 2)); tm = fmaxf(tm, __shfl_xor(tm, 4));
                    const float mn = fmaxf(mrun[mp], tm); float ps = 0.f;
#pragma unroll
                    for (int i = 0; i < 8; ++i) ps += exp2f(sc[mp][i] - mn);
                    ps += __shfl_xor(ps, 1); ps += __shfl_xor(ps, 2); ps += __shfl_xor(ps, 4);
                    lrun[mp] = lrun[mp] * exp2f(mrun[mp] - mn) + ps; mrun[mp] = mn; }
            } else {
#pragma unroll
                for (int i = 0; i < 8; ++i) { float a = exp2f(sc[0][i] - mrun[0]) / lrun[0];
                    if (!CROSS) a -= lam * (exp2f(sc[NMAP - 1][i] - mrun[NMAP - 1]) / lrun[NMAP - 1]);
                    As[r * 65 + c8 + 8 * i] = a; }
                __syncthreads();
                for (int key = 0; key < 64; ++key) { const float a = As[r * 65 + key]; const float* vv = Vs + key * 128 + c8 * 16;
#pragma unroll
                    for (int i = 0; i < 16; ++i) o[i] += a * vv[i]; }
            }
        }
    }
    if (!CROSS) { float ss = 0.f;
#pragma unroll
        for (int i = 0; i < 16; ++i) ss += o[i] * o[i];
        ss += __shfl_xor(ss, 1); ss += __shfl_xor(ss, 2); ss += __shfl_xor(ss, 4);
        const float sc = (1.0f - LAM_INIT) / sqrtf(ss * (1.0f / 128.0f) + EPS); const float* g = (const float*)P.in[I_SUBLN] + c8 * 16;
#pragma unroll
        for (int i = 0; i < 16; ++i) o[i] = o[i] * sc * g[i]; }
    v4u w0, w1; w0.x = pk2(o[0], o[1]); w0.y = pk2(o[2], o[3]); w0.z = pk2(o[4], o[5]); w0.w = pk2(o[6], o[7]); w1.x = pk2(o[8], o[9]); w1.y = pk2(o[10], o[11]); w1.z = pk2(o[12], o[13]); w1.w = pk2(o[14], o[15]);
    *(v4u*)(Qg + c8 * 16) = w0; *(v4u*)(Qg + c8 * 16 + 8) = w1;
}

typedef short bf16x8 __attribute__((ext_vector_type(8)));
typedef short s16x4 __attribute__((ext_vector_type(4)));
typedef float f32x16 __attribute__((ext_vector_type(16)));
typedef __bf16 bf16x2_t __attribute__((ext_vector_type(2)));
typedef float f32x2_t __attribute__((ext_vector_type(2)));
#define MFMA32(a, b, c) __builtin_amdgcn_mfma_f32_32x32x16_bf16((a), (b), (c), 0, 0, 0)
__device__ __forceinline__ unsigned cvtpk(float lo, float hi) { f32x2_t v = {lo, hi}; bf16x2_t b = __builtin_convertvector(v, bf16x2_t); return __builtin_bit_cast(unsigned, b); }
__device__ __forceinline__ unsigned off_b(unsigned row, unsigned ch) { return 256u * row + 16u * (ch ^ (((row & 3u) << 2) | ((row >> 2) & 3u))); }
__device__ __forceinline__ s16x4 vtr(const unsigned char* p) { typedef short v4i16_t __attribute__((ext_vector_type(4))); return __builtin_bit_cast(s16x4, __builtin_amdgcn_ds_read_tr16_b64_v4i16((LAS v4i16_t*)p)); }
__device__ __forceinline__ bf16x8 pack8f(const f32x16& x, int s2) { v4u w; w.x = cvtpk(x[8 * s2], x[8 * s2 + 1]); w.y = cvtpk(x[8 * s2 + 2], x[8 * s2 + 3]); w.z = cvtpk(x[8 * s2 + 4], x[8 * s2 + 5]); w.w = cvtpk(x[8 * s2 + 6], x[8 * s2 + 7]); return __builtin_bit_cast(bf16x8, w); }

template <bool CROSS>
__device__ __forceinline__ void attn_mfma_unit(const Params& P, unsigned char* lds, int tid_in, int b, int h, int qb) {
    int tid = tid_in; asm volatile("" : "+v"(tid)); const int lane = tid & 63, wave = __builtin_amdgcn_readfirstlane(tid >> 6);
    constexpr int NKS = CROSS ? 8 : 4;
    unsigned char* ws = P.ws;
    const int r = lane & 31, hh = lane >> 5;
    const int mp = CROSS ? 0 : (wave & 1), qsub = CROSS ? wave : (wave >> 1);
    const int nt = CROSS ? 4 : 2 * qb + 2;
    const int my_nt = (!CROSS && qsub < 2) ? nt - 1 : nt;
    const bf16* Kg; const bf16* Vg; bf16* Qg; int ldk, ldq;
    if (CROSS) { Kg = (const bf16*)(ws + WS_MKV) + (size_t)b * NMEM * 1024 + h * 128; Vg = Kg + 512; ldk = 1024; Qg = (bf16*)((unsigned char*)P.out + OUT_CAQ) + ((size_t)b * SEQ + (size_t)qb * 256) * 512 + h * 128; ldq = 512; }
    else { Kg = (const bf16*)(ws + WS_DAK) + (size_t)b * SEQ * 768 + h * 128; Vg = (const bf16*)(ws + WS_DAV) + (size_t)b * SEQ * 768 + h * 128; ldk = 768; Qg = (bf16*)(ws + WS_DAQ) + ((size_t)b * SEQ + (size_t)qb * 128) * 768 + h * 128; ldq = 768; }
    const int srow = tid >> 3, sc = tid & 7;
    const unsigned so0 = off_b(srow, sc), so1 = off_b(srow, sc + 8);
    const bf16* kgp = Kg + (size_t)srow * ldk + sc * 8; const bf16* vgp = Vg + (size_t)srow * ldk + sc * 8;
    __syncthreads();
    bf16x8 qf[NKS];
    {
        const bf16* qp = Qg + (size_t)(qsub * 32 + r) * ldq + mp * 64 + 8 * hh;
#pragma unroll
        for (int s = 0; s < NKS; ++s) qf[s] = *(const bf16x8*)(qp + 16 * s);
        if (CROSS) {
            float ss = 0.f;
#pragma unroll
            for (int s = 0; s < NKS; ++s)
#pragma unroll
                for (int j = 0; j < 8; ++j) { const float v = bf2f((bf16)qf[s][j]); ss += v * v; }
            ss += __shfl_xor(ss, 32);
            const float scl = C2_CA / sqrtf(ss * (1.0f / 128.0f) + EPS); const float* g = (const float*)P.in[I_CAQN] + 8 * hh;
#pragma unroll
            for (int s = 0; s < NKS; ++s) { v4u w;
                float t[8];
#pragma unroll
                for (int j = 0; j < 8; ++j) t[j] = bf2f((bf16)qf[s][j]) * scl * g[16 * s + j];
                w.x = cvtpk(t[0], t[1]); w.y = cvtpk(t[2], t[3]); w.z = cvtpk(t[4], t[5]); w.w = cvtpk(t[6], t[7]); qf[s] = __builtin_bit_cast(bf16x8, w); }
        }
    }
    {
        const v4u k0 = *(const v4u*)kgp, k1 = *(const v4u*)(kgp + 64), v0 = *(const v4u*)vgp, v1 = *(const v4u*)(vgp + 64);
        *(v4u*)(lds + so0) = k0; *(v4u*)(lds + so1) = k1; *(v4u*)(lds + 16384 + so0) = v0; *(v4u*)(lds + 16384 + so1) = v1;
    }
    unsigned kaddr[NKS], vaddr[2][4];
    { const unsigned X = ((r & 3u) << 2) | ((r >> 2) & 3u);
#pragma unroll
      for (int s = 0; s < NKS; ++s) kaddr[s] = 256u * r + 16u * ((unsigned)(8 * mp + 2 * s + hh) ^ X);
      const unsigned blk = (lane >> 4) & 1, q = (lane & 15) >> 2, p = lane & 3;
#pragma unroll
      for (int t = 0; t < 2; ++t)
#pragma unroll
          for (int db = 0; db < 4; ++db) vaddr[t][db] = 256u * (8 * t + 4 * hh + q) + 16u * ((((unsigned)db ^ q) << 2) | ((2 * blk + (p >> 1)) ^ ((2 * t + hh) & 3u))) + 8u * (p & 1); }
    f32x16 ot[4];
#pragma unroll
    for (int db = 0; db < 4; ++db)
#pragma unroll
        for (int i = 0; i < 16; ++i) ot[db][i] = 0.f;
    float m_run = -1e30f, l_run = 0.f;
    __syncthreads();
#pragma unroll 1
    for (int kt = 0; kt < nt; ++kt) {
        const int cur = kt & 1; const bool more = kt + 1 < nt;
        v4u nk0, nk1, nv0, nv1;
        if (more) { const size_t go = (size_t)(kt + 1) * 64 * ldk; nk0 = *(const v4u*)(kgp + go); nk1 = *(const v4u*)(kgp + go + 64); nv0 = *(const v4u*)(vgp + go); nv1 = *(const v4u*)(vgp + go + 64); }
        if (kt < my_nt) {
            const unsigned char* kb_ = lds + cur * 32768; const unsigned char* vb_ = kb_ + 16384;
            f32x16 st0, st1;
#pragma unroll
            for (int i = 0; i < 16; ++i) { st0[i] = 0.f; st1[i] = 0.f; }
#pragma unroll
            for (int s = 0; s < NKS; ++s) { const bf16x8 a0 = *(const bf16x8*)(kb_ + kaddr[s]), a1 = *(const bf16x8*)(kb_ + 8192 + kaddr[s]); st0 = MFMA32(a0, qf[s], st0); st1 = MFMA32(a1, qf[s], st1); }
            float tm = fmaxf(st0[0], st1[0]);
#pragma unroll
            for (int i = 1; i < 16; ++i) tm = fmaxf(tm, fmaxf(st0[i], st1[i]));
            tm = fmaxf(tm, __shfl_xor(tm, 32));
            const float m_new = fmaxf(m_run, tm), alpha = exp2f(m_run - m_new); m_run = m_new;
            float ps = 0.f;
#pragma unroll
            for (int i = 0; i < 16; ++i) { st0[i] = exp2f(st0[i] - m_new); st1[i] = exp2f(st1[i] - m_new); ps += st0[i] + st1[i]; }
            l_run = l_run * alpha + ps;
#pragma unroll
            for (int db = 0; db < 4; ++db)
#pragma unroll
                for (int i = 0; i < 16; ++i) ot[db][i] *= alpha;
            bf16x8 pf[2][2];
            pf[0][0] = pack8f(st0, 0); pf[0][1] = pack8f(st0, 1); pf[1][0] = pack8f(st1, 0); pf[1][1] = pack8f(st1, 1);
#pragma unroll
            for (int db = 0; db < 4; ++db)
#pragma unroll
                for (int kb = 0; kb < 2; ++kb)
#pragma unroll
                    for (int s2 = 0; s2 < 2; ++s2) { const s16x4 lo = vtr(vb_ + vaddr[0][db] + 8192 * kb + 4096 * s2), hi = vtr(vb_ + vaddr[1][db] + 8192 * kb + 4096 * s2);
                        const bf16x8 vf = __builtin_shufflevector(lo, hi, 0, 1, 2, 3, 4, 5, 6, 7); ot[db] = MFMA32(vf, pf[kb][s2], ot[db]); }
        }
        if (more) { unsigned char* nb = lds + (cur ^ 1) * 32768; *(v4u*)(nb + so0) = nk0; *(v4u*)(nb + so1) = nk1; *(v4u*)(nb + 16384 + so0) = nv0; *(v4u*)(nb + 16384 + so1) = nv1; }
        __syncthreads();
    }
    l_run += __shfl_xor(l_run, 32);
    const float rl = 1.0f / l_run;
    bf16* Og = Qg + (size_t)(qsub * 32 + r) * ldq;
    if (CROSS) {
#pragma unroll
        for (int db = 0; db < 4; ++db)
#pragma unroll
            for (int g = 0; g < 4; ++g) { v2u w; w.x = cvtpk(ot[db][4 * g] * rl, ot[db][4 * g + 1] * rl); w.y = cvtpk(ot[db][4 * g + 2] * rl, ot[db][4 * g + 3] * rl);
                *(v2u*)(Og + 32 * db + 8 * g + 4 * hh) = w; }
    } else {
        float* xch = (float*)(lds + 65536) + (wave >> 1) * 4096;
        const float lam = ((const float*)(ws + WS_MISC))[0];
        if (mp == 1) {
            const float f = rl * lam;
#pragma unroll
            for (int db = 0; db < 4; ++db)
#pragma unroll
                for (int i = 0; i < 16; ++i) xch[(db * 16 + i) * 64 + lane] = ot[db][i] * f;
        }
        __syncthreads();
        if (mp == 0) {
            float ss = 0.f;
#pragma unroll
            for (int db = 0; db < 4; ++db)
#pragma unroll
                for (int i = 0; i < 16; ++i) { const float v = ot[db][i] * rl - xch[(db * 16 + i) * 64 + lane]; ot[db][i] = v; ss += v * v; }
            ss += __shfl_xor(ss, 32);
            const float scl = (1.0f - LAM_INIT) / sqrtf(ss * (1.0f / 128.0f) + EPS); const float* gp = (const float*)P.in[I_SUBLN] + 4 * hh;
#pragma unroll
            for (int db = 0; db < 4; ++db)
#pragma unroll
                for (int g = 0; g < 4; ++g) { const f32x4 gg = *(const f32x4*)(gp + 32 * db + 8 * g);
                    v2u w; w.x = cvtpk(ot[db][4 * g] * scl * gg.x, ot[db][4 * g + 1] * scl * gg.y); w.y = cvtpk(ot[db][4 * g + 2] * scl * gg.z, ot[db][4 * g + 3] * scl * gg.w);
                    *(v2u*)(Og + 32 * db + 8 * g + 4 * hh) = w; }
        }
    }
}

__device__ __forceinline__ void gdn_naive_unit(const Params& P, unsigned char* lds, int tid, int lane, int wave, int b, int hh) {
    float* X = (float*)lds;
    float* Os = X + 64 * 384;
    unsigned char* ws = P.ws;
    const float* wconv = (const float*)P.in[I_WCONV]; const float* BT = (const float*)(ws + WS_BT); const float* LA = (const float*)(ws + WS_LA);
    const float* gng = (const float*)P.in[I_GDNN];
    const int el = lane & 15, dg = lane >> 4, e = wave * 16 + el;
    float S[32];
#pragma unroll
    for (int i = 0; i < 32; ++i) S[i] = 0.f;
    for (int ch = 0; ch < SEQ / 64; ++ch) {
        const int t0 = ch * 64;
        __syncthreads();
        for (int idx = tid; idx < 64 * 384; idx += NTHR) { const int t = idx / 384, c = idx - t * 384, sec = c >> 7, cc = c & 127;
            const bf16* src = (const bf16*)(ws + WS_GQ + (size_t)sec * WS_SEC) + hh * 128 + cc; const float* wc = wconv + sec * 768 + hh * 128 + cc;
            float acc = 0.f;
#pragma unroll
            for (int tap = 0; tap < 4; ++tap) { const int tt = t0 + t - 3 + tap; if (tt >= 0) acc += wc[tap * 2304] * bf2f(src[((size_t)b * SEQ + tt) * 768]); }
            X[idx] = siluf(acc); }
        __syncthreads();
        {
            const int rr = tid >> 2, c4 = tid & 3, t = rr & 63, sec = rr >> 6; float* p = X + t * 384 + sec * 128 + c4 * 32; float ss = 0.f;
#pragma unroll
            for (int i = 0; i < 32; ++i) ss += p[i] * p[i];
            ss += __shfl_xor(ss, 1); ss += __shfl_xor(ss, 2);
            const float sc = (sec == 0 ? 0.08838834764831845f : 1.0f) / sqrtf(ss + EPS);
#pragma unroll
            for (int i = 0; i < 32; ++i) p[i] *= sc;
        }
        __syncthreads();
        for (int tl = 0; tl < 64; ++tl) { const size_t row = (size_t)b * SEQ + t0 + tl;
            const float beta = BT[row * 6 + hh], alpha = expf(LA[row * 6 + hh]);
            const float* xr = X + tl * 384; const float v = xr[256 + e];
            float kk[32], ks = 0.f;
#pragma unroll
            for (int i = 0; i < 32; ++i) { kk[i] = xr[128 + dg * 32 + i]; ks += kk[i] * S[i]; }
            ks += __shfl_xor(ks, 16); ks += __shfl_xor(ks, 32);
            const float cf = beta * (v - alpha * ks); float oo = 0.f;
#pragma unroll
            for (int i = 0; i < 32; ++i) { S[i] = alpha * S[i] + kk[i] * cf; oo += xr[dg * 32 + i] * S[i]; }
            oo += __shfl_xor(oo, 16); oo += __shfl_xor(oo, 32);
            if (dg == 0) Os[tl * 128 + e] = oo; }
        __syncthreads();
        {
            const int r = tid >> 3, c8 = tid & 7; const float* op = Os + r * 128 + c8 * 16; float ss = 0.f;
#pragma unroll
            for (int i = 0; i < 16; ++i) ss += op[i] * op[i];
            ss += __shfl_xor(ss, 1); ss += __shfl_xor(ss, 2); ss += __shfl_xor(ss, 4);
            const float sc = 1.0f / sqrtf(ss * (1.0f / 128.0f) + EPS);
            bf16* zp = (bf16*)(ws + WS_GZ) + ((size_t)b * SEQ + t0 + r) * 768 + hh * 128 + c8 * 16;
            const v4u za = *(const v4u*)zp, zc = *(const v4u*)(zp + 8);
            const float z[16] = { bflo(za.x), bfhi(za.x), bflo(za.y), bfhi(za.y), bflo(za.z), bfhi(za.z), bflo(za.w), bfhi(za.w), bflo(zc.x), bfhi(zc.x), bflo(zc.y), bfhi(zc.y), bflo(zc.z), bfhi(zc.z), bflo(zc.w), bfhi(zc.w) };
            float y[16];
#pragma unroll
            for (int i = 0; i < 16; ++i) y[i] = op[i] * sc * gng[c8 * 16 + i] * siluf(z[i]);
            v4u w0, w1; w0.x = pk2(y[0], y[1]); w0.y = pk2(y[2], y[3]); w0.z = pk2(y[4], y[5]); w0.w = pk2(y[6], y[7]); w1.x = pk2(y[8], y[9]); w1.y = pk2(y[10], y[11]); w1.z = pk2(y[12], y[13]); w1.w = pk2(y[14], y[15]);
            *(v4u*)zp = w0; *(v4u*)(zp + 8) = w1;
        }
    }
}

constexpr size_t OUT_NW = 0, OUT_QKM = 48 * MiB;
__device__ __forceinline__ int kperm16(int d) { return (d & ~12) | ((d & 4) << 1) | ((d & 8) >> 1); }
__device__ __forceinline__ void gdn_intra_unit(const Params& P, unsigned char* lds, int tid_in, int b, int hh, int n) {
    int tid = tid_in; asm volatile("" : "+v"(tid)); const int lane = tid & 63, wave = __builtin_amdgcn_readfirstlane(tid >> 6);
    unsigned char* ws = P.ws; unsigned char* outb = (unsigned char*)P.out;
    bf16* RAW = (bf16*)lds;
    float* RHS = (float*)lds;
    unsigned char* QS = lds + 65536;
    unsigned char* KS = lds + 81920;
    float* AM = (float*)(lds + 98304);
    float* WC = (float*)(lds + 114688);
    float* GB = (float*)(lds + 120832);
    const int t0 = n * 64; const size_t row0 = (size_t)b * SEQ + t0; const int gci = b * (SEQ / 64) + n;
    float* LA = (float*)(ws + WS_LA); const float* BT = (const float*)(ws + WS_BT);
    __syncthreads();
    for (int it = tid; it < 67 * 48; it += NTHR) { const int i = it / 48, ch = it - i * 48, sec = ch >> 4, c16 = ch & 15;
        v4u v = {0u, 0u, 0u, 0u};
        if (i >= 3) v = *(const v4u*)((const bf16*)(ws + WS_GQ + (size_t)sec * WS_SEC) + (row0 + i - 3) * 768 + hh * 128 + c16 * 8);
        else if (n > 0) v = *(const v4u*)((const bf16*)(ws + WS_HALO) + ((size_t)(gci - 1) * 3 + i) * 2304 + sec * 768 + hh * 128 + c16 * 8);
        *(v4u*)(RAW + i * 384 + sec * 128 + c16 * 8) = v; }
    if (tid < 384) { const float* wconv = (const float*)P.in[I_WCONV] + (tid >> 7) * 768 + hh * 128 + (tid & 127);
#pragma unroll
        for (int tap = 0; tap < 4; ++tap) WC[tap * 384 + tid] = wconv[tap * 2304]; }
    if (wave == 7) { float g = LA[(row0 + lane) * 6 + hh];
#pragma unroll
        for (int o = 1; o < 64; o <<= 1) { const float t = __shfl_up(g, o); if (lane >= o) g += t; }
        GB[lane] = g; GB[64 + lane] = BT[(row0 + lane) * 6 + hh]; LA[(row0 + lane) * 6 + hh] = g;
        if (lane == 63) ((float*)(ws + WS_MISC))[64 + gci * 6 + hh] = __expf(g); }
    __syncthreads();
    const int tk = tid >> 3, c8 = tid & 7;
    float xq[16], xk[16], xv[16];
    {
#pragma unroll
        for (int sec = 0; sec < 3; ++sec) { float acc[16];
#pragma unroll
            for (int i = 0; i < 16; ++i) acc[i] = 0.f;
#pragma unroll
            for (int tap = 0; tap < 4; ++tap) { const bf16* rp = RAW + (tk + tap) * 384 + sec * 128 + c8 * 16; const float* wp = WC + tap * 384 + sec * 128 + c8 * 16;
                const v4u a = *(const v4u*)rp, c = *(const v4u*)(rp + 8);
                const float xr[16] = { bflo(a.x), bfhi(a.x), bflo(a.y), bfhi(a.y), bflo(a.z), bfhi(a.z), bflo(a.w), bfhi(a.w), bflo(c.x), bfhi(c.x), bflo(c.y), bfhi(c.y), bflo(c.z), bfhi(c.z), bflo(c.w), bfhi(c.w) };
#pragma unroll
                for (int i = 0; i < 16; ++i) acc[i] += wp[i] * xr[i]; }
#pragma unroll
            for (int i = 0; i < 16; ++i) { const float y = siluf(acc[i]); if (sec == 0) xq[i] = y; else if (sec == 1) xk[i] = y; else xv[i] = y; } }
        float sq = 0.f, sk = 0.f;
#pragma unroll
        for (int i = 0; i < 16; ++i) { sq += xq[i] * xq[i]; sk += xk[i] * xk[i]; }
        sq += __shfl_xor(sq, 1); sq += __shfl_xor(sq, 2); sq += __shfl_xor(sq, 4); sk += __shfl_xor(sk, 1); sk += __shfl_xor(sk, 2); sk += __shfl_xor(sk, 4);
        const float scq = 0.08838834764831845f / sqrtf(sq + EPS), sck = 1.0f / sqrtf(sk + EPS);
#pragma unroll
        for (int i = 0; i < 16; ++i) { xq[i] *= scq; xk[i] *= sck; }
    }
    const float g_c = GB[tk], g_l = GB[63], bt_c = GB[64 + tk];
    const float eg = __expf(g_c), ekd = __expf(g_l - g_c);
    {
        v4u w0, w1;
        w0.x = pk2(xq[0], xq[1]); w0.y = pk2(xq[2], xq[3]); w0.z = pk2(xq[4], xq[5]); w0.w = pk2(xq[6], xq[7]); w1.x = pk2(xq[8], xq[9]); w1.y = pk2(xq[10], xq[11]); w1.z = pk2(xq[12], xq[13]); w1.w = pk2(xq[14], xq[15]);
        *(v4u*)(QS + off_b(tk, 2 * c8)) = w0; *(v4u*)(QS + off_b(tk, 2 * c8 + 1)) = w1;
        w0.x = pk2(xk[0], xk[1]); w0.y = pk2(xk[2], xk[3]); w0.z = pk2(xk[4], xk[5]); w0.w = pk2(xk[6], xk[7]); w1.x = pk2(xk[8], xk[9]); w1.y = pk2(xk[10], xk[11]); w1.z = pk2(xk[12], xk[13]); w1.w = pk2(xk[14], xk[15]);
        *(v4u*)(KS + off_b(tk, 2 * c8)) = w0; *(v4u*)(KS + off_b(tk, 2 * c8 + 1)) = w1;
        bf16* gq = (bf16*)(ws + WS_GQ) + (row0 + tk) * 768 + hh * 128 + c8 * 16; bf16* gk = (bf16*)(ws + WS_GK) + (row0 + tk) * 768 + hh * 128 + c8 * 16;
        w0.x = pk2(xq[0] * eg, xq[1] * eg); w0.y = pk2(xq[2] * eg, xq[3] * eg); w0.z = pk2(xq[8] * eg, xq[9] * eg); w0.w = pk2(xq[10] * eg, xq[11] * eg);
        w1.x = pk2(xq[4] * eg, xq[5] * eg); w1.y = pk2(xq[6] * eg, xq[7] * eg); w1.z = pk2(xq[12] * eg, xq[13] * eg); w1.w = pk2(xq[14] * eg, xq[15] * eg);
        *(v4u*)gq = w0; *(v4u*)(gq + 8) = w1;
        w0.x = pk2(xk[0] * ekd, xk[1] * ekd); w0.y = pk2(xk[2] * ekd, xk[3] * ekd); w0.z = pk2(xk[4] * ekd, xk[5] * ekd); w0.w = pk2(xk[6] * ekd, xk[7] * ekd);
        w1.x = pk2(xk[8] * ekd, xk[9] * ekd); w1.y = pk2(xk[10] * ekd, xk[11] * ekd); w1.z = pk2(xk[12] * ekd, xk[13] * ekd); w1.w = pk2(xk[14] * ekd, xk[15] * ekd);
        *(v4u*)gk = w0; *(v4u*)(gk + 8) = w1;
    }
    __syncthreads();
    {
        float* rp = RHS + tk * 256 + c8 * 16; const float kb = bt_c * eg;
#pragma unroll
        for (int i = 0; i < 16; i += 4) { *(f32x4*)(rp + i) = (f32x4){xv[i] * bt_c, xv[i + 1] * bt_c, xv[i + 2] * bt_c, xv[i + 3] * bt_c};
            *(f32x4*)(rp + 128 + i) = (f32x4){xk[i] * kb, xk[i + 1] * kb, xk[i + 2] * kb, xk[i + 3] * kb}; }
    }
    __syncthreads();
    {
        const int which = wave >> 2, ti = (wave >> 1) & 1, tj = wave & 1, r = lane & 31, h5 = lane >> 5;
        f32x16 acc;
#pragma unroll
        for (int i = 0; i < 16; ++i) acc[i] = 0.f;
        if (ti >= tj) {
            const unsigned char* Ab = (which ? QS : KS) + 8192 * ti; const unsigned char* Bb = KS + 8192 * tj;
            const unsigned X = ((r & 3u) << 2) | ((r >> 2) & 3u);
#pragma unroll
            for (int s = 0; s < 8; ++s) { const unsigned o = 256u * r + 16u * ((unsigned)(2 * s + h5) ^ X); acc = MFMA32(*(const bf16x8*)(Ab + o), *(const bf16x8*)(Bb + o), acc); }
        }
        const int j = 32 * tj + r; const float g_j = GB[j];
        if (which == 0) {
            if (ti >= tj) {
#pragma unroll
                for (int i = 0; i < 16; ++i) { const int c = 32 * ti + (i & 3) + 8 * (i >> 2) + 4 * h5; AM[c * 64 + j] = (c > j) ? GB[64 + c] * acc[i] * __expf(GB[c] - g_j) : 0.f; }
            }
        } else {
            bf16* qkm = (bf16*)(outb + OUT_QKM) + ((size_t)gci * 6 + hh) * 4096; const int jp = (j & ~15) | kperm16(j & 15);
#pragma unroll
            for (int i = 0; i < 16; ++i) { const int c = 32 * ti + (i & 3) + 8 * (i >> 2) + 4 * h5; const float v = (c >= j) ? acc[i] * __expf(GB[c] - g_j) : 0.f; qkm[c * 64 + jp] = (bf16)f2bf(v); }
        }
    }
    __syncthreads();
    if (wave < 4) {
        int tid4 = tid; asm volatile("" : "+v"(tid4)); const int lane = tid4 & 63;
        const int col = 64 * wave + lane;
        int lz = 0; asm volatile("" : "+v"(lz));
        const float* AMl = AM + lz;
        float x[64];
#pragma unroll
        for (int i = 0; i < 64; ++i) { float a = RHS[i * 256 + col];
#pragma unroll
            for (int j4 = 0; j4 < (i + 3) / 4; ++j4) { const f32x4 av = *(const f32x4*)(AMl + i * 64 + 4 * j4);
                if (4 * j4 + 0 < i) a -= av.x * x[4 * j4 + 0];
                if (4 * j4 + 1 < i) a -= av.y * x[4 * j4 + 1];
                if (4 * j4 + 2 < i) a -= av.z * x[4 * j4 + 2];
                if (4 * j4 + 3 < i) a -= av.w * x[4 * j4 + 3]; }
            x[i] = a; }
        if (wave < 2) {
            const int e = col, ew = e >> 5, r = e & 31;
            bf16* gv = (bf16*)(ws + WS_GV) + row0 * 768 + hh * 128;
#pragma unroll
            for (int i4 = 0; i4 < 16; ++i4) { const int i = 4 * i4, cb = i >> 5, g = (i & 31) >> 3, h = (i >> 2) & 1;
                const int idx = ((((ew * 2 + cb) * 4 + g) * 64) + h * 32 + r) * 4;
                v2u w; w.x = pk2(x[i], x[i + 1]); w.y = pk2(x[i + 2], x[i + 3]);
                *(v2u*)(gv + (size_t)(idx >> 7) * 768 + (idx & 127)) = w; }
        } else {
            const int d = col - 128; bf16* nw = (bf16*)(outb + OUT_NW) + row0 * 768 + hh * 128 + ((d & ~15) | kperm16(d & 15));
#pragma unroll
            for (int i = 0; i < 64; ++i) nw[(size_t)i * 768] = (bf16)f2bf(-x[i]);
        }
    }
}

__device__ __forceinline__ void mk_kx(int lane, unsigned (&kx)[8]) { const unsigned r = lane & 31, h5 = lane >> 5, X = ((r & 3u) << 2) | ((r >> 2) & 3u);
#pragma unroll
    for (int k = 0; k < 8; ++k) kx[k] = 256u * r + 16u * ((unsigned)(2 * k + h5) ^ X); }
__device__ __forceinline__ void mk_qkx(int lane, unsigned (&qkx)[4]) { const unsigned r = lane & 31, h5 = lane >> 5, ir = r >> 1, X2 = ((ir & 3u) << 2) | ((ir >> 2) & 3u);
#pragma unroll
    for (int k = 0; k < 4; ++k) qkx[k] = 256u * ir + 16u * ((unsigned)(8 * (r & 1) + 2 * k + h5) ^ X2); }
__device__ __forceinline__ void mk_vaddr(int lane, unsigned (&vaddr)[2][4]) { const unsigned h5 = lane >> 5, blk = (lane >> 4) & 1, q = (lane & 15) >> 2, p = lane & 3;
#pragma unroll
    for (int t = 0; t < 2; ++t)
#pragma unroll
        for (int db = 0; db < 4; ++db) vaddr[t][db] = 256u * (8 * t + 4 * h5 + q) + 16u * ((((unsigned)db ^ q) << 2) | ((2 * blk + (p >> 1)) ^ ((2 * t + h5) & 3u))) + 8u * (p & 1); }
__device__ __forceinline__ void gdn_scan_unit(const Params& P, unsigned char* lds, int tid_in, int b, int hh) {
    int tid = tid_in; asm volatile("" : "+v"(tid)); const int lane = tid & 63, wave = __builtin_amdgcn_readfirstlane(tid >> 6);
    unsigned char* ws = P.ws; unsigned char* outb = (unsigned char*)P.out;
    constexpr int BUFB = 57344, O_NW = 0, O_QD = 16384, O_KD = 32768, O_QK = 49152;
    LAS unsigned char* lds3 = (LAS unsigned char*)lds;
    const size_t rowb = (size_t)b * SEQ;
    const bf16* gNW = (const bf16*)(outb + OUT_NW) + rowb * 768 + hh * 128; const bf16* gQD = (const bf16*)(ws + WS_GQ) + rowb * 768 + hh * 128; const bf16* gKD = (const bf16*)(ws + WS_GK) + rowb * 768 + hh * 128;
    const bf16* gU = (const bf16*)(ws + WS_GV) + rowb * 768 + hh * 128; const bf16* gQK = (const bf16*)(outb + OUT_QKM) + ((size_t)(b * (SEQ / 64)) * 6 + hh) * 4096;
    const float* CD = (const float*)(ws + WS_MISC) + 64 + (size_t)(b * (SEQ / 64)) * 6 + hh;
    bf16* gZ = (bf16*)(ws + WS_GZ) + rowb * 768 + hh * 128;
    unsigned gsrc[4], gsrcq[2];
    const unsigned st_ = tid & 255;
#pragma unroll
    for (int i = 0; i < 4; ++i) { const unsigned p = i * 256 + st_, row = p >> 4, ch = (p & 15u) ^ (((row & 3u) << 2) | ((row >> 2) & 3u)); gsrc[i] = (row * 768 + ch * 8) * 2; }
#pragma unroll
    for (int i = 0; i < 2; ++i) { const unsigned p = i * 256 + st_, ir = p >> 4, c16 = (p & 15u) ^ (((ir & 3u) << 2) | ((ir >> 2) & 3u)); gsrcq[i] = ((2 * ir + (c16 >> 3)) * 64 + (c16 & 7) * 8) * 2; }
    const unsigned ldsw = (unsigned)(wave & 3) * 1024u;
#define GDN_DMA(bufoff, n_) do { const size_t go_ = (size_t)(n_) * 64 * 768 * 2; \
        _Pragma("unroll") for (int i_ = 0; i_ < 4; ++i_) { \
            __builtin_amdgcn_global_load_lds((const unsigned*)((const char*)gNW + go_ + gsrc[i_]), (LAS unsigned*)(lds3 + (bufoff) + O_NW + i_ * 4096 + ldsw), 16, 0, 0); \
            __builtin_amdgcn_global_load_lds((const unsigned*)((const char*)gQD + go_ + gsrc[i_]), (LAS unsigned*)(lds3 + (bufoff) + O_QD + i_ * 4096 + ldsw), 16, 0, 0); \
            __builtin_amdgcn_global_load_lds((const unsigned*)((const char*)gKD + go_ + gsrc[i_]), (LAS unsigned*)(lds3 + (bufoff) + O_KD + i_ * 4096 + ldsw), 16, 0, 0); } \
        _Pragma("unroll") for (int i_ = 0; i_ < 2; ++i_) \
            __builtin_amdgcn_global_load_lds((const unsigned*)((const char*)gQK + (size_t)(n_) * 6 * 4096 * 2 + gsrcq[i_]), (LAS unsigned*)(lds3 + (bufoff) + O_QK + i_ * 4096 + ldsw), 16, 0, 0); } while (0)
    const int r = lane & 31, h5 = lane >> 5;
    __syncthreads();
    if (wave < 4) GDN_DMA(0, 0);
    const float cdv0 = CD[(size_t)lane * 6], cdv1 = CD[(size_t)(64 + lane) * 6];
    f32x16 S[4];
#pragma unroll
    for (int db = 0; db < 4; ++db)
#pragma unroll
        for (int i = 0; i < 16; ++i) S[db][i] = 0.f;
    const int ew = wave & 3;
    bf16* Ob = (bf16*)(lds + 2 * BUFB);
    unsigned char* Ub = lds + 2 * BUFB + 16384;
    const int ht = tid & 255, hr = ht >> 2, c4 = ht & 3;
    const bf16* gUh = gU + (size_t)(ht >> 2) * 768 + (ht & 3) * 32;
    if (wave >= 4) {
#pragma unroll
        for (int i = 0; i < 4; ++i) *(v4u*)(Ub + ht * 64 + 16 * i) = *(const v4u*)(gUh + 8 * i);
    }
    __syncthreads();
#define SYNC_B() asm volatile("s_waitcnt lgkmcnt(0)\n\ts_barrier" ::: "memory")
#define SYNC_A() asm volatile("s_waitcnt vmcnt(0) lgkmcnt(0)\n\ts_barrier" ::: "memory")
    if (wave < 4) {
#pragma unroll 1
        for (int n = 0; n <= SEQ / 64; ++n) {
            const int cur = n & 1; const bool more = n + 1 < SEQ / 64, act = n < SEQ / 64;
            unsigned char* cb_ = lds + cur * BUFB;
            if (more) { if (cur) GDN_DMA(0, n + 1); else GDN_DMA(BUFB, n + 1); }
            bf16x8 vb[2][2];
            if (act) {
                int l1 = lane; asm volatile("" : "+v"(l1)); unsigned kx[8]; mk_kx(l1, kx);
                f32x16 vn0, vn1;
#pragma unroll
                for (int g = 0; g < 4; ++g) { const v2u w0 = *(const v2u*)(Ub + (((ew * 8 + g) * 64) + lane) * 8), w1 = *(const v2u*)(Ub + (((ew * 8 + 4 + g) * 64) + lane) * 8);
                    vn0[4 * g] = bflo(w0.x); vn0[4 * g + 1] = bfhi(w0.x); vn0[4 * g + 2] = bflo(w0.y); vn0[4 * g + 3] = bfhi(w0.y);
                    vn1[4 * g] = bflo(w1.x); vn1[4 * g + 1] = bfhi(w1.x); vn1[4 * g + 2] = bflo(w1.y); vn1[4 * g + 3] = bfhi(w1.y); }
#pragma unroll
                for (int db = 0; db < 4; ++db)
#pragma unroll
                    for (int s = 0; s < 2; ++s) { const bf16x8 sb = pack8f(S[db], s);
                        vn0 = MFMA32(*(const bf16x8*)(cb_ + O_NW + kx[2 * db + s]), sb, vn0); vn1 = MFMA32(*(const bf16x8*)(cb_ + O_NW + 8192 + kx[2 * db + s]), sb, vn1); }
                vb[0][0] = pack8f(vn0, 0); vb[0][1] = pack8f(vn0, 1); vb[1][0] = pack8f(vn1, 0); vb[1][1] = pack8f(vn1, 1);
            }
            SYNC_B();
            if (act) {
                const float cd = __builtin_bit_cast(float, __builtin_amdgcn_readlane(__builtin_bit_cast(int, (n & 64) ? cdv1 : cdv0), n & 63));
                int l2 = lane; asm volatile("" : "+v"(l2)); unsigned kx[8], qkx[4]; mk_kx(l2, kx); mk_qkx(l2, qkx);
                f32x16 o0, o1;
#pragma unroll
                for (int i = 0; i < 16; ++i) { o0[i] = 0.f; o1[i] = 0.f; }
#pragma unroll
                for (int db = 0; db < 4; ++db)
#pragma unroll
                    for (int s = 0; s < 2; ++s) { const bf16x8 sb = pack8f(S[db], s);
                        o0 = MFMA32(*(const bf16x8*)(cb_ + O_QD + kx[2 * db + s]), sb, o0); o1 = MFMA32(*(const bf16x8*)(cb_ + O_QD + 8192 + kx[2 * db + s]), sb, o1); }
#pragma unroll
                for (int jb = 0; jb < 2; ++jb)
#pragma unroll
                    for (int s = 0; s < 2; ++s) { o0 = MFMA32(*(const bf16x8*)(cb_ + O_QK + qkx[2 * jb + s]), vb[jb][s], o0); o1 = MFMA32(*(const bf16x8*)(cb_ + O_QK + 4096 + qkx[2 * jb + s]), vb[jb][s], o1); }
#pragma unroll
                for (int i = 0; i < 16; ++i) { Ob[((i & 3) + 8 * (i >> 2) + 4 * h5) * 128 + 32 * ew + r] = (bf16)f2bf(o0[i]); Ob[(32 + (i & 3) + 8 * (i >> 2) + 4 * h5) * 128 + 32 * ew + r] = (bf16)f2bf(o1[i]); }
                int l3 = lane; asm volatile("" : "+v"(l3)); unsigned vaddr[2][4]; mk_vaddr(l3, vaddr); const unsigned cbase = (unsigned)(uintptr_t)cb_;
#pragma unroll
                for (int db = 0; db < 4; ++db) {
#pragma unroll
                    for (int i = 0; i < 16; ++i) S[db][i] *= cd;
                    s16x4 tl[4], th[4]; const unsigned a0 = cbase + vaddr[0][db], a1 = cbase + vaddr[1][db];
#define TRR(dst, addr, off) asm volatile("ds_read_b64_tr_b16 %0, %1 offset:%c2" : "=&v"(dst) : "v"(addr), "i"(off) : "memory")
                    TRR(tl[0], a0, O_KD); TRR(th[0], a1, O_KD); TRR(tl[1], a0, O_KD + 4096); TRR(th[1], a1, O_KD + 4096);
                    TRR(tl[2], a0, O_KD + 8192); TRR(th[2], a1, O_KD + 8192); TRR(tl[3], a0, O_KD + 12288); TRR(th[3], a1, O_KD + 12288);
#undef TRR
                    asm volatile("s_waitcnt lgkmcnt(0)" : "+v"(tl[0]), "+v"(th[0]), "+v"(tl[1]), "+v"(th[1]), "+v"(tl[2]), "+v"(th[2]), "+v"(tl[3]), "+v"(th[3]) :: "memory");
                    __builtin_amdgcn_sched_barrier(0);
#pragma unroll
                    for (int cs = 0; cs < 4; ++cs) { const bf16x8 kf = __builtin_shufflevector(tl[cs], th[cs], 0, 1, 2, 3, 4, 5, 6, 7); S[db] = MFMA32(kf, vb[cs >> 1][cs & 1], S[db]); } }
            }
            SYNC_A();
        }
    } else {
#pragma unroll 1
        for (int n = 0; n <= SEQ / 64; ++n) {
            const bool more = n + 1 < SEQ / 64;
            v4u ovr[4], zv[4], un[4];
            if (n > 0) {
                const bf16* op = Ob + hr * 128 + c4 * 32;
#pragma unroll
                for (int i = 0; i < 4; ++i) ovr[i] = *(const v4u*)(op + 8 * i);
            }
            if (more) {
#pragma unroll
                for (int i = 0; i < 4; ++i) un[i] = *(const v4u*)(gUh + (size_t)(n + 1) * 64 * 768 + 8 * i);
            }
            SYNC_B();
            if (n > 0) { const bf16* zp = gZ + ((size_t)(n - 1) * 64 + hr) * 768 + c4 * 32;
#pragma unroll
                for (int i = 0; i < 4; ++i) zv[i] = *(const v4u*)(zp + 8 * i); }
            if (more) {
#pragma unroll
                for (int i = 0; i < 4; ++i) *(v4u*)(Ub + ht * 64 + 16 * i) = un[i];
            }
            if (n > 0) {
                float ov[32];
#pragma unroll
                for (int i = 0; i < 4; ++i) { const v4u t = ovr[i]; ov[8 * i] = bflo(t.x); ov[8 * i + 1] = bfhi(t.x); ov[8 * i + 2] = bflo(t.y); ov[8 * i + 3] = bfhi(t.y); ov[8 * i + 4] = bflo(t.z); ov[8 * i + 5] = bfhi(t.z); ov[8 * i + 6] = bflo(t.w); ov[8 * i + 7] = bfhi(t.w); }
                float ss = 0.f;
#pragma unroll
                for (int i = 0; i < 32; ++i) ss += ov[i] * ov[i];
                ss += __shfl_xor(ss, 1); ss += __shfl_xor(ss, 2);
                const float sc = 1.0f / sqrtf(ss * (1.0f / 128.0f) + EPS); const float* gn = (const float*)P.in[I_GDNN] + c4 * 32;
                bf16* zp = gZ + ((size_t)(n - 1) * 64 + hr) * 768 + c4 * 32;
#pragma unroll
                for (int i = 0; i < 4; ++i) { const v4u z = zv[i]; const float zz[8] = { bflo(z.x), bfhi(z.x), bflo(z.y), bfhi(z.y), bflo(z.z), bfhi(z.z), bflo(z.w), bfhi(z.w) };
                    float y[8];
#pragma unroll
                    for (int k = 0; k < 8; ++k) y[k] = ov[8 * i + k] * sc * gn[8 * i + k] * siluf(zz[k]);
                    v4u w; w.x = pk2(y[0], y[1]); w.y = pk2(y[2], y[3]); w.z = pk2(y[4], y[5]); w.w = pk2(y[6], y[7]); *(v4u*)(zp + 8 * i) = w; }
            }
            SYNC_A();
        }
    }
#undef SYNC_A
#undef SYNC_B
#undef GDN_DMA
}

constexpr int NPHASE = 8;
__global__ void __launch_bounds__(NTHR, 2) mega_fwd(Params P) {
    extern __shared__ __attribute__((aligned(16))) unsigned char lds[];
    cg::grid_group grid = cg::this_grid();
    const int G = gridDim.x;
    unsigned char* ws = P.ws; unsigned char* outb = (unsigned char*)P.out;
    PG8_LAS unsigned char* lds3 = (PG8_LAS unsigned char*)lds;
    const int lo = P.lo, hi = P.hi;
#define IN(k) (lo <= (k) && (k) < hi)
#define SEAM(k) do { if (IN(k) && IN((k) + 1)) grid.sync(); } while (0)

#define LAUNDER() int tid = threadIdx.x; asm volatile("" : "+v"(tid)); const int lane = tid & 63, wave = __builtin_amdgcn_readfirstlane(tid >> 6); (void)lane; (void)wave
    if (IN(0)) { LAUNDER(); p0_prologue(P, lds, tid, lane, wave); __syncthreads(); }
    SEAM(0);
    if (IN(1)) {
        { pg8::Gemm g{(const pg8::bf16_t*)(outb + OUT_HB), (const pg8::bf16_t*)(ws + WS_W1T), MTOK, NCOMB, DM}; pg8::StaticOrder S; S.init(MTOK, NCOMB, G, (int)blockIdx.x);
          pg8::EpiP1 E{ws, outb, (const float*)P.in[I_BGATE]};
          pg8::gemm_phase<pg8::EpiP1, pg8::StaticOrder, true, true>(lds3, g, S, E); }
        { pg8::Gemm g{(const pg8::bf16_t*)(ws + WS_MN), (const pg8::bf16_t*)(ws + WS_WMEM), MEMROWS, 1024, DM}; pg8::StaticOrder S; S.init(MEMROWS, 1024, G, (int)blockIdx.x);
          pg8::EpiPlain E{(pg8::bf16_t*)(ws + WS_MKV), 1024};
          pg8::gemm_phase<pg8::EpiPlain, pg8::StaticOrder, true, true>(lds3, g, S, E); }
    }
    SEAM(1);
    if (IN(2)) { LAUNDER();
        for (int u = (int)blockIdx.x; u < NB * 6 * (SEQ / 64); u += G) { const int n = u & 127, bh = u >> 7; gdn_intra_unit(P, lds, tid, bh / 6, bh % 6, n); }
        p2a_qknorm_rope(P, lane, wave); }
    SEAM(2);
    if (IN(3)) {
        LAUNDER();
        if ((int)blockIdx.x < 24) gdn_scan_unit(P, lds, tid, (int)blockIdx.x / 6, (int)blockIdx.x % 6);
        int* qctr = (int*)(ws + WS_MISC) + 1;
        for (;;) {
            __syncthreads();
            if (tid == 0) *(volatile int*)(lds + LDS_BYTES - 16) = atomicAdd(qctr, 1);
            __syncthreads();
            const int u = *(volatile int*)(lds + LDS_BYTES - 16);
            if (u >= 24 * 64 + NB * 4 * 32) break;
            if (u < 24 * 64) { const int qb = 63 - u / 24, bh = u % 24; attn_mfma_unit<false>(P, lds, tid, bh / 6, bh % 6, qb); }
            else { const int v = u - 24 * 64, qb = v & 31, bh = v >> 5; attn_mfma_unit<true>(P, lds, tid, bh >> 2, bh & 3, qb); }
        }
        __syncthreads();
    }
    SEAM(3);
    if (IN(4)) {
        pg8::StaticOrder S; S.init(MTOK, DM, G, (int)blockIdx.x);
        const unsigned char* gates = ws + WS_GATES; float* mixf = (float*)(ws + WS_MIXF); pg8::bf16_t* mixed = (pg8::bf16_t*)(ws + WS_MIXED);
        { pg8::Gemm g{(const pg8::bf16_t*)(ws + WS_DAQ), (const pg8::bf16_t*)(ws + WS_WOD), MTOK, DM, 768}; pg8::EpiGate<0> E{gates, mixf, mixed, 0};
          pg8::gemm_phase<pg8::EpiGate<0>, pg8::StaticOrder, true, true>(lds3, g, S, E); }
        { pg8::Gemm g{(const pg8::bf16_t*)(ws + WS_GZ), (const pg8::bf16_t*)(ws + WS_WODL), MTOK, DM, 768}; pg8::EpiGate<1> E{gates, mixf, mixed, 1};
          pg8::gemm_phase<pg8::EpiGate<1>, pg8::StaticOrder, true, true>(lds3, g, S, E); }
        { pg8::Gemm g{(const pg8::bf16_t*)(outb + OUT_CAQ), (const pg8::bf16_t*)(ws + WS_WOC), MTOK, DM, 512}; pg8::EpiGate<2> E{gates, mixf, mixed, 2};
          pg8::gemm_phase<pg8::EpiGate<2>, pg8::StaticOrder, true, true>(lds3, g, S, E); }
    }
    SEAM(4);
    if (IN(5)) {
        pg8::Gemm g{(const pg8::bf16_t*)(ws + WS_MIXED), (const pg8::bf16_t*)(ws + WS_WOUT), MTOK, DM, DM}; pg8::StaticOrder S; S.init(MTOK, DM, G, (int)blockIdx.x);
        pg8::EpiRes1 E{(const float*)P.in[I_X], P.out, (pg8::bf16_t*)(ws + WS_X1B), (float*)(ws + WS_ROWSS)};
        pg8::gemm_phase<pg8::EpiRes1, pg8::StaticOrder, true, true>(lds3, g, S, E);
    }
    SEAM(5);
    if (IN(6)) {
        pg8::Gemm g{(const pg8::bf16_t*)(ws + WS_X1B), (const pg8::bf16_t*)(ws + WS_WM1), MTOK, DFF, DM}; pg8::StaticOrder S; S.init(MTOK, DFF, G, (int)blockIdx.x);
        pg8::EpiMlp1 E{(const float*)(ws + WS_ROWSS), (pg8::bf16_t*)(ws + WS_HMID)};
        pg8::gemm_phase<pg8::EpiMlp1, pg8::StaticOrder, true, true>(lds3, g, S, E);
    }
    SEAM(6);
    if (IN(7)) {
        pg8::Gemm g{(const pg8::bf16_t*)(ws + WS_HMID), (const pg8::bf16_t*)(ws + WS_WM2), MTOK, DM, DFF}; pg8::StaticOrder S; S.init(MTOK, DM, G, (int)blockIdx.x);
        pg8::EpiRes2 E{P.out};
        pg8::gemm_phase<pg8::EpiRes2, pg8::StaticOrder, true, true>(lds3, g, S, E);
    }
#undef IN
#undef SEAM
}

#ifndef MK_SPLIT
#define MK_SPLIT 0
#endif
extern "C" void kernel_launch(void* const* d_in, const int* in_sizes, int n_in, void* d_out, int out_size, void* d_ws, size_t ws_size, hipStream_t stream) {
    static int grid = 0;
    if (grid == 0) {
        if (n_in != 29 || in_sizes[0] != MTOK * DM || out_size != MTOK * DM || ws_size < WS_NEED) {
            fprintf(stderr, "kernel_launch: unexpected problem: n_in %d in0 %d out %d ws %zu (need %zu)\n", n_in, n_in > 0 ? in_sizes[0] : -1, out_size, ws_size, (size_t)WS_NEED); grid = -1; return; }
        int dev = 0, cus = 0, per_cu = 0;
        hipGetDevice(&dev); hipDeviceGetAttribute(&cus, hipDeviceAttributeMultiprocessorCount, dev);
        if (hipFuncSetAttribute((const void*)mega_fwd, hipFuncAttributeMaxDynamicSharedMemorySize, LDS_BYTES) != hipSuccess) { fprintf(stderr, "kernel_launch: hipFuncSetAttribute failed\n"); grid = -1; return; }
        if (hipOccupancyMaxActiveBlocksPerMultiprocessor(&per_cu, (const void*)mega_fwd, NTHR, LDS_BYTES) != hipSuccess || per_cu < 1) { fprintf(stderr, "kernel_launch: occupancy query says %d\n", per_cu); per_cu = 1; }
        (void)hipGetLastError();
        grid = cus * 1;
        fprintf(stderr, "kernel_launch: cus %d per_cu %d grid %d ws %zu\n", cus, per_cu, grid, ws_size);
    }
    if (grid < 0) return;
    Params p{};
    for (int i = 0; i < 29; ++i) p.in[i] = d_in[i];
    p.out = (float*)d_out; p.ws = (unsigned char*)d_ws;
#if MK_SPLIT
    for (int ph = 0; ph < NPHASE; ++ph) { p.lo = ph; p.hi = ph + 1; hipLaunchKernelGGL(mega_fwd, dim3(grid), dim3(NTHR), LDS_BYTES, stream, p); }
#else
    p.lo = 0; p.hi = NPHASE;
    void* args[] = { &p };
    hipError_t e = hipLaunchCooperativeKernel((const void*)mega_fwd, dim3(grid), dim3(NTHR), args, LDS_BYTES, stream);
    if (e != hipSuccess) fprintf(stderr, "kernel_launch: cooperative launch failed: %s (grid %d)\n", hipGetErrorString(e), grid);
#endif
}
```

```cpp
#include <hip/hip_runtime.h>
#include <hip/hip_cooperative_groups.h>
#include <cstdio>
#include <cstdint>
namespace cg = cooperative_groups;

constexpr int NB = 4, SEQ = 8192, DM = 1024, MTOK = NB * SEQ;
constexpr int NMEM = 256, MEMROWS = NB * NMEM;
constexpr int DIN = 5900, NGATE = 3072, DFF = 4096;
constexpr int NCOMB = 8960;
constexpr float EPS = 1e-6f;
constexpr float C2_DA = 0.125f * 1.4426950408889634f;
constexpr float C2_CA = 0.08838834764831845f * 1.4426950408889634f;
constexpr float LAM_INIT = 0.2f;

constexpr size_t MiB = (size_t)1 << 20;
constexpr size_t WS_W1T = 0, WS_WOD = 18 * MiB, WS_WODL = 19 * MiB + 512 * 1024, WS_WOC = 21 * MiB  , WS_WOUT = 23 * MiB, WS_WM1 = 25 * MiB, WS_WM2 = 33 * MiB, WS_WMEM = 41 * MiB;
constexpr size_t WS_ROPEC = 43 * MiB, WS_ROPES = 47 * MiB, WS_BT = 51 * MiB, WS_LA = 52 * MiB, WS_MN = 53 * MiB, WS_MKV = 55 * MiB, WS_HALO = 57 * MiB;
constexpr size_t WS_ROWSS = 63 * MiB + 768 * 1024, WS_MISC = 63 * MiB + 960 * 1024;
constexpr size_t WS_GATES = 64 * MiB;
constexpr size_t WS_DAQ = 160 * MiB, WS_SEC = 48 * MiB;
constexpr size_t WS_DAK = WS_DAQ + WS_SEC, WS_DAV = WS_DAQ + 2 * WS_SEC, WS_GQ = WS_DAQ + 3 * WS_SEC, WS_GK = WS_DAQ + 4 * WS_SEC, WS_GV = WS_DAQ + 5 * WS_SEC, WS_GZ = WS_DAQ + 6 * WS_SEC;
constexpr size_t WS_MIXF = 208 * MiB, WS_MIXED = 336 * MiB, WS_X1B = 416 * MiB, WS_HMID = 160 * MiB;
constexpr size_t WS_NEED = 496 * MiB;
constexpr size_t OUT_HB = 0, OUT_CAQ = 72 * MiB;

__device__ __forceinline__ int mk_tid(int wave_s) { int l; asm volatile("v_mbcnt_lo_u32_b32 %0, -1, 0\n\tv_mbcnt_hi_u32_b32 %0, -1, %0" : "=v"(l)); return wave_s * 64 + l; }
namespace pg8 {
#define PG8_LAS __attribute__((address_space(3)))
typedef unsigned short bf16_t;
typedef short bf16x8 __attribute__((ext_vector_type(8)));
typedef float f32x4 __attribute__((ext_vector_type(4)));
typedef unsigned u32x4 __attribute__((ext_vector_type(4)));
constexpr int BM = 256, BK = 64, HALF = 128, HTB = HALF * BK * 2  , STAGE_BYTES = 8 * HTB, NXCD = 8, WGM = 8;

__host__ __device__ __forceinline__ int lds_byte(int r, int c) { const int st = (r >> 4) * 2 + (c >> 5), rr = r & 15, cc = c & 31, ob = rr * 64 + cc * 2; return st * 1024 + (ob ^ (((ob >> 9) & 1) << 5)); }
__host__ __device__ __forceinline__ void stage_rc(int b, int& R, int& C) { const int st = b / 1024, sb = b % 1024, swz = sb ^ (((sb >> 9) & 1) << 5); R = (st >> 1) * 16 + swz / 64; C = (st & 1) * 32 + (swz % 64) / 2; }
__host__ __device__ __forceinline__ int perm32(int rho) { const int n = rho >> 4, i = rho & 15; return 8 * (i >> 2) + 4 * n + (i & 3); }

struct Unit { int pm, pn, seg; };
struct Gemm { const bf16_t* A; const bf16_t* Bt; int M, N, K; };

struct StaticOrder {
    int nM, nN, nwg, G, c;
    __host__ __device__ void init(int M, int N, int G_, int c_) { nM = M / BM; nN = N / BM; nwg = nM * nN; G = G_; c = c_; }
    __host__ __device__ bool next(int i, Unit& u) const {
        const long L = (long)i * G + c; if (L >= nwg) return false;
        int wgid = (int)L; { const int q = nwg / NXCD, r = nwg % NXCD, xcd = wgid % NXCD, off = wgid / NXCD; wgid = (xcd < r ? xcd * (q + 1) : r * (q + 1) + (xcd - r) * q) + off; }
        const int nig = WGM * nN, gid = wgid / nig, fm = gid * WGM, gsz = (nM - fm) < WGM ? (nM - fm) : WGM;
        u.pm = fm + ((wgid % nig) % gsz); u.pn = (wgid % nig) / gsz; u.seg = 0; return true;
    }
    __device__ __forceinline__ void a_ready(const Unit&) const {}
    __device__ __forceinline__ void done(const Unit&) const {}
};
struct ChainOrder : StaticOrder {
    __host__ __device__ bool next(int i, Unit& u) const { const int t = i / 3; if (!StaticOrder::next(t, u)) return false; u.seg = i - 3 * t; return true; }
};

__device__ __forceinline__ unsigned cvt_pk_bf16(float lo, float hi) { unsigned r; asm volatile("v_cvt_pk_bf16_f32 %0, %1, %2" : "=v"(r) : "v"(lo), "v"(hi)); return r; }
typedef unsigned u32x2 __attribute__((ext_vector_type(2)));
__device__ __forceinline__ u32x4 pack8(const f32x4 a, const f32x4 b) { u32x4 w; w.x = cvt_pk_bf16(a[0], a[1]); w.y = cvt_pk_bf16(a[2], a[3]); w.z = cvt_pk_bf16(b[0], b[1]); w.w = cvt_pk_bf16(b[2], b[3]); return w; }
__device__ __forceinline__ float sigm(float x) { return __builtin_amdgcn_rcpf(1.0f + __expf(-x)); }

struct EpiPlain {
    static constexpr bool PERM = true, AFTER_DRAIN = false, CHAIN = false;
    bf16_t* O; int ldc;
    __device__ __forceinline__ void operator()(const f32x4 (&acc)[2][2][4][2], const Unit& u, int wr, int wc, int fr, int fq) const {
        const int row0 = u.pm * BM + wr * 64 + fr, col0 = u.pn * BM + wc * 32 + 8 * fq;
#pragma unroll
        for (int ai = 0; ai < 2; ++ai)
#pragma unroll
            for (int m = 0; m < 4; ++m) { bf16_t* rowp = O + (size_t)(row0 + ai * HALF + m * 16) * ldc + col0;
#pragma unroll
                for (int bj = 0; bj < 2; ++bj) *(u32x4*)(rowp + bj * HALF) = pack8(acc[ai][bj][m][0], acc[ai][bj][m][1]); }
    }
};

struct EpiP1 {
    static constexpr bool PERM = true, AFTER_DRAIN = false, CHAIN = false;
    unsigned char* ws; unsigned char* outb; const float* bgate; const float* qng; const float* kng;
    __device__ __forceinline__ void operator()(const f32x4 (&acc)[2][2][4][2], const Unit& u, int wr, int wc, int fr, int fq) const {
        const int pn = u.pn, row0 = u.pm * BM + wr * 64 + fr, cl0 = wc * 32 + 8 * fq;
        if (pn < 6) {
            const bool isk = pn >= 3; bf16_t* base = (bf16_t*)(ws + (isk ? WS_DAK : WS_DAQ)); const float* g = isk ? kng : qng;
            const int hm = 4 * (pn - (isk ? 3 : 0)) + wc; const float osc = isk ? 1.0f : C2_DA;
            f32x4 g1[2], g2[2];
#pragma unroll
            for (int n = 0; n < 2; ++n) { g1[n] = *(const f32x4*)(g + 8 * fq + 4 * n); g2[n] = *(const f32x4*)(g + 32 + 8 * fq + 4 * n); }
            const float* RC = (const float*)(ws + WS_ROPEC); const float* RS = (const float*)(ws + WS_ROPES);
#pragma unroll
            for (int ai = 0; ai < 2; ++ai)
#pragma unroll
                for (int m = 0; m < 4; ++m) { const int row = row0 + ai * HALF + m * 16;
                    float ss = 0.f;
#pragma unroll
                    for (int bj = 0; bj < 2; ++bj)
#pragma unroll
                        for (int n = 0; n < 2; ++n) { const f32x4 v = acc[ai][bj][m][n]; ss += (v[0] * v[0] + v[1] * v[1]) + (v[2] * v[2] + v[3] * v[3]); }
                    ss += __shfl_xor(ss, 16); ss += __shfl_xor(ss, 32);
                    const float rs = __builtin_amdgcn_rsqf(ss * (1.0f / 64.0f) + EPS) * osc;
                    f32x4 o1[2], o2[2];
#pragma unroll
                    for (int n = 0; n < 2; ++n) { const f32x4 c = *(const f32x4*)(RC + (size_t)row * 32 + 8 * fq + 4 * n), sn = *(const f32x4*)(RS + (size_t)row * 32 + 8 * fq + 4 * n);
                        const f32x4 y1 = acc[ai][0][m][n] * rs * g1[n], y2 = acc[ai][1][m][n] * rs * g2[n];
                        o1[n] = y1 * c - y2 * sn; o2[n] = y2 * c + y1 * sn; }
                    bf16_t* rowp = base + (size_t)row * 768 + hm * 64 + 8 * fq;
                    *(u32x4*)rowp = pack8(o1[0], o1[1]); *(u32x4*)(rowp + 32) = pack8(o2[0], o2[1]); }
        } else if (pn < 23) {
            bf16_t* base; int ldc, colt;
            if (pn < 21) { const int bi = pn / 3; base = (bf16_t*)(ws + WS_DAQ + (size_t)bi * WS_SEC); ldc = 768; colt = (pn - 3 * bi) * 256; }
            else { base = (bf16_t*)(outb + OUT_CAQ); ldc = 768; colt = (pn - 21) * 256; }
            const bool halo = (pn >= 9 && pn < 18);
            bf16_t* hb = (bf16_t*)(ws + WS_HALO);
#pragma unroll
            for (int ai = 0; ai < 2; ++ai)
#pragma unroll
                for (int m = 0; m < 4; ++m) { const int row = row0 + ai * HALF + m * 16; bf16_t* rowp = base + (size_t)row * ldc + colt + cl0;
#pragma unroll
                    for (int bj = 0; bj < 2; ++bj) { const u32x4 w = pack8(acc[ai][bj][m][0], acc[ai][bj][m][1]); *(u32x4*)(rowp + bj * HALF) = w;
                        if (halo && (row & 63) >= 61) *(u32x4*)(hb + ((size_t)(row >> 6) * 3 + ((row & 63) - 61)) * 2304 + (pn - 9) * 256 + bj * HALF + cl0) = w; } }
        } else {
            unsigned char* gb = ws + WS_GATES; const int colt = (pn - 23) * 256 + cl0;
            f32x4 bv[2][2];
#pragma unroll
            for (int bj = 0; bj < 2; ++bj)
#pragma unroll
                for (int n = 0; n < 2; ++n) bv[bj][n] = *(const f32x4*)(bgate + colt + bj * HALF + 4 * n);
#pragma unroll
            for (int ai = 0; ai < 2; ++ai)
#pragma unroll
                for (int m = 0; m < 4; ++m) { const int row = row0 + ai * HALF + m * 16; unsigned char* rowp = gb + (size_t)row * NGATE + colt;
#pragma unroll
                    for (int bj = 0; bj < 2; ++bj) { const f32x4 v0 = acc[ai][bj][m][0] + bv[bj][0], v1 = acc[ai][bj][m][1] + bv[bj][1];
                        unsigned q[8];
#pragma unroll
                        for (int i = 0; i < 4; ++i) { q[i] = (unsigned)__builtin_fmaxf(1.0f, __builtin_rintf(255.0f * sigm(v0[i]))); q[4 + i] = (unsigned)__builtin_fmaxf(1.0f, __builtin_rintf(255.0f * sigm(v1[i])));     }
                        u32x2 w; w.x = q[0] | (q[1] << 8) | (q[2] << 16) | (q[3] << 24); w.y = q[4] | (q[5] << 8) | (q[6] << 16) | (q[7] << 24);
                        *(u32x2*)(rowp + bj * HALF) = w; } }
        }
    }
};

template <int MODE> struct EpiGate {
    static constexpr bool PERM = true, AFTER_DRAIN = false, CHAIN = false;
    const unsigned char* gates; float* mixf; bf16_t* mixed; int br;
    __device__ __forceinline__ void operator()(const f32x4 (&acc)[2][2][4][2], const Unit& u, int wr, int wc, int fr, int fq) const {
        const int row0 = u.pm * BM + wr * 64 + fr, col0 = u.pn * BM + wc * 32 + 8 * fq;
#pragma unroll
        for (int ai = 0; ai < 2; ++ai)
#pragma unroll
            for (int m = 0; m < 4; ++m) { const int row = row0 + ai * HALF + m * 16;
#pragma unroll
                for (int bj = 0; bj < 2; ++bj) { const int col = col0 + bj * HALF;
                    const u32x2 gw = *(const u32x2*)(gates + (size_t)row * NGATE + br * 1024 + col);
                    f32x4 g0, g1;
#pragma unroll
                    for (int i = 0; i < 4; ++i) { g0[i] = (float)((gw.x >> (8 * i)) & 255u) * (1.0f / 255.0f); g1[i] = (float)((gw.y >> (8 * i)) & 255u) * (1.0f / 255.0f); }
                    f32x4 v0 = acc[ai][bj][m][0] * g0, v1 = acc[ai][bj][m][1] * g1;
                    float* mp = mixf + (size_t)row * DM + col;
                    if (MODE >= 1) { v0 = v0 + *(const f32x4*)mp; v1 = v1 + *(const f32x4*)(mp + 4); }
                    if (MODE <= 1) { *(f32x4*)mp = v0; *(f32x4*)(mp + 4) = v1; }
                    else *(u32x4*)(mixed + (size_t)row * DM + col) = pack8(v0, v1); } }
    }
};

struct EpiRes1 {
    static constexpr bool PERM = true, AFTER_DRAIN = false, CHAIN = false;
    const float* x; float* out; bf16_t* x1b; float* rowss;
    __device__ __forceinline__ void operator()(const f32x4 (&acc)[2][2][4][2], const Unit& u, int wr, int wc, int fr, int fq) const {
        const int row0 = u.pm * BM + wr * 64 + fr, col0 = u.pn * BM + wc * 32 + 8 * fq;
#pragma unroll
        for (int ai = 0; ai < 2; ++ai) {
            f32x4 xr[4][2][2];
#pragma unroll
            for (int m = 0; m < 4; ++m)
#pragma unroll
                for (int bj = 0; bj < 2; ++bj) { const float* xp = x + (size_t)(row0 + ai * HALF + m * 16) * DM + col0 + bj * HALF; xr[m][bj][0] = *(const f32x4*)xp; xr[m][bj][1] = *(const f32x4*)(xp + 4); }
            asm volatile("" ::: "memory");
#pragma unroll
            for (int m = 0; m < 4; ++m) { const int row = row0 + ai * HALF + m * 16; float ss = 0.f;
#pragma unroll
                for (int bj = 0; bj < 2; ++bj) { const size_t off = (size_t)row * DM + col0 + bj * HALF;
                    const f32x4 v0 = acc[ai][bj][m][0] + xr[m][bj][0], v1 = acc[ai][bj][m][1] + xr[m][bj][1];
                    *(u32x4*)(x1b + off) = pack8(v0, v1);
                    ss += (v0[0] * v0[0] + v0[1] * v0[1]) + (v0[2] * v0[2] + v0[3] * v0[3]) + (v1[0] * v1[0] + v1[1] * v1[1]) + (v1[2] * v1[2] + v1[3] * v1[3]); }
                ss += __shfl_xor(ss, 16); ss += __shfl_xor(ss, 32);
                if (fq == 0) atomicAdd(rowss + row, ss); } }
    }
};

struct EpiMlp1 {
    static constexpr bool PERM = true, AFTER_DRAIN = false, CHAIN = false;
    bf16_t* O;
    __device__ __forceinline__ void operator()(const f32x4 (&acc)[2][2][4][2], const Unit& u, int wr, int wc, int fr, int fq) const {
        const int row0 = u.pm * BM + wr * 64 + fr, col0 = u.pn * BM + wc * 32 + 8 * fq;
#pragma unroll
        for (int ai = 0; ai < 2; ++ai)
#pragma unroll
            for (int m = 0; m < 4; ++m) { const int row = row0 + ai * HALF + m * 16;
                bf16_t* rowp = O + (size_t)row * DFF + col0;
#pragma unroll
                for (int bj = 0; bj < 2; ++bj) { f32x4 v0 = acc[ai][bj][m][0], v1 = acc[ai][bj][m][1];
#pragma unroll
                    for (int i = 0; i < 4; ++i) { const float a = __builtin_fmaxf(v0[i], 0.f), b = __builtin_fmaxf(v1[i], 0.f); v0[i] = a * a; v1[i] = b * b; }
                    *(u32x4*)(rowp + bj * HALF) = pack8(v0, v1); } }
    }
};
struct EpiRes2 {
    static constexpr bool PERM = true, AFTER_DRAIN = false, CHAIN = false;
    const bf16_t* x1b; const float* rowss; float* out;
    __device__ __forceinline__ void operator()(const f32x4 (&acc)[2][2][4][2], const Unit& u, int wr, int wc, int fr, int fq) const {
        const int row0 = u.pm * BM + wr * 64 + fr, col0 = u.pn * BM + wc * 32 + 8 * fq;
        u32x4 xr[2][4][2]; float rsv[2][4];
#pragma unroll
        for (int ai = 0; ai < 2; ++ai)
#pragma unroll
            for (int m = 0; m < 4; ++m) { rsv[ai][m] = rowss[row0 + ai * HALF + m * 16];
#pragma unroll
                for (int bj = 0; bj < 2; ++bj) xr[ai][m][bj] = *(const u32x4*)(x1b + (size_t)(row0 + ai * HALF + m * 16) * DM + col0 + bj * HALF); }
        asm volatile("" ::: "memory");
#pragma unroll
        for (int ai = 0; ai < 2; ++ai)
#pragma unroll
            for (int m = 0; m < 4; ++m) { const float r2 = __builtin_amdgcn_rcpf(rsv[ai][m] * (1.0f / 1024.0f) + EPS);
#pragma unroll
                for (int bj = 0; bj < 2; ++bj) { float* op = out + (size_t)(row0 + ai * HALF + m * 16) * DM + col0 + bj * HALF; const u32x4 w = xr[ai][m][bj];
                    const f32x4 r0 = {__builtin_bit_cast(float, w.x << 16), __builtin_bit_cast(float, w.x & 0xffff0000u), __builtin_bit_cast(float, w.y << 16), __builtin_bit_cast(float, w.y & 0xffff0000u)};
                    const f32x4 r1 = {__builtin_bit_cast(float, w.z << 16), __builtin_bit_cast(float, w.z & 0xffff0000u), __builtin_bit_cast(float, w.w << 16), __builtin_bit_cast(float, w.w & 0xffff0000u)};
                    *(f32x4*)op = acc[ai][bj][m][0] * r2 + r0; *(f32x4*)(op + 4) = acc[ai][bj][m][1] * r2 + r1; } }
    }
};

struct EpiChain {
    static constexpr bool PERM = true, AFTER_DRAIN = false, CHAIN = true;
    const bf16_t *A0, *A1, *A2, *B0, *B1, *B2; int k0, k1, k2;
    const unsigned char* gates; bf16_t* mixed;
    __device__ __forceinline__ const bf16_t* segA(int s) const { return (const bf16_t*)((unsigned long long)A0 + (unsigned long long)(s == 1) * ((unsigned long long)A1 - (unsigned long long)A0) + (unsigned long long)(s == 2) * ((unsigned long long)A2 - (unsigned long long)A0)); }
    __device__ __forceinline__ const bf16_t* segB(int s) const { return (const bf16_t*)((unsigned long long)B0 + (unsigned long long)(s == 1) * ((unsigned long long)B1 - (unsigned long long)B0) + (unsigned long long)(s == 2) * ((unsigned long long)B2 - (unsigned long long)B0)); }
    __device__ __forceinline__ int segK(int s) const { return k0 + (s == 1) * (k1 - k0) + (s == 2) * (k2 - k0); }
    __device__ __forceinline__ void chain(f32x4 (&acc)[2][2][4][2], const Unit& u, int wr, int wc, int fr, int fq) const {
        const int row0 = u.pm * BM + wr * 64 + fr, col0 = u.pn * BM + wc * 32 + 8 * fq; const int sg = u.seg; const int sd = sg < 2 ? sg + 1 : sg;
#pragma unroll
        for (int ai = 0; ai < 2; ++ai) {
            u32x2 gnv[4][2], gdv[4][2];
#pragma unroll
            for (int m = 0; m < 4; ++m)
#pragma unroll
                for (int bj = 0; bj < 2; ++bj) { const unsigned char* gp = gates + (size_t)(row0 + ai * HALF + m * 16) * NGATE + col0 + bj * HALF; gnv[m][bj] = *(const u32x2*)(gp + sg * 1024); gdv[m][bj] = *(const u32x2*)(gp + sd * 1024); }
            asm volatile("" ::: "memory");
#pragma unroll
            for (int m = 0; m < 4; ++m) { const int row = row0 + ai * HALF + m * 16;
#pragma unroll
                for (int bj = 0; bj < 2; ++bj) { const int col = col0 + bj * HALF; const u32x2 gn = gnv[m][bj], gd = gdv[m][bj];
                    f32x4 f0, f1;
                    if (sg < 2) {
#pragma unroll
                        for (int i = 0; i < 4; ++i) { f0[i] = (float)((gn.x >> (8 * i)) & 255u) * __builtin_amdgcn_rcpf((float)((gd.x >> (8 * i)) & 255u)); f1[i] = (float)((gn.y >> (8 * i)) & 255u) * __builtin_amdgcn_rcpf((float)((gd.y >> (8 * i)) & 255u)); }
                        acc[ai][bj][m][0] = acc[ai][bj][m][0] * f0; acc[ai][bj][m][1] = acc[ai][bj][m][1] * f1;
                    } else {
#pragma unroll
                        for (int i = 0; i < 4; ++i) { f0[i] = (float)((gn.x >> (8 * i)) & 255u) * (1.0f / 255.0f); f1[i] = (float)((gn.y >> (8 * i)) & 255u) * (1.0f / 255.0f); }
                        *(u32x4*)(mixed + (size_t)row * DM + col) = pack8(acc[ai][bj][m][0] * f0, acc[ai][bj][m][1] * f1); } } } }
    }
};

template <class Epi, class Sched, bool ALIGN_EPI = false, bool SP2 = false>
__device__ __forceinline__ void gemm_phase(PG8_LAS unsigned char* lds, const Gemm g, const Sched& S, const Epi& E, int wave_s) {
    int tid_ = mk_tid(wave_s); asm volatile("" : "+v"(tid_));
    const int tid = tid_, wid = __builtin_amdgcn_readfirstlane(tid >> 6), lane = tid & 63, wr = wid >> 2, wc = wid & 3, fr = lane & 15, fq = lane >> 4;
    const int K = g.K; int nt = K / BK;
    unsigned voffA[2], voffB[2];
#pragma unroll
    for (int i = 0; i < 2; ++i) { int R, C; stage_rc(tid * 16 + i * 8192, R, C); const int Rb = Epi::PERM ? ((R & ~31) + perm32(R & 31)) : R;
        voffA[i] = (unsigned)(R * K + C) * 2u; voffB[i] = (unsigned)(Rb * K + C) * 2u; }
    const size_t kstep = (size_t)(BK * 2);
    const size_t hstep = (size_t)HALF * K * 2;
    const size_t tstep = 2 * hstep;
    const unsigned ldsw = (unsigned)wid * 1024u;
    const int aoff = lds_byte(wr * 64 + fr, fq * 8), boff = lds_byte(wc * 32 + fr, fq * 8);
#define PG8_SA(b, h) (((b) * 2 + (h)) * HTB)
#define PG8_SB(b, h) ((4 + (b) * 2 + (h)) * HTB)
#define PG8_STAGE(bufoff, gbase, voff) do { _Pragma("unroll") for (int _i = 0; _i < 2; ++_i) \
        __builtin_amdgcn_global_load_lds((const unsigned*)((const char*)(gbase) + (voff)[_i]), (PG8_LAS unsigned*)(lds + (bufoff) + ldsw + _i * 8192), 16, 0, 0); } while (0)
#define PG8_LDA(dst, b, h) do { _Pragma("unroll") for (int m = 0; m < 4; ++m) _Pragma("unroll") for (int k = 0; k < 2; ++k) dst[m][k] = *(const PG8_LAS bf16x8*)(lds + PG8_SA(b, h) + aoff + m * 2048 + k * 1024); } while (0)
#define PG8_LDB(dst, b, h) do { _Pragma("unroll") for (int n = 0; n < 2; ++n) _Pragma("unroll") for (int k = 0; k < 2; ++k) dst[n][k] = *(const PG8_LAS bf16x8*)(lds + PG8_SB(b, h) + boff + n * 2048 + k * 1024); } while (0)
#define PG8_MMA(ai, bj, At, Bt) do { __builtin_amdgcn_s_setprio(1); _Pragma("unroll") for (int m = 0; m < 4; ++m) _Pragma("unroll") for (int n = 0; n < 2; ++n) _Pragma("unroll") for (int k = 0; k < 2; ++k) \
        acc[ai][bj][m][n] = __builtin_amdgcn_mfma_f32_16x16x32_bf16(Bt[n][k], At[m][k], acc[ai][bj][m][n], 0, 0, 0); __builtin_amdgcn_s_setprio(0); } while (0)
#define PG8_WAIT_V(n) asm volatile("s_waitcnt vmcnt(" #n ")" ::: "memory")
#define PG8_WAIT_L(n) asm volatile("s_waitcnt lgkmcnt(" #n ")" ::: "memory")
#define PG8_BAR __builtin_amdgcn_s_barrier()
#define PG8_SCHED __builtin_amdgcn_sched_barrier(0)
    Unit cur, nxt; int ui = 0;
    if (!S.next(0, cur)) return;
    f32x4 acc[2][2][4][2];
#pragma unroll
    for (int a = 0; a < 2; ++a)
#pragma unroll
        for (int b = 0; b < 2; ++b)
#pragma unroll
            for (int m = 0; m < 4; ++m)
#pragma unroll
                for (int n = 0; n < 2; ++n) acc[a][b][m][n] = (f32x4){0.f, 0.f, 0.f, 0.f};
    bf16x8 At[4][2], B0[2][2], B1[2][2];
    const char* cA = (const char*)g.A + (size_t)cur.pm * tstep; const char* cB = (const char*)g.Bt + (size_t)cur.pn * tstep;
    if constexpr (Epi::CHAIN) { cA = (const char*)E.segA(cur.seg) + (size_t)cur.pm * tstep; cB = (const char*)E.segB(cur.seg) + (size_t)cur.pn * tstep; nt = E.segK(cur.seg) / BK; }
    S.a_ready(cur);
    if constexpr (SP2) {
        PG8_STAGE(PG8_SB(0, 0), cB, voffB); PG8_STAGE(PG8_SB(0, 1), cB + hstep, voffB); PG8_STAGE(PG8_SA(0, 0), cA, voffA); PG8_STAGE(PG8_SA(0, 1), cA + hstep, voffA);
        if (wr == 1) PG8_BAR;
        PG8_WAIT_V(2); PG8_BAR;
        PG8_STAGE(PG8_SB(1, 0), cB + kstep, voffB); PG8_STAGE(PG8_SA(1, 0), cA + kstep, voffA); PG8_STAGE(PG8_SB(1, 1), cB + hstep + kstep, voffB);
        PG8_WAIT_V(6); PG8_BAR;
    } else {
        PG8_STAGE(PG8_SB(0, 0), cB, voffB); PG8_STAGE(PG8_SA(0, 0), cA, voffA); PG8_STAGE(PG8_SB(0, 1), cB + hstep, voffB); PG8_STAGE(PG8_SA(0, 1), cA + hstep, voffA);
        if (wr == 1) PG8_BAR;
        PG8_WAIT_V(4); PG8_BAR;
        PG8_STAGE(PG8_SB(1, 0), cB + kstep, voffB); PG8_STAGE(PG8_SA(1, 0), cA + kstep, voffA); PG8_STAGE(PG8_SB(1, 1), cB + hstep + kstep, voffB);
        PG8_WAIT_V(6); PG8_BAR;
    }
    for (;;) {
        const bool has_next = S.next(ui + 1, nxt);
        const char* nA = has_next ? (const char*)g.A + (size_t)nxt.pm * tstep : cA; const char* nB = has_next ? (const char*)g.Bt + (size_t)nxt.pn * tstep : cB;
        int nt_next = nt;
        if constexpr (Epi::CHAIN) { if (has_next) { nA = (const char*)E.segA(nxt.seg) + (size_t)nxt.pm * tstep; nB = (const char*)E.segB(nxt.seg) + (size_t)nxt.pn * tstep; nt_next = E.segK(nxt.seg) / BK; } }
        for (int t = 0; t < nt; t += 2) {
            const bool last = (t == nt - 2);
            const char* a1 = cA + (size_t)(t + 1) * kstep;
            const char* a2 = last ? nA : cA + (size_t)(t + 2) * kstep; const char* b2 = last ? nB : cB + (size_t)(t + 2) * kstep;
            const char* a3 = a2 + kstep; const char* b3 = b2 + kstep;
            if (last && has_next) S.a_ready(nxt);
            if constexpr (SP2) {
            PG8_LDB(B0, 0, 0); PG8_LDB(B1, 0, 1); PG8_SCHED; PG8_LDA(At, 0, 0); PG8_STAGE(PG8_SA(1, 1), a1 + hstep, voffA);
            PG8_WAIT_V(8); PG8_WAIT_L(0); PG8_BAR; PG8_MMA(0, 0, At, B0); PG8_MMA(0, 1, At, B1); PG8_BAR; PG8_SCHED;
            PG8_LDA(At, 0, 1); PG8_STAGE(PG8_SB(0, 0), b2, voffB); PG8_STAGE(PG8_SB(0, 1), b2 + hstep, voffB); PG8_STAGE(PG8_SA(0, 0), a2, voffA);
            PG8_WAIT_V(8); PG8_WAIT_L(0); PG8_BAR; PG8_MMA(1, 0, At, B0); PG8_MMA(1, 1, At, B1); PG8_BAR; PG8_SCHED;
            PG8_LDB(B0, 1, 0); PG8_LDB(B1, 1, 1); PG8_SCHED; PG8_LDA(At, 1, 0); PG8_STAGE(PG8_SA(0, 1), a2 + hstep, voffA);
            PG8_WAIT_V(8); PG8_WAIT_L(0); PG8_BAR; PG8_MMA(0, 0, At, B0); PG8_MMA(0, 1, At, B1); PG8_BAR; PG8_SCHED;
            PG8_LDA(At, 1, 1); PG8_STAGE(PG8_SB(1, 0), b3, voffB); PG8_STAGE(PG8_SB(1, 1), b3 + hstep, voffB); PG8_STAGE(PG8_SA(1, 0), a3, voffA);
            PG8_WAIT_V(8); PG8_WAIT_L(0); PG8_BAR; PG8_MMA(1, 0, At, B0); PG8_MMA(1, 1, At, B1); PG8_BAR; PG8_SCHED;
            } else {
            PG8_LDB(B0, 0, 0); PG8_SCHED; PG8_LDA(At, 0, 0); PG8_STAGE(PG8_SA(1, 1), a1 + hstep, voffA);
            PG8_WAIT_L(8); PG8_BAR; PG8_WAIT_L(0); PG8_MMA(0, 0, At, B0); PG8_BAR; PG8_SCHED;
            PG8_LDB(B1, 0, 1); PG8_STAGE(PG8_SB(0, 0), b2, voffB);
            PG8_BAR; PG8_WAIT_L(0); PG8_MMA(0, 1, At, B1); PG8_BAR;
            PG8_LDA(At, 0, 1); PG8_STAGE(PG8_SA(0, 0), a2, voffA);
            PG8_BAR; PG8_WAIT_L(0); PG8_MMA(1, 0, At, B0); PG8_BAR; PG8_SCHED;
            PG8_STAGE(PG8_SB(0, 1), b2 + hstep, voffB);
            PG8_WAIT_V(6); PG8_BAR; PG8_MMA(1, 1, At, B1); PG8_BAR;
            PG8_LDB(B0, 1, 0); PG8_SCHED; PG8_LDA(At, 1, 0); PG8_STAGE(PG8_SA(0, 1), a2 + hstep, voffA);
            PG8_WAIT_L(8); PG8_BAR; PG8_WAIT_L(0); PG8_MMA(0, 0, At, B0); PG8_BAR; PG8_SCHED;
            PG8_LDB(B1, 1, 1); PG8_STAGE(PG8_SB(1, 0), b3, voffB);
            PG8_BAR; PG8_WAIT_L(0); PG8_MMA(0, 1, At, B1); PG8_BAR;
            PG8_LDA(At, 1, 1); PG8_STAGE(PG8_SA(1, 0), a3, voffA);
            PG8_BAR; PG8_WAIT_L(0); PG8_MMA(1, 0, At, B0); PG8_BAR; PG8_SCHED;
            PG8_STAGE(PG8_SB(1, 1), b3 + hstep, voffB);
            PG8_WAIT_V(6); PG8_BAR; PG8_MMA(1, 1, At, B1); PG8_BAR;
            }
        }
        if constexpr (ALIGN_EPI) { if (wr == 0) PG8_BAR; }
        if constexpr (Epi::CHAIN) { E.chain(acc, cur, wr, wc, fr, fq); S.done(cur); }
        else if constexpr (!Epi::AFTER_DRAIN) { E(acc, cur, wr, wc, fr, fq); S.done(cur); }
        if (!has_next) break;
        if (!Epi::CHAIN || cur.seg == 2)
#pragma unroll
        for (int a = 0; a < 2; ++a)
#pragma unroll
            for (int b = 0; b < 2; ++b)
#pragma unroll
                for (int m = 0; m < 4; ++m)
#pragma unroll
                    for (int n = 0; n < 2; ++n) acc[a][b][m][n] = (f32x4){0.f, 0.f, 0.f, 0.f};
        cur = nxt; cA = nA; cB = nB; nt = nt_next; ++ui;
        if constexpr (ALIGN_EPI) { if (wr == 1) PG8_BAR; }
    }
    PG8_WAIT_V(0);
    if constexpr (!ALIGN_EPI) { if (wr == 0) PG8_BAR; }
    PG8_BAR;
    if constexpr (Epi::AFTER_DRAIN) { E.fused(acc, cur, wr, wc, fr, fq, lds, wid, lane); S.done(cur); }
#undef PG8_SA
#undef PG8_SB
#undef PG8_STAGE
#undef PG8_LDA
#undef PG8_LDB
#undef PG8_MMA
#undef PG8_WAIT_V
#undef PG8_WAIT_L
#undef PG8_BAR
#undef PG8_SCHED
}
}

#define LAS __attribute__((address_space(3)))
typedef unsigned short bf16;
typedef unsigned v4u __attribute__((ext_vector_type(4)));
typedef unsigned v2u __attribute__((ext_vector_type(2)));
typedef float f32x4 __attribute__((ext_vector_type(4)));
constexpr int NWAVES = 8, NTHR = 512;
constexpr int LDS_BYTES = 147456;

typedef __bf16 bf16x2_t __attribute__((ext_vector_type(2)));
typedef float f32x2_t __attribute__((ext_vector_type(2)));
__device__ __forceinline__ unsigned pk2(float lo, float hi) { f32x2_t v = {lo, hi}; bf16x2_t b = __builtin_convertvector(v, bf16x2_t); return __builtin_bit_cast(unsigned, b); }
__device__ __forceinline__ unsigned f2bf(float f) { return pk2(f, 0.f) & 0xffffu; }
__device__ __forceinline__ float bflo(unsigned w) { return __builtin_bit_cast(float, w << 16); }
__device__ __forceinline__ float bfhi(unsigned w) { return __builtin_bit_cast(float, w & 0xffff0000u); }
__device__ __forceinline__ float bf2f(bf16 h) { return __builtin_bit_cast(float, (unsigned)h << 16); }
__device__ __forceinline__ float wave_sum(float v) {
#pragma unroll
    for (int o = 1; o < 64; o <<= 1) v += __shfl_xor(v, o);
    return v;
}
__device__ __forceinline__ float siluf(float x) { return x * __builtin_amdgcn_rcpf(1.0f + __expf(-x)); }

struct Params { const void* in[29]; float* out; unsigned char* ws; int lo, hi; };
enum { I_X = 0, I_MEM, I_POS, I_LN1G, I_WIN, I_WGATE, I_BGATE, I_DAQN, I_DAKN, I_LQ1, I_LK1, I_LQ2, I_LK2, I_SUBLN, I_WODIFF, I_WCONV, I_ALOG, I_DTB, I_GDNN, I_WODELTA,
       I_MEMN, I_WMEMKV, I_CAQN, I_CAKN, I_WOCROSS, I_WOUT, I_LN2G, I_WMLP1, I_WMLP2 };

struct TrItem { const float* W; const float* kscale; bf16* WT; int ldw, K, src_col0, dst_row0, k0; };
__device__ __forceinline__ void p0_item_load(const TrItem& d, int lane, float (&v)[32]) {
    const float* src = d.W + (size_t)(d.k0 + (lane >> 5)) * d.ldw + d.src_col0 + (lane & 31);
#pragma unroll
    for (int i = 0; i < 32; ++i) v[i] = src[(size_t)(2 * i) * d.ldw];
}
__device__ __forceinline__ void p0_item_finish(const TrItem& d, int lane, const float (&v)[32], float* scr) {
#pragma unroll
    for (int i = 0; i < 32; ++i) { const int kk = 2 * i + (lane >> 5); float x = v[i]; if (d.kscale) x *= d.kscale[d.k0 + kk]; scr[kk * 33 + (lane & 31)] = x; }
    __builtin_amdgcn_wave_barrier(); asm volatile("s_waitcnt lgkmcnt(0)" ::: "memory");
    const int c = lane & 7;
#pragma unroll
    for (int j = 0; j < 4; ++j) { const int n = (lane >> 3) + 8 * j; const float* s = scr + (8 * c) * 33 + n;
        v4u o; o.x = pk2(s[0 * 33], s[1 * 33]); o.y = pk2(s[2 * 33], s[3 * 33]); o.z = pk2(s[4 * 33], s[5 * 33]); o.w = pk2(s[6 * 33], s[7 * 33]);
        *(v4u*)(d.WT + (size_t)(d.dst_row0 + n) * d.K + d.k0 + 8 * c) = o; }
    asm volatile("s_waitcnt lgkmcnt(0)" ::: "memory"); __builtin_amdgcn_wave_barrier();
}
constexpr int P0_I1 = 16 * 280, P0_I2 = 12 * 32, P0_I3 = 12 * 32, P0_I4 = 8 * 32, P0_I5 = 16 * 32, P0_I6 = 16 * 128, P0_I7 = 64 * 32, P0_I8 = 16 * 32;
constexpr int P0_NITEMS = P0_I1 + P0_I2 + P0_I3 + P0_I4 + P0_I5 + P0_I6 + P0_I7 + P0_I8;
__device__ __forceinline__ TrItem p0_item_decode(const Params& P, int it) {
    unsigned char* ws = P.ws; TrItem d; d.kscale = nullptr; int r = it;
    if (r < P0_I1) { const int kb = r / 280, g = r % 280, p0 = 32 * g; d.K = 1024; d.k0 = 64 * kb; d.dst_row0 = p0; d.WT = (bf16*)(ws + WS_W1T);
        if (p0 < 1536) { const int gi = g & 7; d.W = (const float*)P.in[I_WIN]; d.ldw = DIN; d.src_col0 = (p0 & ~255) + 32 * (2 * (gi & 3) + (gi >> 2)); }
        else if (p0 < 5376) { d.W = (const float*)P.in[I_WIN]; d.ldw = DIN; d.src_col0 = p0; }
        else if (p0 < 5888) { d.W = (const float*)P.in[I_WIN]; d.ldw = DIN; d.src_col0 = 5388 + (p0 - 5376); }
        else { d.W = (const float*)P.in[I_WGATE]; d.ldw = NGATE; d.src_col0 = p0 - 5888; }
        return d; } r -= P0_I1;
    if (r < P0_I2) { d.W = (const float*)P.in[I_WODIFF]; d.ldw = 1024; d.K = 768; d.src_col0 = d.dst_row0 = 32 * (r % 32); d.k0 = 64 * (r / 32); d.WT = (bf16*)(ws + WS_WOD); return d; } r -= P0_I2;
    if (r < P0_I3) { d.W = (const float*)P.in[I_WODELTA]; d.ldw = 1024; d.K = 768; d.src_col0 = d.dst_row0 = 32 * (r % 32); d.k0 = 64 * (r / 32); d.WT = (bf16*)(ws + WS_WODL); return d; } r -= P0_I3;
    if (r < P0_I4) { d.W = (const float*)P.in[I_WOCROSS]; d.ldw = 1024; d.K = 768;     d.src_col0 = d.dst_row0 = 32 * (r % 32); d.k0 = 64 * (r / 32); d.WT = (bf16*)(ws + WS_WOC); return d; } r -= P0_I4;
    if (r < P0_I5) { d.W = (const float*)P.in[I_WOUT]; d.ldw = 1024; d.K = 1024; d.src_col0 = d.dst_row0 = 32 * (r % 32); d.k0 = 64 * (r / 32); d.WT = (bf16*)(ws + WS_WOUT); return d; } r -= P0_I5;
    if (r < P0_I6) { d.W = (const float*)P.in[I_WMLP1]; d.ldw = DFF; d.K = 1024; d.src_col0 = d.dst_row0 = 32 * (r % 128); d.k0 = 64 * (r / 128); d.WT = (bf16*)(ws + WS_WM1); d.kscale = (const float*)P.in[I_LN2G]; return d; } r -= P0_I6;
    if (r < P0_I7) { d.W = (const float*)P.in[I_WMLP2]; d.ldw = 1024; d.K = DFF; d.src_col0 = d.dst_row0 = 32 * (r % 32); d.k0 = 64 * (r / 32); d.WT = (bf16*)(ws + WS_WM2); return d; } r -= P0_I7;
    d.W = (const float*)P.in[I_WMEMKV]; d.ldw = 1024; d.K = 1024; d.src_col0 = d.dst_row0 = 32 * (r % 32); d.k0 = 64 * (r / 32); d.WT = (bf16*)(ws + WS_WMEM); return d;
}

constexpr int P0_NEARLY = P0_I1 + P0_I8, P0_NLATE = P0_NITEMS - P0_NEARLY;
template <bool EARLY>
__device__ __forceinline__ void p0_items(const Params& P, unsigned char* lds, int lane, int wave, int gw, int NGW) {
    float* scr = (float*)(lds + wave * 8448);
    constexpr int N = EARLY ? P0_NEARLY : P0_NLATE;
#pragma unroll 1
    for (int e = gw; e < N; e += 3 * NGW) {
        const bool two = e + NGW < N, three = e + 2 * NGW < N;
        const int e1 = two ? e + NGW : e, e2 = three ? e + 2 * NGW : e;
        const int ia = EARLY ? (e < P0_I1 ? e : e + P0_NLATE) : P0_I1 + e, ib = EARLY ? (e1 < P0_I1 ? e1 : e1 + P0_NLATE) : P0_I1 + e1, ic = EARLY ? (e2 < P0_I1 ? e2 : e2 + P0_NLATE) : P0_I1 + e2;
        float va[32], vb[32], vc[32];
        const TrItem da = p0_item_decode(P, ia); p0_item_load(da, lane, va);
        const TrItem db = p0_item_decode(P, ib); if (two) p0_item_load(db, lane, vb);
        const TrItem dc = p0_item_decode(P, ic); if (three) p0_item_load(dc, lane, vc);
        p0_item_finish(da, lane, va, scr);
        if (two) p0_item_finish(db, lane, vb, scr);
        if (three) p0_item_finish(dc, lane, vc, scr);
    }
}
__device__ __forceinline__ void p0_prologue(const Params& P, unsigned char* lds, int tid, int lane, int wave) {
    const int G = gridDim.x, gw = blockIdx.x * NWAVES + wave, NGW = G * NWAVES;
    unsigned char* ws = P.ws;
    float* scr = (float*)(lds + wave * 8448);
    float* w12t = (float*)(lds + 73728);
    const float* w_in = (const float*)P.in[I_WIN];
    float w12r[24];
#pragma unroll
    for (int q = 0; q < 24; ++q) { const int i = tid + q * NTHR, c = i >> 10, k = i & 1023; w12r[q] = w_in[(size_t)k * DIN + 5376 + c]; }
    p0_items<true>(P, lds, lane, wave, gw, NGW);
#pragma unroll
    for (int q = 0; q < 24; ++q) w12t[tid + q * NTHR] = w12r[q];
    __syncthreads();
#ifdef PROBE_A
    if (blockIdx.x == 0 && tid == 0) ((unsigned long long*)(ws + WS_MISC + 32768))[11] = __builtin_amdgcn_s_memrealtime();
#endif
    {
        const float* x = (const float*)P.in[I_X]; const float* g1 = (const float*)P.in[I_LN1G];
        const float* alog = (const float*)P.in[I_ALOG]; const float* dtb = (const float*)P.in[I_DTB];
        bf16* HB = (bf16*)((unsigned char*)P.out + OUT_HB); float* BT = (float*)(ws + WS_BT); float* LA = (float*)(ws + WS_LA);
        f32x4 gv[4];
#pragma unroll
        for (int j = 0; j < 4; ++j) gv[j] = ((const f32x4*)g1)[lane + 64 * j];
        f32x4 vn[2][4];
#pragma unroll
        for (int r = 0; r < 2; ++r) if (gw + r * NGW < MTOK) {
#pragma unroll
            for (int j = 0; j < 4; ++j) vn[r][j] = ((const f32x4*)(x + (size_t)(gw + r * NGW) * DM) + lane)[64 * j]; }
#pragma unroll 1
        for (int m = gw; m < MTOK; m += 2 * NGW) {
            const bool has1 = m + NGW < MTOK;
            f32x4 v[2][4]; float pd[2][13];
#pragma unroll
            for (int r = 0; r < 2; ++r)
#pragma unroll
                for (int j = 0; j < 4; ++j) v[r][j] = vn[r][j];
#pragma unroll
            for (int r = 0; r < 2; ++r) if (m + (2 + r) * NGW < MTOK) {
#pragma unroll
                for (int j = 0; j < 4; ++j) vn[r][j] = ((const f32x4*)(x + (size_t)(m + (2 + r) * NGW) * DM) + lane)[64 * j]; }
#pragma unroll
            for (int r = 0; r < 2; ++r) { float s = 0.f;
#pragma unroll
                for (int j = 0; j < 4; ++j) { s += (v[r][j].x * v[r][j].x + v[r][j].y * v[r][j].y) + (v[r][j].z * v[r][j].z + v[r][j].w * v[r][j].w); v[r][j] = v[r][j] * gv[j]; }
                pd[r][12] = s; }
#pragma unroll
            for (int c = 0; c < 12; ++c) { float p0 = 0.f, p1 = 0.f;
#pragma unroll
                for (int j = 0; j < 4; ++j) { const f32x4 w = *(const f32x4*)(w12t + c * 1024 + 4 * lane + 256 * j);
                    p0 += (v[0][j].x * w.x + v[0][j].y * w.y) + (v[0][j].z * w.z + v[0][j].w * w.w); p1 += (v[1][j].x * w.x + v[1][j].y * w.y) + (v[1][j].z * w.z + v[1][j].w * w.w); }
                pd[0][c] = p0; pd[1][c] = p1; }
            float q8[2][8], q4[2][4], q2[2][2], q1[2];
#pragma unroll
            for (int i = 0; i < 8; ++i)
#pragma unroll
                for (int r = 0; r < 2; ++r) { const float lo = pd[r][i], hi = (i + 8 < 13) ? pd[r][i + 8] : 0.f; const bool up = (lane & 32) != 0; q8[r][i] = (up ? hi : lo) + __shfl_xor(up ? lo : hi, 32); }
#pragma unroll
            for (int i = 0; i < 4; ++i)
#pragma unroll
                for (int r = 0; r < 2; ++r) { const bool up = (lane & 16) != 0; q4[r][i] = (up ? q8[r][i + 4] : q8[r][i]) + __shfl_xor(up ? q8[r][i] : q8[r][i + 4], 16); }
#pragma unroll
            for (int i = 0; i < 2; ++i)
#pragma unroll
                for (int r = 0; r < 2; ++r) { const bool up = (lane & 8) != 0; q2[r][i] = (up ? q4[r][i + 2] : q4[r][i]) + __shfl_xor(up ? q4[r][i] : q4[r][i + 2], 8); }
#pragma unroll
            for (int r = 0; r < 2; ++r) { const bool up = (lane & 4) != 0; q1[r] = (up ? q2[r][1] : q2[r][0]) + __shfl_xor(up ? q2[r][0] : q2[r][1], 4); }
#pragma unroll
            for (int r = 0; r < 2; ++r) q1[r] += __shfl_xor(q1[r], 1);
#pragma unroll
            for (int r = 0; r < 2; ++r) q1[r] += __shfl_xor(q1[r], 2);
            const int slot = ((lane >> 5) & 1) * 8 + ((lane >> 4) & 1) * 4 + ((lane >> 3) & 1) * 2 + ((lane >> 2) & 1);
#pragma unroll
            for (int r = 0; r < 2; ++r) if (r == 0 || has1) { const int mr = m + r * NGW;
                const float rstd = 1.0f / sqrtf(__shfl(q1[r], 48) * (1.0f / DM) + EPS);
                unsigned long long* o8 = (unsigned long long*)(HB + (size_t)mr * DM) + lane;
#pragma unroll
                for (int j = 0; j < 4; ++j) { const f32x4 hv = v[r][j] * rstd; o8[64 * j] = (unsigned long long)pk2(hv.x, hv.y) | ((unsigned long long)pk2(hv.z, hv.w) << 32); }
                if ((lane & 3) == 0) { const float dot = q1[r] * rstd;
                    if (slot < 6) BT[(size_t)mr * 6 + slot] = 1.0f / (1.0f + expf(-dot));
                    else if (slot < 12) { const int hh = slot - 6; const float z = dot + dtb[hh]; const float sp = (z > 20.f) ? z : log1pf(expf(z)); LA[(size_t)mr * 6 + hh] = -expf(alog[hh]) * sp; }
                } }
        }
    }
    {
        const float* mem = (const float*)P.in[I_MEM]; const float* g = (const float*)P.in[I_MEMN]; bf16* MN = (bf16*)(ws + WS_MN);
        for (int m = gw; m < MEMROWS; m += NGW) {
            const f32x4* xr = (const f32x4*)(mem + (size_t)m * DM) + lane;
            f32x4 v[4]; float s = 0.f;
#pragma unroll
            for (int j = 0; j < 4; ++j) { v[j] = xr[64 * j]; s += (v[j].x * v[j].x + v[j].y * v[j].y) + (v[j].z * v[j].z + v[j].w * v[j].w); }
            const float rstd = 1.0f / sqrtf(wave_sum(s) * (1.0f / DM) + EPS);
            unsigned long long* o8 = (unsigned long long*)(MN + (size_t)m * DM) + lane;
#pragma unroll
            for (int j = 0; j < 4; ++j) { const f32x4 gg = ((const f32x4*)g)[lane + 64 * j]; const f32x4 y = (v[j] * rstd) * gg; o8[64 * j] = (unsigned long long)pk2(y.x, y.y) | ((unsigned long long)pk2(y.z, y.w) << 32); }
        }
    }
    {
        const int* pos = (const int*)P.in[I_POS]; float* RC = (float*)(ws + WS_ROPEC); float* RS = (float*)(ws + WS_ROPES); float* rowss = (float*)(ws + WS_ROWSS);
        const int gt = blockIdx.x * NTHR + tid, NGT = G * NTHR;
        for (int i = gt; i < MTOK * 32; i += NGT) { const int row = i >> 5, j = i & 31;
            const float inv = expf((-9.210340371976184f * (float)j) / 32.0f); const float ang = (float)pos[row] * inv;
            double rev = (double)ang * 0.15915494309189535; rev -= rint(rev); const float rf = (float)rev;
            RC[i] = __builtin_amdgcn_cosf(rf); RS[i] = __builtin_amdgcn_sinf(rf); }
        for (int i = gt; i < MTOK; i += NGT) rowss[i] = 0.f;
        if (blockIdx.x == 0 && wave == 0) {
            const float a = ((const float*)P.in[I_LQ1])[lane] * ((const float*)P.in[I_LK1])[lane], b = ((const float*)P.in[I_LQ2])[lane] * ((const float*)P.in[I_LK2])[lane];
            const float sa = wave_sum(a), sb = wave_sum(b);
            if (lane == 0) { ((float*)(ws + WS_MISC))[0] = expf(sa) - expf(sb) + LAM_INIT; ((int*)(ws + WS_MISC))[1] = 0; }
        }
    }
}

__device__ __forceinline__ void p2a_qknorm_rope(const Params& P, int lane, int wave) {
    const int gw = blockIdx.x * NWAVES + wave, NGW = gridDim.x * NWAVES;
    unsigned char* ws = P.ws; const float* RC = (const float*)(ws + WS_ROPEC); const float* RS = (const float*)(ws + WS_ROPES);
    const float* qg = (const float*)P.in[I_DAQN]; const float* kg = (const float*)P.in[I_DAKN];
    {
        const float* g = (const float*)P.in[I_CAKN];
        for (int it = gw; it < MEMROWS * 4; it += NGW) { unsigned* p = (unsigned*)((bf16*)(ws + WS_MKV) + (size_t)(it >> 2) * 1024 + (it & 3) * 128) + lane;
            const unsigned w = *p; float a = bflo(w), c = bfhi(w); const float ss = wave_sum(a * a + c * c); const float sc = 1.0f / sqrtf(ss * (1.0f / 128.0f) + EPS);
            *p = pk2(a * sc * g[2 * lane], c * sc * g[2 * lane + 1]); }
    }
}

typedef short bf16x8 __attribute__((ext_vector_type(8)));
typedef short s16x4 __attribute__((ext_vector_type(4)));
typedef float f32x16 __attribute__((ext_vector_type(16)));
#define MFMA32(a, b, c) __builtin_amdgcn_mfma_f32_32x32x16_bf16((a), (b), (c), 0, 0, 0)
__device__ __forceinline__ float max3f(float a, float b, float c) { float r; asm("v_max3_f32 %0, %1, %2, %3" : "=v"(r) : "v"(a), "v"(b), "v"(c)); return r; }
__device__ __forceinline__ unsigned cvtpk(float lo, float hi) { f32x2_t v = {lo, hi}; bf16x2_t b = __builtin_convertvector(v, bf16x2_t); return __builtin_bit_cast(unsigned, b); }
__device__ __forceinline__ unsigned off_b(unsigned row, unsigned ch) { return 256u * row + 16u * (ch ^ (((row & 3u) << 2) | ((row >> 2) & 3u))); }
__device__ __forceinline__ s16x4 vtr(const unsigned char* p) { typedef short v4i16_t __attribute__((ext_vector_type(4))); return __builtin_bit_cast(s16x4, __builtin_amdgcn_ds_read_tr16_b64_v4i16((LAS v4i16_t*)p)); }
__device__ __forceinline__ bf16x8 pack8f(const f32x16& x, int s2) { v4u w; w.x = cvtpk(x[8 * s2], x[8 * s2 + 1]); w.y = cvtpk(x[8 * s2 + 2], x[8 * s2 + 3]); w.z = cvtpk(x[8 * s2 + 4], x[8 * s2 + 5]); w.w = cvtpk(x[8 * s2 + 6], x[8 * s2 + 7]); return __builtin_bit_cast(bf16x8, w); }

__device__ __forceinline__ void mk_kx(int lane, unsigned (&kx)[8]) { const unsigned r = lane & 31, h5 = lane >> 5, X = ((r & 3u) << 2) | ((r >> 2) & 3u);
#pragma unroll
    for (int k = 0; k < 8; ++k) kx[k] = 256u * r + 16u * ((unsigned)(2 * k + h5) ^ X); }
__device__ __forceinline__ void mk_qkx(int lane, unsigned (&qkx)[4]) { const unsigned r = lane & 31, h5 = lane >> 5, ir = r >> 1, X2 = ((ir & 3u) << 2) | ((ir >> 2) & 3u);
#pragma unroll
    for (int k = 0; k < 4; ++k) qkx[k] = 256u * ir + 16u * ((unsigned)(8 * (r & 1) + 2 * k + h5) ^ X2); }
__device__ __forceinline__ void mk_vaddr(int lane, unsigned (&vaddr)[2][4]) { const unsigned h5 = lane >> 5, blk = (lane >> 4) & 1, q = (lane & 15) >> 2, p = lane & 3;
#pragma unroll
    for (int t = 0; t < 2; ++t)
#pragma unroll
        for (int db = 0; db < 4; ++db) vaddr[t][db] = 256u * (8 * t + 4 * h5 + q) + 16u * ((((unsigned)db ^ q) << 2) | ((2 * blk + (p >> 1)) ^ ((2 * t + h5) & 3u))) + 8u * (p & 1); }
template <bool CROSS>
__device__ __forceinline__ void attn_mfma_unit(const Params& P, unsigned char* lds, int tid_in, int b, int h, int qb) {
    int tid = mk_tid(tid_in); asm volatile("" : "+v"(tid)); const int lane = tid & 63, wave = __builtin_amdgcn_readfirstlane(tid >> 6);
    constexpr int NKS = CROSS ? 8 : 4;
    unsigned char* ws = P.ws;
    LAS unsigned char* lds3 = (LAS unsigned char*)lds;
    const int r = lane & 31, hh = lane >> 5;
    const int mp = CROSS ? 0 : (wave & 1), qsub = CROSS ? wave : (wave >> 1);
    const int nt = CROSS ? 4 : 2 * qb + 2;
    const int my_nt = (!CROSS && qsub < 2) ? nt - 1 : nt;
    const bf16* Kg; const bf16* Vg; bf16* Qg; int ldk, ldq;
    if (CROSS) { Kg = (const bf16*)(ws + WS_MKV) + (size_t)b * NMEM * 1024 + h * 128; Vg = Kg + 512; ldk = 1024; Qg = (bf16*)((unsigned char*)P.out + OUT_CAQ) + ((size_t)b * SEQ + (size_t)qb * 256) * 768 + h * 128; ldq = 768; }
    else { Kg = (const bf16*)(ws + WS_DAK) + (size_t)b * SEQ * 768 + h * 128; Vg = (const bf16*)(ws + WS_DAV) + (size_t)b * SEQ * 768 + h * 128; ldk = 768; Qg = (bf16*)(ws + WS_DAQ) + ((size_t)b * SEQ + (size_t)qb * 128) * 768 + h * 128; ldq = 768; }
    unsigned gsrc[2];
#pragma unroll
    for (int i = 0; i < 2; ++i) { const unsigned p = i * 512 + tid, row = p >> 4, ch = (p & 15u) ^ (((row & 3u) << 2) | ((row >> 2) & 3u)); gsrc[i] = (row * ldk + ch * 8) * 2; }
    const unsigned ldsw = (unsigned)wave * 1024u;
#define ATT_DMA(t_) do { const size_t go_ = (size_t)(t_) * 64 * ldk * 2; const unsigned sl_ = ((unsigned)(t_) & 3u) * 32768u; \
        _Pragma("unroll") for (int i_ = 0; i_ < 2; ++i_) { \
            __builtin_amdgcn_global_load_lds((const unsigned*)((const char*)Kg + go_ + gsrc[i_]), (LAS unsigned*)(lds3 + sl_ + i_ * 8192 + ldsw), 16, 0, 0); \
            __builtin_amdgcn_global_load_lds((const unsigned*)((const char*)Vg + go_ + gsrc[i_]), (LAS unsigned*)(lds3 + sl_ + 16384 + i_ * 8192 + ldsw), 16, 0, 0); } } while (0)
    __syncthreads();
    ATT_DMA(0); if (nt > 1) ATT_DMA(1);
    bf16x8 qf[NKS];
    {
        const bf16* qp = Qg + (size_t)(qsub * 32 + r) * ldq + mp * 64 + 8 * hh;
#pragma unroll
        for (int s = 0; s < NKS; ++s) qf[s] = *(const bf16x8*)(qp + 16 * s);
        if (CROSS) {
            float ss = 0.f;
#pragma unroll
            for (int s = 0; s < NKS; ++s)
#pragma unroll
                for (int j = 0; j < 8; ++j) { const float v = bf2f((bf16)qf[s][j]); ss += v * v; }
            ss += __shfl_xor(ss, 32);
            const float scl = C2_CA / sqrtf(ss * (1.0f / 128.0f) + EPS); const float* g = (const float*)P.in[I_CAQN] + 8 * hh;
#pragma unroll
            for (int s = 0; s < NKS; ++s) { v4u w;
                float t[8];
#pragma unroll
                for (int j = 0; j < 8; ++j) t[j] = bf2f((bf16)qf[s][j]) * scl * g[16 * s + j];
                w.x = cvtpk(t[0], t[1]); w.y = cvtpk(t[2], t[3]); w.z = cvtpk(t[4], t[5]); w.w = cvtpk(t[6], t[7]); qf[s] = __builtin_bit_cast(bf16x8, w); }
        }
#pragma unroll
        for (int s = 0; s < NKS; ++s) asm volatile("" : "+v"(qf[s]));
    }
    f32x16 ot[4];
#pragma unroll
    for (int db = 0; db < 4; ++db)
#pragma unroll
        for (int i = 0; i < 16; ++i) ot[db][i] = 0.f;
    float m_run = 0.f, l_run = 0.f;
    f32x16 negm;
#pragma unroll
    for (int i = 0; i < 16; ++i) negm[i] = 0.f;
    const unsigned lbase = (unsigned)(uintptr_t)lds;
    unsigned kaddr[NKS], vaddr[2][4];
    { const unsigned X = ((r & 3u) << 2) | ((r >> 2) & 3u);
#pragma unroll
      for (int s = 0; s < NKS; ++s) kaddr[s] = 256u * r + 16u * ((unsigned)(8 * mp + 2 * s + hh) ^ X);
      mk_vaddr(lane, vaddr); }
    bf16x8 pf[4];
#define ATT_H1(kt_) do { \
            const unsigned char* kb_ = lds + ((kt_) & 3) * 32768; \
            f32x16 st0 = negm, st1 = negm;                      \
            if (ATT_EXP == 1) { f32x16 d0 = negm, d1 = negm; _Pragma("unroll") for (int s = 0; s < NKS; ++s) { const bf16x8 a0 = *(const bf16x8*)(kb_ + kaddr[s]), a1 = *(const bf16x8*)(kb_ + 8192 + kaddr[s]); d0 = MFMA32(a0, qf[s], d0); d1 = MFMA32(a1, qf[s], d1); } asm volatile("" :: "v"(d0), "v"(d1)); } \
            _Pragma("unroll") for (int s = 0; s < NKS; ++s) { const bf16x8 a0 = *(const bf16x8*)(kb_ + kaddr[s]), a1 = *(const bf16x8*)(kb_ + 8192 + kaddr[s]); st0 = MFMA32(a0, qf[s], st0); st1 = MFMA32(a1, qf[s], st1); } \
            float tm = max3f(st0[0], st1[0], st0[1]); \
            _Pragma("unroll") for (int i = 1; i < 15; i += 2) { tm = max3f(tm, st1[i], st0[i + 1]); tm = max3f(tm, st1[i + 1], st0[i + 2]); } \
            tm = max3f(tm, st1[15], st0[15]); \
            tm = max3f(tm, __shfl_xor(tm, 32), tm); \
            if (__any(tm > 0.f)) {                              \
                const float dl = fmaxf(tm, 0.f), alpha = __builtin_amdgcn_exp2f(-dl); m_run += dl; l_run *= alpha; \
                _Pragma("unroll") for (int i = 0; i < 16; ++i) { st0[i] -= dl; st1[i] -= dl; negm[i] = -m_run; } \
                _Pragma("unroll") for (int db = 0; db < 4; ++db) _Pragma("unroll") for (int i = 0; i < 16; ++i) ot[db][i] *= alpha; } \
            float ps = 0.f; \
            _Pragma("unroll") for (int i = 0; i < 16; ++i) { st0[i] = __builtin_amdgcn_exp2f(st0[i]); st1[i] = __builtin_amdgcn_exp2f(st1[i]); ps += st0[i] + st1[i]; } \
            l_run += ps; \
            if (ATT_EXP == 2) { float dd = 0.f; _Pragma("unroll") for (int i = 0; i < 16; ++i) { float a_ = st0[i] * 1.5f, b_ = st1[i] * 1.5f; asm volatile("" : "+v"(a_), "+v"(b_)); dd += __builtin_amdgcn_exp2f(a_) + __builtin_amdgcn_exp2f(b_); } asm volatile("" :: "v"(dd)); } \
            pf[0] = pack8f(st0, 0); pf[1] = pack8f(st0, 1); pf[2] = pack8f(st1, 0); pf[3] = pack8f(st1, 1); } while (0)
#define TRR(dst, addr, off) asm volatile("ds_read_b64_tr_b16 %0, %1 offset:%c2" : "=&v"(dst) : "v"(addr), "i"(off) : "memory")
#define TRR8(tl, th, db_) do { const unsigned a0_ = vbase + vaddr[0][db_], a1_ = vbase + vaddr[1][db_]; \
                TRR(tl[0], a0_, 0); TRR(th[0], a1_, 0); TRR(tl[1], a0_, 4096); TRR(th[1], a1_, 4096); TRR(tl[2], a0_, 8192); TRR(th[2], a1_, 8192); TRR(tl[3], a0_, 12288); TRR(th[3], a1_, 12288); } while (0)
#define TRWAIT(n_, tl, th) do { asm volatile("s_waitcnt lgkmcnt(" #n_ ")" : "+v"(tl[0]), "+v"(th[0]), "+v"(tl[1]), "+v"(th[1]), "+v"(tl[2]), "+v"(th[2]), "+v"(tl[3]), "+v"(th[3]) :: "memory"); __builtin_amdgcn_sched_barrier(0); } while (0)
#define PVMM(tl, th, db_) do { __builtin_amdgcn_s_setprio(1); _Pragma("unroll") for (int ks = 0; ks < 4; ++ks) { const bf16x8 vf = __builtin_shufflevector(tl[ks], th[ks], 0, 1, 2, 3, 4, 5, 6, 7); ot[db_] = MFMA32(vf, pf[ks], ot[db_]); } __builtin_amdgcn_s_setprio(0); } while (0)
#define PVMM2(tl, th, acc_) do { _Pragma("unroll") for (int ks = 0; ks < 4; ++ks) { const bf16x8 vf = __builtin_shufflevector(tl[ks], th[ks], 0, 1, 2, 3, 4, 5, 6, 7); acc_ = MFMA32(vf, pf[ks], acc_); } } while (0)
#ifndef ATT_EXP
#define ATT_EXP 0
#endif
#define ATT_H2(kt_) do { \
            const unsigned vbase = lbase + ((kt_) & 3) * 32768 + 16384; \
            s16x4 tlA[4], thA[4], tlB[4], thB[4]; \
            TRR8(tlA, thA, 0); \
            TRR8(tlB, thB, 1); TRWAIT(8, tlA, thA); PVMM(tlA, thA, 0); \
            TRR8(tlA, thA, 2); TRWAIT(8, tlB, thB); PVMM(tlB, thB, 1); \
            TRR8(tlB, thB, 3); TRWAIT(8, tlA, thA); PVMM(tlA, thA, 2); \
            TRWAIT(0, tlB, thB); PVMM(tlB, thB, 3); \
            if (ATT_EXP == 3) { f32x16 dz; _Pragma("unroll") for (int i = 0; i < 16; ++i) dz[i] = 0.f; _Pragma("unroll") for (int rep = 0; rep < 4; ++rep) { PVMM2(tlA, thA, dz); } asm volatile("" :: "v"(dz)); } } while (0)
#ifndef ATT_STAGGER
#define ATT_STAGGER 0
#endif
    const bool late = ATT_STAGGER == 1 ? wave >= 4 : ATT_STAGGER == 2 ? (wave & 1) != 0 : ATT_STAGGER == 3 ? (wave & 2) != 0 : false;
#pragma unroll 1
    for (int kt = 0; kt < nt; ++kt) {
        if (kt + 1 < nt) asm volatile("s_waitcnt vmcnt(4)\n\ts_barrier" ::: "memory");
        else asm volatile("s_waitcnt vmcnt(0)\n\ts_barrier" ::: "memory");
        if (kt + 2 < nt) ATT_DMA(kt + 2);
        if (!late) { if (kt < my_nt) { ATT_H1(kt); ATT_H2(kt); } }
        else { if (kt >= 1 && kt - 1 < my_nt) ATT_H2(kt - 1); if (kt < my_nt) ATT_H1(kt); }
    }
    if (late && nt - 1 < my_nt) ATT_H2(nt - 1);
#undef ATT_H1
#undef ATT_H2
#undef TRR
#undef TRR8
#undef TRWAIT
#undef PVMM
#undef ATT_DMA
    __syncthreads();
    l_run += __shfl_xor(l_run, 32);
    const float rl = 1.0f / l_run;
    bf16* Og = Qg + (size_t)(qsub * 32 + r) * ldq;
    if (CROSS) {
#pragma unroll
        for (int db = 0; db < 4; ++db)
#pragma unroll
            for (int g = 0; g < 4; ++g) { v2u w; w.x = cvtpk(ot[db][4 * g] * rl, ot[db][4 * g + 1] * rl); w.y = cvtpk(ot[db][4 * g + 2] * rl, ot[db][4 * g + 3] * rl);
                *(v2u*)(Og + 32 * db + 8 * g + 4 * hh) = w; }
    } else {
        float* xch = (float*)lds + (wave >> 1) * 4096;
        const float lam = ((const float*)(ws + WS_MISC))[0];
        if (mp == 1) {
            const float f = rl * lam;
#pragma unroll
            for (int db = 0; db < 4; ++db)
#pragma unroll
                for (int i = 0; i < 16; ++i) xch[(db * 16 + i) * 64 + lane] = ot[db][i] * f;
        }
        __syncthreads();
        if (mp == 0) {
            float ss = 0.f;
#pragma unroll
            for (int db = 0; db < 4; ++db)
#pragma unroll
                for (int i = 0; i < 16; ++i) { const float v = ot[db][i] * rl - xch[(db * 16 + i) * 64 + lane]; ot[db][i] = v; ss += v * v; }
            ss += __shfl_xor(ss, 32);
            const float scl = (1.0f - LAM_INIT) / sqrtf(ss * (1.0f / 128.0f) + EPS); const float* gp = (const float*)P.in[I_SUBLN] + 4 * hh;
#pragma unroll
            for (int db = 0; db < 4; ++db)
#pragma unroll
                for (int g = 0; g < 4; ++g) { const f32x4 gg = *(const f32x4*)(gp + 32 * db + 8 * g);
                    v2u w; w.x = cvtpk(ot[db][4 * g] * scl * gg.x, ot[db][4 * g + 1] * scl * gg.y); w.y = cvtpk(ot[db][4 * g + 2] * scl * gg.z, ot[db][4 * g + 3] * scl * gg.w);
                    *(v2u*)(Og + 32 * db + 8 * g + 4 * hh) = w; }
        }
    }
}

#ifndef PIPE_PIN
#define PIPE_PIN 0
#endif
#ifndef PIPE_XBAR
#define PIPE_XBAR 0
#endif
__device__ __forceinline__ void attn_pipe_unit(const Params& P, unsigned char* lds, int wave_s, int b, int h, int qb) {
    int tid = mk_tid(wave_s); asm volatile("" : "+v"(tid)); const int lane = tid & 63, wave = __builtin_amdgcn_readfirstlane(tid >> 6);
    unsigned char* ws = P.ws;
    LAS unsigned char* lds3 = (LAS unsigned char*)lds;
    const int r = lane & 31, hh = lane >> 5;
    const int mp = wave & 1, qsub = wave >> 1;
    const int nt = 2 * qb + 2, my_nt = (qsub < 2) ? nt - 1 : nt;
    const bf16* Kg = (const bf16*)(ws + WS_DAK) + (size_t)b * SEQ * 768 + h * 128; const bf16* Vg = (const bf16*)(ws + WS_DAV) + (size_t)b * SEQ * 768 + h * 128;
    bf16* Qg = (bf16*)(ws + WS_DAQ) + ((size_t)b * SEQ + (size_t)qb * 128) * 768 + h * 128;
    unsigned gsrc[2];
#pragma unroll
    for (int i = 0; i < 2; ++i) { const unsigned p = i * 512 + tid, row = p >> 4, ch = (p & 15u) ^ (((row & 3u) << 2) | ((row >> 2) & 3u)); gsrc[i] = (row * 768 + ch * 8) * 2; }
    const unsigned ldsw = (unsigned)wave * 1024u;
#define ATT_DMA(t_) do { const size_t go_ = (size_t)(t_) * 64 * 768 * 2; const unsigned sl_ = ((unsigned)(t_) & 3u) * 32768u; \
        _Pragma("unroll") for (int i_ = 0; i_ < 2; ++i_) { \
            __builtin_amdgcn_global_load_lds((const unsigned*)((const char*)Kg + go_ + gsrc[i_]), (LAS unsigned*)(lds3 + sl_ + i_ * 8192 + ldsw), 16, 0, 0); \
            __builtin_amdgcn_global_load_lds((const unsigned*)((const char*)Vg + go_ + gsrc[i_]), (LAS unsigned*)(lds3 + sl_ + 16384 + i_ * 8192 + ldsw), 16, 0, 0); } } while (0)
#define ATT_DMA1(t_, w_) do { const size_t go_ = (size_t)(t_) * 64 * 768 * 2; const unsigned sl_ = ((unsigned)(t_) & 3u) * 32768u; \
        if ((w_) < 2) __builtin_amdgcn_global_load_lds((const unsigned*)((const char*)Kg + go_ + gsrc[(w_) & 1]), (LAS unsigned*)(lds3 + sl_ + ((w_) & 1) * 8192 + ldsw), 16, 0, 0); \
        else __builtin_amdgcn_global_load_lds((const unsigned*)((const char*)Vg + go_ + gsrc[(w_) & 1]), (LAS unsigned*)(lds3 + sl_ + 16384 + ((w_) & 1) * 8192 + ldsw), 16, 0, 0); } while (0)
    __syncthreads();
    ATT_DMA(0); ATT_DMA(1); if (nt > 2) ATT_DMA(2);
    bf16x8 qf[4];
    { const bf16* qp = Qg + (size_t)(qsub * 32 + r) * 768 + mp * 64 + 8 * hh;
#pragma unroll
      for (int s = 0; s < 4; ++s) qf[s] = *(const bf16x8*)(qp + 16 * s);
#pragma unroll
      for (int s = 0; s < 4; ++s) asm volatile("" : "+v"(qf[s])); }
    f32x16 ot[4];
#pragma unroll
    for (int db = 0; db < 4; ++db)
#pragma unroll
        for (int i = 0; i < 16; ++i) ot[db][i] = 0.f;
    float m_run = 0.f, l_run = 0.f;
    const unsigned lbase = (unsigned)(uintptr_t)lds;
    unsigned kaddr[4], vaddr[2][4];
    { const unsigned X = ((r & 3u) << 2) | ((r >> 2) & 3u);
#pragma unroll
      for (int s = 0; s < 4; ++s) kaddr[s] = 256u * r + 16u * ((unsigned)(8 * mp + 2 * s + hh) ^ X);
      mk_vaddr(lane, vaddr); }
#define PIPE_S(t_, sA_, sB_, dl_, alpha_, grow_) do { \
        const unsigned char* kb_ = lds + ((t_) & 3) * 32768; { const float nm_ = -m_run; _Pragma("unroll") for (int i = 0; i < 16; ++i) { sA_[i] = nm_; sB_[i] = nm_; } } \
        __builtin_amdgcn_s_setprio(1); \
        { bf16x8 kf_[8]; _Pragma("unroll") for (int s = 0; s < 4; ++s) { kf_[2 * s] = *(const bf16x8*)(kb_ + kaddr[s]); kf_[2 * s + 1] = *(const bf16x8*)(kb_ + 8192 + kaddr[s]); } \
          asm volatile("" ::: "memory");     \
          _Pragma("unroll") for (int s = 0; s < 4; ++s) { sA_ = MFMA32(kf_[2 * s], qf[s], sA_); sB_ = MFMA32(kf_[2 * s + 1], qf[s], sB_); } } \
        __builtin_amdgcn_s_setprio(0); \
        float tm = max3f(sA_[0], sA_[1], sA_[2]), tn = max3f(sB_[0], sB_[1], sB_[2]); \
        _Pragma("unroll") for (int i = 3; i < 15; i += 2) { tm = max3f(tm, sA_[i], sA_[i + 1]); tn = max3f(tn, sB_[i], sB_[i + 1]); } \
        tm = max3f(tm, sA_[15], tn); tm = max3f(tm, sB_[15], tm); tm = max3f(tm, __shfl_xor(tm, 32), tm); \
        grow_ = __any(tm > 0.f) != 0; dl_ = 0.f; alpha_ = 1.f; \
        if (grow_) { dl_ = fmaxf(tm, 0.f); alpha_ = __builtin_amdgcn_exp2f(-dl_); \
            _Pragma("unroll") for (int i = 0; i < 16; ++i) { sA_[i] -= dl_; sB_[i] -= dl_; } } } while (0)
#define PIPE_FILL(p_, sA_, sB_, PN_) do { { \
        float e0, e1; if ((p_) < 8) { e0 = __builtin_amdgcn_exp2f(sA_[2 * ((p_) & 7)]); e1 = __builtin_amdgcn_exp2f(sA_[2 * ((p_) & 7) + 1]); } else { e0 = __builtin_amdgcn_exp2f(sB_[2 * ((p_) & 7)]); e1 = __builtin_amdgcn_exp2f(sB_[2 * ((p_) & 7) + 1]); } \
        psn += e0 + e1; PN_[(p_) >> 2][(p_) & 3] = cvtpk(e0, e1); } } while (0)
#define TRR(dst, addr, off) asm volatile("ds_read_b64_tr_b16 %0, %1 offset:%c2" : "=&v"(dst) : "v"(addr), "i"(off) : "memory")
#define TRR8(tl, th, db_) do { const unsigned a0_ = vbase + vaddr[0][db_], a1_ = vbase + vaddr[1][db_]; \
                TRR(tl[0], a0_, 0); TRR(th[0], a1_, 0); TRR(tl[1], a0_, 4096); TRR(th[1], a1_, 4096); TRR(tl[2], a0_, 8192); TRR(th[2], a1_, 8192); TRR(tl[3], a0_, 12288); TRR(th[3], a1_, 12288); } while (0)
#define TRWAIT(n_, tl, th) do { asm volatile("s_waitcnt lgkmcnt(" #n_ ")" : "+v"(tl[0]), "+v"(th[0]), "+v"(tl[1]), "+v"(th[1]), "+v"(tl[2]), "+v"(th[2]), "+v"(tl[3]), "+v"(th[3]) :: "memory"); __builtin_amdgcn_sched_barrier(0); } while (0)
#define PIPE_PV4(FILL_, tl, th, db_, PC_, sA_, sB_, PN_) do { _Pragma("unroll") for (int ks = 0; ks < 4; ++ks) { const bf16x8 vf = __builtin_shufflevector(tl[ks], th[ks], 0, 1, 2, 3, 4, 5, 6, 7); \
            ot[db_] = MFMA32(vf, __builtin_bit_cast(bf16x8, PC_[ks]), ot[db_]); if (FILL_) PIPE_FILL(4 * (db_) + ks, sA_, sB_, PN_); if (PIPE_PIN) __builtin_amdgcn_sched_barrier(0); } } while (0)
#define PIPE_STEP(kt_, PC_, PN_) do { \
        if ((kt_) + 2 < nt) { if (PIPE_XBAR == 2) asm volatile("s_waitcnt vmcnt(8)\n\ts_barrier" ::: "memory"); else asm volatile("s_waitcnt vmcnt(4)\n\ts_barrier" ::: "memory"); } else asm volatile("s_waitcnt vmcnt(0)\n\ts_barrier" ::: "memory");     \
        if (PIPE_XBAR == 1) asm volatile("s_barrier" ::: "memory"); \
        if ((kt_) >= my_nt) { if ((kt_) + 3 < nt) ATT_DMA((kt_) + 3); } \
        if ((kt_) < my_nt) { \
            const bool fill = (kt_) + 1 < my_nt; f32x16 sA, sB; float dl = 0.f, alpha = 1.f, psn = 0.f; bool grow = false; \
            if (fill) PIPE_S((kt_) + 1, sA, sB, dl, alpha, grow); \
            const bool dma_ = (kt_) + 3 < nt;                                 \
            const unsigned vbase = lbase + ((kt_) & 3) * 32768 + 16384; \
            s16x4 tlA[4], thA[4], tlB[4], thB[4]; \
            TRR8(tlA, thA, 0); \
            TRR8(tlB, thB, 1); TRWAIT(8, tlA, thA); PIPE_PV4(fill, tlA, thA, 0, PC_, sA, sB, PN_); if (dma_) ATT_DMA1((kt_) + 3, 0); \
            TRR8(tlA, thA, 2); TRWAIT(8, tlB, thB); PIPE_PV4(fill, tlB, thB, 1, PC_, sA, sB, PN_); if (dma_) ATT_DMA1((kt_) + 3, 1); \
            TRR8(tlB, thB, 3); TRWAIT(8, tlA, thA); PIPE_PV4(fill, tlA, thA, 2, PC_, sA, sB, PN_); if (dma_) ATT_DMA1((kt_) + 3, 2); \
            TRWAIT(0, tlB, thB); PIPE_PV4(fill, tlB, thB, 3, PC_, sA, sB, PN_); if (dma_) ATT_DMA1((kt_) + 3, 3); \
            if (grow) { m_run += dl; l_run *= alpha; \
                _Pragma("unroll") for (int db = 0; db < 4; ++db) _Pragma("unroll") for (int i = 0; i < 16; ++i) ot[db][i] *= alpha; } \
            l_run += psn; } } while (0)
    v4u pfa[4], pfb[4];
    {
        asm volatile("s_waitcnt vmcnt(0)\n\ts_barrier" ::: "memory");
        f32x16 sA, sB; float dl, alpha; bool grow; PIPE_S(0, sA, sB, dl, alpha, grow);
        float ps = 0.f;
#pragma unroll
        for (int i = 0; i < 16; ++i) { sA[i] = __builtin_amdgcn_exp2f(sA[i]); sB[i] = __builtin_amdgcn_exp2f(sB[i]); ps += sA[i] + sB[i]; }
        m_run = dl; l_run = ps;
        pfa[0] = __builtin_bit_cast(v4u, pack8f(sA, 0)); pfa[1] = __builtin_bit_cast(v4u, pack8f(sA, 1)); pfa[2] = __builtin_bit_cast(v4u, pack8f(sB, 0)); pfa[3] = __builtin_bit_cast(v4u, pack8f(sB, 1));
    }
#pragma unroll 1
    for (int kt = 0; kt < nt; kt += 2) { PIPE_STEP(kt, pfa, pfb); PIPE_STEP(kt + 1, pfb, pfa); }
#undef ATT_DMA
#undef ATT_DMA1
#undef PIPE_S
#undef PIPE_FILL
#undef PIPE_PV4
#undef PIPE_STEP
#undef TRR
#undef TRR8
#undef TRWAIT
    __syncthreads();
    l_run += __shfl_xor(l_run, 32);
    const float rl = 1.0f / l_run;
    int l9 = lane; asm volatile("" : "+v"(l9));
    bf16* Og = (bf16*)(ws + WS_DAQ) + ((size_t)b * SEQ + (size_t)qb * 128 + qsub * 32 + (l9 & 31)) * 768 + h * 128;
    {
        float* xch = (float*)lds + (wave >> 1) * 4096;
        const float lam = ((const float*)(ws + WS_MISC))[0];
        if (mp == 1) {
            const float f = rl * lam;
#pragma unroll
            for (int db = 0; db < 4; ++db)
#pragma unroll
                for (int i = 0; i < 16; ++i) xch[(db * 16 + i) * 64 + lane] = ot[db][i] * f;
        }
        __syncthreads();
        if (mp == 0) {
            float ss = 0.f;
#pragma unroll
            for (int db = 0; db < 4; ++db)
#pragma unroll
                for (int i = 0; i < 16; ++i) { const float v = ot[db][i] * rl - xch[(db * 16 + i) * 64 + lane]; ot[db][i] = v; ss += v * v; }
            ss += __shfl_xor(ss, 32);
            const float scl = (1.0f - LAM_INIT) / sqrtf(ss * (1.0f / 128.0f) + EPS); const float* gp = (const float*)P.in[I_SUBLN] + 4 * hh;
#pragma unroll
            for (int db = 0; db < 4; ++db)
#pragma unroll
                for (int g = 0; g < 4; ++g) { const f32x4 gg = *(const f32x4*)(gp + 32 * db + 8 * g);
                    v2u w; w.x = cvtpk(ot[db][4 * g] * scl * gg.x, ot[db][4 * g + 1] * scl * gg.y); w.y = cvtpk(ot[db][4 * g + 2] * scl * gg.z, ot[db][4 * g + 3] * scl * gg.w);
                    *(v2u*)(Og + 32 * db + 8 * g + 4 * (l9 >> 5)) = w; }
        }
    }
}

constexpr size_t OUT_NW = 0, OUT_QKM = 48 * MiB;
__device__ __forceinline__ int kperm16(int d) { return (d & ~12) | ((d & 4) << 1) | ((d & 8) >> 1); }
constexpr int I_RAW2A = 66560, I_RAW2B = 123392;
template <int NT>
__device__ __forceinline__ void gdn_intra_fetch(const Params& P, unsigned char* lds, int t, int u) {
    unsigned char* ws = P.ws; const int n = u & 127, bh = u >> 7, b = bh / 6, hh = bh - 6 * b;
    const size_t row0 = (size_t)b * SEQ + n * 64; const int gci = b * (SEQ / 64) + n;
    constexpr int K = (67 * 48 + NT - 1) / NT;
    v4u v[K];
#pragma unroll
    for (int k = 0; k < K; ++k) { const int it = t + k * NT; const int i = it / 48, ch = it - i * 48, sec = ch >> 4, c16 = ch & 15; v[k] = (v4u){0u, 0u, 0u, 0u};
        if (it < 67 * 48) {
            if (i >= 3) v[k] = *(const v4u*)((const bf16*)(ws + WS_GQ + (size_t)sec * WS_SEC) + (row0 + i - 3) * 768 + hh * 128 + c16 * 8);
            else if (n > 0) v[k] = *(const v4u*)((const bf16*)(ws + WS_HALO) + ((size_t)(gci - 1) * 3 + i) * 2304 + sec * 768 + hh * 128 + c16 * 8); } }
#pragma unroll
    for (int k = 0; k < K; ++k) { const int it = t + k * NT;
        if (it < 67 * 48) *(v4u*)(lds + (it < 2048 ? I_RAW2A + it * 16 : I_RAW2B + (it - 2048) * 16)) = v[k]; }
}
template <int N> __device__ __forceinline__ void fmac_bc(float& d, float a, float x) { asm("v_fmac_f32_dpp %0, -%1, %2 row_newbcast:%3 row_mask:0xf bank_mask:0xf" : "+v"(d) : "v"(a), "v"(x), "n"(N)); }
template <int J, int I> __device__ __forceinline__ void solve_row(float (&x)[64], const float (&va)[4]) {
    if constexpr (I < 64) { fmac_bc<(I & 15)>(x[I], va[I >> 4], x[J]); solve_row<J, I + 1>(x, va); }
}
template <int J> __device__ __forceinline__ void solve_steps(float (&x)[64], float (&va)[4], float (&vb)[4], const float* AMl) {
    if constexpr (J < 63) {
        if constexpr (J + 1 < 63) {
#pragma unroll
            for (int g = (J + 2) >> 4; g < 4; ++g) vb[g] = AMl[(J + 1) * 68 + 16 * g];
        }
        solve_row<J, J + 1>(x, va);
        solve_steps<J + 1>(x, vb, va, AMl);
    }
}
__device__ __forceinline__ void gdn_intra_block(const Params& P, unsigned char* lds, int tid_in, int u_begin_, int u_end_) {
    const int u_begin = __builtin_amdgcn_readfirstlane(u_begin_), u_end = __builtin_amdgcn_readfirstlane(u_end_);
    if (u_begin >= u_end) return;
    float* GB2 = (float*)(lds + 142080);
    __syncthreads();
    { int t0_ = mk_tid(tid_in); asm volatile("" : "+v"(t0_)); gdn_intra_fetch<NTHR>(P, lds, t0_, u_begin);
      if ((t0_ >> 6) == 7) { const int n = u_begin & 127, bh = u_begin >> 7, b = bh / 6, hh = bh - 6 * b; const size_t r_ = ((size_t)b * SEQ + n * 64 + (t0_ & 63)) * 6 + hh;
          GB2[t0_ & 63] = ((const float*)(P.ws + WS_LA))[r_]; GB2[64 + (t0_ & 63)] = ((const float*)(P.ws + WS_BT))[r_]; } }
  int wc_hh = -1;
#pragma unroll 1
  for (int u = u_begin; u < u_end; ++u) {
    int tid = mk_tid(tid_in); asm volatile("" : "+v"(tid)); const int lane = tid & 63, wave = __builtin_amdgcn_readfirstlane(tid >> 6);
    const int n = u & 127, bh = u >> 7, b = bh / 6, hh = bh - 6 * b;
    unsigned char* ws = P.ws; unsigned char* outb = (unsigned char*)P.out; asm volatile("" : "+v"(ws), "+v"(outb));
    bf16* RAW = (bf16*)lds;
    float* RHS = (float*)lds;
    unsigned char* QS = lds + 66560;
    unsigned char* KS = lds + 82944;
    float* AM = (float*)(lds + 99328);
    float* WC = (float*)(lds + 116736);
    float* GB = (float*)(lds + 122880);
    const int t0 = n * 64; const size_t row0 = (size_t)b * SEQ + t0; const int gci = b * (SEQ / 64) + n;
    float* LA = (float*)(ws + WS_LA);
    __syncthreads();
#ifdef PROBE_A
    if (blockIdx.x == 0 && tid == 0 && u == u_begin + 2) ((unsigned long long*)(ws + WS_MISC + 32768))[20] = __builtin_amdgcn_s_memrealtime();
#endif
#pragma unroll
    for (int k = 0; k < 7; ++k) { const int it = tid + k * NTHR;
        if (it < 67 * 48) { const int i = it / 48, ch = it - i * 48; *(v4u*)(lds + i * 784 + ch * 16) = *(const v4u*)(lds + (it < 2048 ? I_RAW2A + it * 16 : I_RAW2B + (it - 2048) * 16)); } }
    if (hh != wc_hh) { wc_hh = hh;
#pragma unroll
        for (int k = 0; k < 3; ++k) { const int i = tid + k * NTHR, tap = i / 384, c = i - tap * 384; WC[i] = ((const float*)P.in[I_WCONV])[tap * 2304 + (c >> 7) * 768 + hh * 128 + (c & 127)]; } }
    if (wave == 7) { float g = GB2[lane]; const float pbt = GB2[64 + lane];
#pragma unroll
        for (int o = 1; o < 64; o <<= 1) { const float t = __shfl_up(g, o); if (lane >= o) g += t; }
        GB[lane] = g; GB[64 + lane] = pbt; LA[(row0 + lane) * 6 + hh] = g;
        if (lane == 63) ((float*)(ws + WS_MISC))[64 + gci * 6 + hh] = __expf(g); }
    __syncthreads();
#ifdef PROBE_A
    if (blockIdx.x == 0 && tid == 0 && u == u_begin + 2) ((unsigned long long*)(ws + WS_MISC + 32768))[21] = __builtin_amdgcn_s_memrealtime();
#endif
    int tid2 = tid; asm volatile("" : "+v"(tid2)); const int tk = tid2 >> 3, c8 = tid2 & 7;
    float xq[16], xk[16], xv[16];
    {
#pragma unroll
        for (int sec = 0; sec < 3; ++sec) { float acc[16];
#pragma unroll
            for (int i = 0; i < 16; ++i) acc[i] = 0.f;
#pragma unroll
            for (int tap = 0; tap < 4; ++tap) { const bf16* rp = RAW + (tk + tap) * 392 + sec * 128 + c8 * 16; const float* wp = WC + tap * 384 + sec * 128 + c8 * 16;
                const v4u a = *(const v4u*)rp, c = *(const v4u*)(rp + 8);
                const float xr[16] = { bflo(a.x), bfhi(a.x), bflo(a.y), bfhi(a.y), bflo(a.z), bfhi(a.z), bflo(a.w), bfhi(a.w), bflo(c.x), bfhi(c.x), bflo(c.y), bfhi(c.y), bflo(c.z), bfhi(c.z), bflo(c.w), bfhi(c.w) };
#pragma unroll
                for (int i = 0; i < 16; ++i) acc[i] += wp[i] * xr[i]; }
#pragma unroll
            for (int i = 0; i < 16; ++i) { const float y = siluf(acc[i]); if (sec == 0) xq[i] = y; else if (sec == 1) xk[i] = y; else xv[i] = y; } }
        float sq = 0.f, sk = 0.f;
#pragma unroll
        for (int i = 0; i < 16; ++i) { sq += xq[i] * xq[i]; sk += xk[i] * xk[i]; }
        sq += __shfl_xor(sq, 1); sq += __shfl_xor(sq, 2); sq += __shfl_xor(sq, 4); sk += __shfl_xor(sk, 1); sk += __shfl_xor(sk, 2); sk += __shfl_xor(sk, 4);
        const float scq = 0.08838834764831845f / sqrtf(sq + EPS), sck = 1.0f / sqrtf(sk + EPS);
#pragma unroll
        for (int i = 0; i < 16; ++i) { xq[i] *= scq; xk[i] *= sck; }
    }
    const float g_c = GB[tk], g_l = GB[63], bt_c = GB[64 + tk];
    const float eg = __expf(g_c), ekd = __expf(g_l - g_c);
    {
        v4u w0, w1;
        w0.x = pk2(xq[0], xq[1]); w0.y = pk2(xq[2], xq[3]); w0.z = pk2(xq[4], xq[5]); w0.w = pk2(xq[6], xq[7]); w1.x = pk2(xq[8], xq[9]); w1.y = pk2(xq[10], xq[11]); w1.z = pk2(xq[12], xq[13]); w1.w = pk2(xq[14], xq[15]);
        *(v4u*)(QS + off_b(tk, 2 * c8)) = w0; *(v4u*)(QS + off_b(tk, 2 * c8 + 1)) = w1;
        w0.x = pk2(xk[0], xk[1]); w0.y = pk2(xk[2], xk[3]); w0.z = pk2(xk[4], xk[5]); w0.w = pk2(xk[6], xk[7]); w1.x = pk2(xk[8], xk[9]); w1.y = pk2(xk[10], xk[11]); w1.z = pk2(xk[12], xk[13]); w1.w = pk2(xk[14], xk[15]);
        *(v4u*)(KS + off_b(tk, 2 * c8)) = w0; *(v4u*)(KS + off_b(tk, 2 * c8 + 1)) = w1;
        bf16* gq = (bf16*)(ws + WS_GQ) + (row0 + tk) * 768 + hh * 128 + c8 * 16; bf16* gk = (bf16*)(ws + WS_GK) + (row0 + tk) * 768 + hh * 128 + c8 * 16;
        w0.x = pk2(xq[0] * eg, xq[1] * eg); w0.y = pk2(xq[2] * eg, xq[3] * eg); w0.z = pk2(xq[8] * eg, xq[9] * eg); w0.w = pk2(xq[10] * eg, xq[11] * eg);
        w1.x = pk2(xq[4] * eg, xq[5] * eg); w1.y = pk2(xq[6] * eg, xq[7] * eg); w1.z = pk2(xq[12] * eg, xq[13] * eg); w1.w = pk2(xq[14] * eg, xq[15] * eg);
        *(v4u*)gq = w0; *(v4u*)(gq + 8) = w1;
        w0.x = pk2(xk[0] * ekd, xk[1] * ekd); w0.y = pk2(xk[2] * ekd, xk[3] * ekd); w0.z = pk2(xk[4] * ekd, xk[5] * ekd); w0.w = pk2(xk[6] * ekd, xk[7] * ekd);
        w1.x = pk2(xk[8] * ekd, xk[9] * ekd); w1.y = pk2(xk[10] * ekd, xk[11] * ekd); w1.z = pk2(xk[12] * ekd, xk[13] * ekd); w1.w = pk2(xk[14] * ekd, xk[15] * ekd);
        *(v4u*)gk = w0; *(v4u*)(gk + 8) = w1;
    }
    __syncthreads();
#ifdef PROBE_A
    if (blockIdx.x == 0 && tid == 0 && u == u_begin + 2) ((unsigned long long*)(ws + WS_MISC + 32768))[22] = __builtin_amdgcn_s_memrealtime();
#endif
    {
        float* rp = RHS + tk * 260 + c8 * 16; const float kb = bt_c * eg;
#pragma unroll
        for (int i = 0; i < 16; i += 4) { *(f32x4*)(rp + i) = (f32x4){xv[i] * bt_c, xv[i + 1] * bt_c, xv[i + 2] * bt_c, xv[i + 3] * bt_c};
            *(f32x4*)(rp + 128 + i) = (f32x4){xk[i] * kb, xk[i + 1] * kb, xk[i + 2] * kb, xk[i + 3] * kb}; }
    }
#ifdef PROBE_A
    if (blockIdx.x == 0 && tid == 0 && u == u_begin + 2) ((unsigned long long*)(ws + WS_MISC + 32768))[23] = __builtin_amdgcn_s_memrealtime();
#endif
    {
        const int which = wave >> 2, ti = (wave >> 1) & 1, tj = wave & 1, r = lane & 31, h5 = lane >> 5;
        f32x16 acc;
#pragma unroll
        for (int i = 0; i < 16; ++i) acc[i] = 0.f;
        if (ti >= tj) {
            const unsigned char* Ab = (which ? QS : KS) + 8192 * ti; const unsigned char* Bb = KS + 8192 * tj;
            const unsigned X = ((r & 3u) << 2) | ((r >> 2) & 3u);
#pragma unroll
            for (int s = 0; s < 8; ++s) { const unsigned o = 256u * r + 16u * ((unsigned)(2 * s + h5) ^ X); acc = MFMA32(*(const bf16x8*)(Ab + o), *(const bf16x8*)(Bb + o), acc); }
        }
        const int j = 32 * tj + r; const float g_j = GB[j];
        if (which == 0) {
            if (ti >= tj) {
#pragma unroll
                for (int i = 0; i < 16; ++i) { const int c = 32 * ti + (i & 3) + 8 * (i >> 2) + 4 * h5; AM[j * 68 + c] = (c > j) ? GB[64 + c] * acc[i] * __expf(GB[c] - g_j) : 0.f; }
            }
        } else {
            bf16* qkm = (bf16*)(outb + OUT_QKM) + ((size_t)gci * 6 + hh) * 4096; const int jp = (j & ~15) | kperm16(j & 15);
#pragma unroll
            for (int i = 0; i < 16; ++i) { const int c = 32 * ti + (i & 3) + 8 * (i >> 2) + 4 * h5; const float v = (c >= j) ? acc[i] * __expf(GB[c] - g_j) : 0.f; qkm[c * 64 + jp] = (bf16)f2bf(v); }
        }
    }
    __syncthreads();
#ifdef PROBE_A
    if (blockIdx.x == 0 && tid == 0 && u == u_begin + 2) ((unsigned long long*)(ws + WS_MISC + 32768))[24] = __builtin_amdgcn_s_memrealtime();
#endif
    if (wave >= 4) {
        if (u + 1 < u_end) { gdn_intra_fetch<256>(P, lds, tid - 256, u + 1);
            if (wave == 7) { const int n1 = (u + 1) & 127, bh1 = (u + 1) >> 7, b1 = bh1 / 6, hh1 = bh1 - 6 * b1; const size_t r_ = ((size_t)b1 * SEQ + n1 * 64 + lane) * 6 + hh1;
                GB2[lane] = ((const float*)(ws + WS_LA))[r_]; GB2[64 + lane] = ((const float*)(ws + WS_BT))[r_]; } }
    } else {
        int tid4 = tid; asm volatile("" : "+v"(tid4)); const int lane = tid4 & 63;
        const int col = 64 * wave + lane;
        const float* AMl = AM + (lane & 15);
        float x[64];
#pragma unroll
        for (int i = 0; i < 64; ++i) x[i] = RHS[i * 260 + col];
        float va[4], vb[4];
#pragma unroll
        for (int g = 0; g < 4; ++g) va[g] = AMl[16 * g];
        solve_steps<0>(x, va, vb, AMl);
        int l5 = lane; asm volatile("" : "+v"(l5)); const int col5 = 64 * wave + l5; asm volatile("" : "+v"(ws), "+v"(outb));
        if (wave < 2) {
            const int e = col5, ew = e >> 5, r = e & 31;
            bf16* gv = (bf16*)(ws + WS_GV) + row0 * 768 + hh * 128;
#pragma unroll
            for (int i4 = 0; i4 < 16; ++i4) { const int i = 4 * i4, cb = i >> 5, g = (i & 31) >> 3, h = (i >> 2) & 1;
                const int idx = ((((ew * 2 + cb) * 4 + g) * 64) + h * 32 + r) * 4;
                v2u w; w.x = pk2(x[i], x[i + 1]); w.y = pk2(x[i + 2], x[i + 3]);
                *(v2u*)(gv + (size_t)(idx >> 7) * 768 + (idx & 127)) = w; }
        } else {
            const int d = col5 - 128; bf16* nw = (bf16*)(outb + OUT_NW) + row0 * 768 + hh * 128 + ((d & ~15) | kperm16(d & 15));
#pragma unroll
            for (int i = 0; i < 64; ++i) nw[(size_t)i * 768] = (bf16)(cvtpk(-x[i], 0.f) & 0xffffu);
        }
    }
  }
}

__device__ __forceinline__ void gdn_scan_unit(const Params& P, unsigned char* lds, int tid_in, int b, int hh) {
    int tid = mk_tid(tid_in); asm volatile("" : "+v"(tid)); const int lane = tid & 63, wave = __builtin_amdgcn_readfirstlane(tid >> 6);
    unsigned char* ws = P.ws; unsigned char* outb = (unsigned char*)P.out;
    constexpr int BUFB = 57344, O_NW = 0, O_QD = 16384, O_KD = 32768, O_QK = 49152;
    LAS unsigned char* lds3 = (LAS unsigned char*)lds;
    const size_t rowb = (size_t)b * SEQ;
    const bf16* gNW = (const bf16*)(outb + OUT_NW) + rowb * 768 + hh * 128; const bf16* gQD = (const bf16*)(ws + WS_GQ) + rowb * 768 + hh * 128; const bf16* gKD = (const bf16*)(ws + WS_GK) + rowb * 768 + hh * 128;
    const bf16* gU = (const bf16*)(ws + WS_GV) + rowb * 768 + hh * 128; const bf16* gQK = (const bf16*)(outb + OUT_QKM) + ((size_t)(b * (SEQ / 64)) * 6 + hh) * 4096;
    const float* CD = (const float*)(ws + WS_MISC) + 64 + (size_t)(b * (SEQ / 64)) * 6 + hh;
    bf16* gZ = (bf16*)(ws + WS_GZ) + rowb * 768 + hh * 128;
    unsigned gsrc[4], gsrcq[2];
    const unsigned st_ = tid & 255;
#pragma unroll
    for (int i = 0; i < 4; ++i) { const unsigned p = i * 256 + st_, row = p >> 4, ch = (p & 15u) ^ (((row & 3u) << 2) | ((row >> 2) & 3u)); gsrc[i] = (row * 768 + ch * 8) * 2; }
#pragma unroll
    for (int i = 0; i < 2; ++i) { const unsigned p = i * 256 + st_, ir = p >> 4, c16 = (p & 15u) ^ (((ir & 3u) << 2) | ((ir >> 2) & 3u)); gsrcq[i] = ((2 * ir + (c16 >> 3)) * 64 + (c16 & 7) * 8) * 2; }
    const unsigned ldsw = (unsigned)(wave & 3) * 1024u;
#define GDN_DMA(bufoff, n_) do { const size_t go_ = (size_t)(n_) * 64 * 768 * 2; \
        _Pragma("unroll") for (int i_ = 0; i_ < 4; ++i_) { \
            __builtin_amdgcn_global_load_lds((const unsigned*)((const char*)gNW + go_ + gsrc[i_]), (LAS unsigned*)(lds3 + (bufoff) + O_NW + i_ * 4096 + ldsw), 16, 0, 0); \
            __builtin_amdgcn_global_load_lds((const unsigned*)((const char*)gQD + go_ + gsrc[i_]), (LAS unsigned*)(lds3 + (bufoff) + O_QD + i_ * 4096 + ldsw), 16, 0, 0); \
            __builtin_amdgcn_global_load_lds((const unsigned*)((const char*)gKD + go_ + gsrc[i_]), (LAS unsigned*)(lds3 + (bufoff) + O_KD + i_ * 4096 + ldsw), 16, 0, 0); } \
        _Pragma("unroll") for (int i_ = 0; i_ < 2; ++i_) \
            __builtin_amdgcn_global_load_lds((const unsigned*)((const char*)gQK + (size_t)(n_) * 6 * 4096 * 2 + gsrcq[i_]), (LAS unsigned*)(lds3 + (bufoff) + O_QK + i_ * 4096 + ldsw), 16, 0, 0); } while (0)
    const int r = lane & 31, h5 = lane >> 5;
    __syncthreads();
    if (wave < 4) GDN_DMA(0, 0);
    const float cdv0 = CD[(size_t)lane * 6], cdv1 = CD[(size_t)(64 + lane) * 6];
    f32x16 S[4];
#pragma unroll
    for (int db = 0; db < 4; ++db)
#pragma unroll
        for (int i = 0; i < 16; ++i) S[db][i] = 0.f;
    const int ew = wave & 3;
    bf16* Ob = (bf16*)(lds + 2 * BUFB);
    unsigned char* Ub = lds + 2 * BUFB + 16384;
    const int ht = tid & 255, hr = ht >> 2, c4 = ht & 3;
    const bf16* gUh = gU + (size_t)(ht >> 2) * 768 + (ht & 3) * 32;
    if (wave >= 4) {
#pragma unroll
        for (int i = 0; i < 4; ++i) *(v4u*)(Ub + ht * 64 + 16 * i) = *(const v4u*)(gUh + 8 * i);
    }
    __syncthreads();
#define SYNC_B() asm volatile("s_waitcnt lgkmcnt(0)\n\ts_barrier" ::: "memory")
#define SYNC_A() asm volatile("s_waitcnt vmcnt(0) lgkmcnt(0)\n\ts_barrier" ::: "memory")
    if (wave < 4) {
#pragma unroll 1
        for (int n = 0; n <= SEQ / 64; ++n) {
            const int cur = n & 1; const bool more = n + 1 < SEQ / 64, act = n < SEQ / 64;
            unsigned char* cb_ = lds + cur * BUFB;
            if (more) { if (cur) GDN_DMA(0, n + 1); else GDN_DMA(BUFB, n + 1); }
            bf16x8 vb[2][2];
            if (act) {
                int l1 = lane; asm volatile("" : "+v"(l1)); unsigned kx[8]; mk_kx(l1, kx);
                f32x16 vn0, vn1;
#pragma unroll
                for (int g = 0; g < 4; ++g) { const v2u w0 = *(const v2u*)(Ub + (((ew * 8 + g) * 64) + lane) * 8), w1 = *(const v2u*)(Ub + (((ew * 8 + 4 + g) * 64) + lane) * 8);
                    vn0[4 * g] = bflo(w0.x); vn0[4 * g + 1] = bfhi(w0.x); vn0[4 * g + 2] = bflo(w0.y); vn0[4 * g + 3] = bfhi(w0.y);
                    vn1[4 * g] = bflo(w1.x); vn1[4 * g + 1] = bfhi(w1.x); vn1[4 * g + 2] = bflo(w1.y); vn1[4 * g + 3] = bfhi(w1.y); }
#pragma unroll
                for (int db = 0; db < 4; ++db)
#pragma unroll
                    for (int s = 0; s < 2; ++s) { const bf16x8 sb = pack8f(S[db], s);
                        vn0 = MFMA32(*(const bf16x8*)(cb_ + O_NW + kx[2 * db + s]), sb, vn0); vn1 = MFMA32(*(const bf16x8*)(cb_ + O_NW + 8192 + kx[2 * db + s]), sb, vn1); }
                vb[0][0] = pack8f(vn0, 0); vb[0][1] = pack8f(vn0, 1); vb[1][0] = pack8f(vn1, 0); vb[1][1] = pack8f(vn1, 1);
            }
            SYNC_B();
            if (act) {
                const float cd = __builtin_bit_cast(float, __builtin_amdgcn_readlane(__builtin_bit_cast(int, (n & 64) ? cdv1 : cdv0), n & 63));
                int l2 = lane; asm volatile("" : "+v"(l2)); unsigned kx[8], qkx[4]; mk_kx(l2, kx); mk_qkx(l2, qkx);
                f32x16 o0, o1;
#pragma unroll
                for (int i = 0; i < 16; ++i) { o0[i] = 0.f; o1[i] = 0.f; }
#pragma unroll
                for (int db = 0; db < 4; ++db)
#pragma unroll
                    for (int s = 0; s < 2; ++s) { const bf16x8 sb = pack8f(S[db], s);
                        o0 = MFMA32(*(const bf16x8*)(cb_ + O_QD + kx[2 * db + s]), sb, o0); o1 = MFMA32(*(const bf16x8*)(cb_ + O_QD + 8192 + kx[2 * db + s]), sb, o1); }
#pragma unroll
                for (int jb = 0; jb < 2; ++jb)
#pragma unroll
                    for (int s = 0; s < 2; ++s) { o0 = MFMA32(*(const bf16x8*)(cb_ + O_QK + qkx[2 * jb + s]), vb[jb][s], o0); o1 = MFMA32(*(const bf16x8*)(cb_ + O_QK + 4096 + qkx[2 * jb + s]), vb[jb][s], o1); }
#pragma unroll
                for (int i = 0; i < 16; ++i) { Ob[((i & 3) + 8 * (i >> 2) + 4 * h5) * 128 + 32 * ew + r] = (bf16)f2bf(o0[i]); Ob[(32 + (i & 3) + 8 * (i >> 2) + 4 * h5) * 128 + 32 * ew + r] = (bf16)f2bf(o1[i]); }
                int l3 = lane; asm volatile("" : "+v"(l3)); unsigned vaddr[2][4]; mk_vaddr(l3, vaddr); const unsigned cbase = (unsigned)(uintptr_t)cb_;
#pragma unroll
                for (int db = 0; db < 4; ++db) {
#pragma unroll
                    for (int i = 0; i < 16; ++i) S[db][i] *= cd;
                    s16x4 tl[4], th[4]; const unsigned a0 = cbase + vaddr[0][db], a1 = cbase + vaddr[1][db];
#define TRR(dst, addr, off) asm volatile("ds_read_b64_tr_b16 %0, %1 offset:%c2" : "=&v"(dst) : "v"(addr), "i"(off) : "memory")
                    TRR(tl[0], a0, O_KD); TRR(th[0], a1, O_KD); TRR(tl[1], a0, O_KD + 4096); TRR(th[1], a1, O_KD + 4096);
                    TRR(tl[2], a0, O_KD + 8192); TRR(th[2], a1, O_KD + 8192); TRR(tl[3], a0, O_KD + 12288); TRR(th[3], a1, O_KD + 12288);
#undef TRR
                    asm volatile("s_waitcnt lgkmcnt(0)" : "+v"(tl[0]), "+v"(th[0]), "+v"(tl[1]), "+v"(th[1]), "+v"(tl[2]), "+v"(th[2]), "+v"(tl[3]), "+v"(th[3]) :: "memory");
                    __builtin_amdgcn_sched_barrier(0);
#pragma unroll
                    for (int cs = 0; cs < 4; ++cs) { const bf16x8 kf = __builtin_shufflevector(tl[cs], th[cs], 0, 1, 2, 3, 4, 5, 6, 7); S[db] = MFMA32(kf, vb[cs >> 1][cs & 1], S[db]); } }
            }
            SYNC_A();
        }
    } else {
#define SYNC_AH() asm volatile("s_waitcnt lgkmcnt(0)\n\ts_barrier" ::: "memory")
        v4u un[4], zc[4];
        unsigned pfacc = 0u, pfp0 = 0u, pfp1 = 0u;
#pragma unroll
        for (int i = 0; i < 4; ++i) { un[i] = *(const v4u*)(gUh + (size_t)64 * 768 + 8 * i); zc[i] = (v4u){0u, 0u, 0u, 0u}; }
        const int li0 = ht, li1 = ht + 256;
        const char* pfa0 = (li0 < 128 ? (const char*)gNW : li0 < 256 ? (const char*)gQD : (const char*)gKD) + (size_t)((li0 & 127) >> 1) * 1536 + (li0 & 1) * 128;
        const char* pfa1 = (li1 < 384) ? (const char*)gKD + (size_t)((li1 & 127) >> 1) * 1536 + (li1 & 1) * 128 : (const char*)gQK + (size_t)(li1 - 384) * 128;
        const size_t pfs1 = (li1 < 384) ? (size_t)64 * 1536 : (size_t)6 * 8192;
#pragma unroll 1
        for (int n = 0; n <= SEQ / 64; ++n) {
            const bool more = n + 1 < SEQ / 64;
            v4u ovr[4], zn[4]; unsigned pf0 = 0u, pf1 = 0u;
            if (n > 0) {
                const bf16* op = Ob + hr * 128 + c4 * 32;
#pragma unroll
                for (int i = 0; i < 4; ++i) ovr[i] = *(const v4u*)(op + 8 * i);
            }
            if (n < SEQ / 64) { const bf16* zp = gZ + ((size_t)n * 64 + hr) * 768 + c4 * 32;
#pragma unroll
                for (int i = 0; i < 4; ++i) zn[i] = *(const v4u*)(zp + 8 * i); }
            if (n + 2 < SEQ / 64) { pf0 = *(const unsigned*)(pfa0 + (size_t)(n + 2) * 64 * 1536); if (li1 < 448) pf1 = *(const unsigned*)(pfa1 + (size_t)(n + 2) * pfs1); }
            SYNC_B();
            if (more) {
#pragma unroll
                for (int i = 0; i < 4; ++i) *(v4u*)(Ub + ht * 64 + 16 * i) = un[i];
                if (n + 2 < SEQ / 64) {
#pragma unroll
                    for (int i = 0; i < 4; ++i) un[i] = *(const v4u*)(gUh + (size_t)(n + 2) * 64 * 768 + 8 * i); }
            }
            if (n > 0) {
                float ov[32];
#pragma unroll
                for (int i = 0; i < 4; ++i) { const v4u t = ovr[i]; ov[8 * i] = bflo(t.x); ov[8 * i + 1] = bfhi(t.x); ov[8 * i + 2] = bflo(t.y); ov[8 * i + 3] = bfhi(t.y); ov[8 * i + 4] = bflo(t.z); ov[8 * i + 5] = bfhi(t.z); ov[8 * i + 6] = bflo(t.w); ov[8 * i + 7] = bfhi(t.w); }
                float ss = 0.f;
#pragma unroll
                for (int i = 0; i < 32; ++i) ss += ov[i] * ov[i];
                ss += __shfl_xor(ss, 1); ss += __shfl_xor(ss, 2);
                const float sc = 1.0f / sqrtf(ss * (1.0f / 128.0f) + EPS); const float* gn = (const float*)P.in[I_GDNN] + c4 * 32;
                bf16* zp = gZ + ((size_t)(n - 1) * 64 + hr) * 768 + c4 * 32;
#pragma unroll
                for (int i = 0; i < 4; ++i) { const v4u z = zc[i]; const float zz[8] = { bflo(z.x), bfhi(z.x), bflo(z.y), bfhi(z.y), bflo(z.z), bfhi(z.z), bflo(z.w), bfhi(z.w) };
                    float y[8];
#pragma unroll
                    for (int k = 0; k < 8; ++k) y[k] = ov[8 * i + k] * sc * gn[8 * i + k] * siluf(zz[k]);
                    v4u w; w.x = pk2(y[0], y[1]); w.y = pk2(y[2], y[3]); w.z = pk2(y[4], y[5]); w.w = pk2(y[6], y[7]); *(v4u*)(zp + 8 * i) = w; }
            }
#pragma unroll
            for (int i = 0; i < 4; ++i) zc[i] = zn[i];
            pfacc ^= pfp0 ^ pfp1; pfp0 = pf0; pfp1 = pf1;
            SYNC_AH();
        }
        if ((pfacc ^ pfp0 ^ pfp1) == 0x9e3779b9u && hr == 777) gZ[0] = 0;
#undef SYNC_AH
    }
#undef SYNC_A
#undef SYNC_B
#undef GDN_DMA
}


constexpr size_t WS_BAR = WS_MISC + 16384;
#define XB_TMO      128
#define XB_XCNT(j)  (256  + 64 * (j))
#define XB_XSUB(j)  (1280 + 64 * (j))
#define XB_XGEN(j)  (2304 + 64 * (j))
#define XB_TOP      3328
#define XB_TOPGEN   3392
#define XB_QUEUE    3456
#define XCD_BAR_WORDS 3968
#define XB_SPIN_CAP (1u << 20)
__device__ __forceinline__ unsigned xb_ld(unsigned* p)              { return __hip_atomic_load(p, __ATOMIC_RELAXED, __HIP_MEMORY_SCOPE_AGENT); }
__device__ __forceinline__ unsigned xb_add(unsigned* p, unsigned v) { return __hip_atomic_fetch_add(p, v, __ATOMIC_RELAXED, __HIP_MEMORY_SCOPE_AGENT); }
__device__ __forceinline__ unsigned xb_xcc_id() { return (unsigned)__builtin_amdgcn_s_getreg((3 << 11) | 20) & 0xFu; }
#define XB_SPIN(cond, bar) do { unsigned _sp = 0; while (cond) { __builtin_amdgcn_s_sleep(1); \
    if ((++_sp & 255u) == 0u) { if (xb_ld(&(bar)[XB_TMO])) break; if (_sp > XB_SPIN_CAP) { atomicAdd(&(bar)[XB_TMO], 1u); break; } } } } while (0)
__device__ __forceinline__ void xcd_barrier_census(unsigned* bar, unsigned x, unsigned G, unsigned& nloc, unsigned& nx) {
    unsigned sum, cnt, mine, sp = 0u;
    for (;;) {
        sum = 0u; cnt = 0u; mine = 0u;
#pragma unroll
        for (unsigned j = 0; j < 16; ++j) { const unsigned c = xb_ld(&bar[XB_XCNT(j)]); sum += c; cnt += (c > 0u) ? 1u : 0u; mine = (j == x) ? c : mine; }
        if (sum == G) break;
        __builtin_amdgcn_s_sleep(1);
        if ((++sp & 255u) == 0u) { if (xb_ld(&bar[XB_TMO])) break; if (sp > XB_SPIN_CAP) { atomicAdd(&bar[XB_TMO], 1u); break; } }
    }
    nloc = mine > 0u ? mine : 1u; nx = cnt > 0u ? cnt : 1u;
}
__device__ __forceinline__ void xcd_barrier(unsigned* bar, unsigned x, int tid) {
    asm volatile("s_waitcnt vmcnt(0)" ::: "memory");
    __syncthreads();
    if (tid == 0) {
        __builtin_amdgcn_s_waitcnt(0);
        unsigned nloc, nx; xcd_barrier_census(bar, x, gridDim.x, nloc, nx);
        const unsigned old = xb_add(&bar[XB_XSUB(x)], 1u);
        const unsigned gen = old / nloc;
        if (old + 1u == (gen + 1u) * nloc) {
            __builtin_amdgcn_fence(__ATOMIC_RELEASE, "agent");
            asm volatile("s_waitcnt vmcnt(0)" ::: "memory");
            const unsigned og = xb_add(&bar[XB_TOP], 1u);
            const unsigned tg = og / nx;
            if (og + 1u == (tg + 1u) * nx) xb_add(&bar[XB_TOPGEN], 1u);
            else XB_SPIN(xb_ld(&bar[XB_TOPGEN]) == tg, bar);
            __builtin_amdgcn_fence(__ATOMIC_ACQUIRE, "agent");
            xb_add(&bar[XB_XGEN(x)], 1u);
            asm volatile("s_waitcnt vmcnt(0)" ::: "memory");
        } else {
            XB_SPIN(xb_ld(&bar[XB_XGEN(x)]) == gen, bar);
            __builtin_amdgcn_fence(__ATOMIC_ACQUIRE, "agent");
            asm volatile("s_waitcnt vmcnt(0)" ::: "memory");
        }
    }
    __syncthreads();
}

constexpr int NPHASE = 8;
__global__ void __launch_bounds__(NTHR, 2) mega_fwd(Params P_by_value) {
    (void)P_by_value;
    extern __shared__ __attribute__((aligned(16))) unsigned char lds[];
    cg::grid_group grid = cg::this_grid();
    const Params* Pk = (const Params*)__builtin_amdgcn_kernarg_segment_ptr();
#define PHASE_P() const Params* Pp_ = Pk; asm volatile("" : "+s"(Pp_)); const Params& P = *Pp_
    const int G = gridDim.x;
    const int wave_s = __builtin_amdgcn_readfirstlane((int)threadIdx.x >> 6);
    unsigned char* ws = Pk->ws; unsigned char* outb = (unsigned char*)Pk->out;
    PG8_LAS unsigned char* lds3 = (PG8_LAS unsigned char*)lds;
    const int lo = Pk->lo, hi = Pk->hi;
#define IN(k) (lo <= (k) && (k) < hi)
#ifdef PROBE_A
#define STAMP(k) do { if (blockIdx.x == 0 && threadIdx.x == 0) ((unsigned long long*)(ws + WS_MISC + 32768))[k] = __builtin_amdgcn_s_memrealtime(); } while (0)
#else
#define STAMP(k) do { } while (0)
#endif
#define SEAM(k) do { if (IN(k) && IN((k) + 1)) { xcd_barrier(xbar, xcc, mk_tid(wave_s)); } STAMP((k) + 1); } while (0)

#define LAUNDER() int tid = mk_tid(wave_s); asm volatile("" : "+v"(tid)); const int lane = tid & 63, wave = __builtin_amdgcn_readfirstlane(tid >> 6); (void)lane; (void)wave
    unsigned* xbar = (unsigned*)(ws + WS_BAR); const unsigned xcc = xb_xcc_id();
    if (hi - lo > 1) {
        if (blockIdx.x == 0) { for (int i = (int)threadIdx.x; i < XCD_BAR_WORDS; i += NTHR) __hip_atomic_store(&xbar[i], 0u, __ATOMIC_RELAXED, __HIP_MEMORY_SCOPE_AGENT); }
        grid.sync();
        if (threadIdx.x == 0) (void)xb_add(&xbar[XB_XCNT(xcc)], 1u); }
    STAMP(0);
    if (IN(0)) { PHASE_P(); LAUNDER(); p0_prologue(P, lds, tid, lane, wave); __syncthreads(); }
    SEAM(0);
    if (IN(1)) { PHASE_P();
        { pg8::Gemm g{(const pg8::bf16_t*)(outb + OUT_HB), (const pg8::bf16_t*)(ws + WS_W1T), MTOK, NCOMB, DM}; pg8::StaticOrder S; S.init(MTOK, NCOMB, G, (int)blockIdx.x);
          pg8::EpiP1 E{ws, outb, (const float*)P.in[I_BGATE], (const float*)P.in[I_DAQN], (const float*)P.in[I_DAKN]};
          pg8::gemm_phase<pg8::EpiP1, pg8::StaticOrder, true, true>(lds3, g, S, E, wave_s); }
        { pg8::Gemm g{(const pg8::bf16_t*)(ws + WS_MN), (const pg8::bf16_t*)(ws + WS_WMEM), MEMROWS, 1024, DM}; pg8::StaticOrder S; S.init(MEMROWS, 1024, G, ((int)blockIdx.x + G / 2) % G);
          pg8::EpiPlain E{(pg8::bf16_t*)(ws + WS_MKV), 1024};
          pg8::gemm_phase<pg8::EpiPlain, pg8::StaticOrder, true, true>(lds3, g, S, E, wave_s); }
        {
            const int lo = (G >= 64) ? G / 2 + 16 : 0;
            if ((int)blockIdx.x >= lo) { LAUNDER(); __syncthreads(); p0_items<false>(P, lds, lane, wave, ((int)blockIdx.x - lo) * NWAVES + wave, (G - lo) * NWAVES); } }
    }
    SEAM(1);
    if (IN(2)) { PHASE_P();
        { LAUNDER(); p2a_qknorm_rope(P, lane, wave); }
        { const int NU = NB * 6 * (SEQ / 64), per = (NU + G - 1) / G; const int ub = (int)blockIdx.x * per; gdn_intra_block(P, lds, wave_s, ub, ub + per < NU ? ub + per : NU); }
        STAMP(9);
    }
    SEAM(2);
    if (IN(3)) { PHASE_P();
        LAUNDER();
        if ((int)blockIdx.x < 24) gdn_scan_unit(P, lds, wave_s, (int)blockIdx.x / 6, (int)blockIdx.x % 6);
        STAMP(10);
        unsigned* qx = xbar + XB_QUEUE; const int myx = (int)(xcc & 7u);
        int qi = 0;
        for (;;) {
            __syncthreads();
            if (tid == 0) { int u = -1, q = qi;
                while (q < 8) { const int x = (myx + q) & 7; const int t = (int)xb_add(&qx[64 * x], 1u); if (t < 256) { u = x * 256 + t; break; } ++q; }
                *(volatile int*)(lds + LDS_BYTES - 16) = u; *(volatile int*)(lds + LDS_BYTES - 12) = q; }
            __syncthreads();
            const int u = *(volatile int*)(lds + LDS_BYTES - 16); qi = *(volatile int*)(lds + LDS_BYTES - 12);
            if (u < 0) break;
            const int x = u >> 8, t = u & 255;
            if (t < 192) { const int bh = 3 * x + (t >> 6), qb = 63 - (t & 63); attn_pipe_unit(P, lds, wave_s, bh / 6, bh % 6, qb); }
            else { const int v = x * 64 + (t - 192), qb = v & 31, bh = v >> 5; attn_mfma_unit<true>(P, lds, wave_s, bh >> 2, bh & 3, qb); }
        }
        __syncthreads();
    }
    SEAM(3);
    if (IN(4)) { PHASE_P();
        pg8::ChainOrder S; S.init(MTOK, DM, G, (int)blockIdx.x);
        pg8::Gemm g{(const pg8::bf16_t*)(ws + WS_DAQ), (const pg8::bf16_t*)(ws + WS_WOD), MTOK, DM, 768};
        pg8::EpiChain E{(const pg8::bf16_t*)(ws + WS_DAQ), (const pg8::bf16_t*)(ws + WS_GZ), (const pg8::bf16_t*)(outb + OUT_CAQ),
                        (const pg8::bf16_t*)(ws + WS_WOD), (const pg8::bf16_t*)(ws + WS_WODL), (const pg8::bf16_t*)(ws + WS_WOC), 768, 768, 512,
                        ws + WS_GATES, (pg8::bf16_t*)(ws + WS_MIXED)};
        pg8::gemm_phase<pg8::EpiChain, pg8::ChainOrder, true, true>(lds3, g, S, E, wave_s);
    }
    SEAM(4);
    if (IN(5)) { PHASE_P();
        pg8::Gemm g{(const pg8::bf16_t*)(ws + WS_MIXED), (const pg8::bf16_t*)(ws + WS_WOUT), MTOK, DM, DM}; pg8::StaticOrder S; S.init(MTOK, DM, G, (int)blockIdx.x);
        pg8::EpiRes1 E{(const float*)P.in[I_X], P.out, (pg8::bf16_t*)(ws + WS_X1B), (float*)(ws + WS_ROWSS)};
        pg8::gemm_phase<pg8::EpiRes1, pg8::StaticOrder, true, true>(lds3, g, S, E, wave_s);
    }
    SEAM(5);
    if (IN(6)) { PHASE_P();
        pg8::Gemm g{(const pg8::bf16_t*)(ws + WS_X1B), (const pg8::bf16_t*)(ws + WS_WM1), MTOK, DFF, DM}; pg8::StaticOrder S; S.init(MTOK, DFF, G, (int)blockIdx.x);
        pg8::EpiMlp1 E{(pg8::bf16_t*)(ws + WS_HMID)};
        pg8::gemm_phase<pg8::EpiMlp1, pg8::StaticOrder, true, true>(lds3, g, S, E, wave_s);
    }
    SEAM(6);
    if (IN(7)) { PHASE_P();
        pg8::Gemm g{(const pg8::bf16_t*)(ws + WS_HMID), (const pg8::bf16_t*)(ws + WS_WM2), MTOK, DM, DFF}; pg8::StaticOrder S; S.init(MTOK, DM, G, (int)blockIdx.x);
        pg8::EpiRes2 E{(const pg8::bf16_t*)(ws + WS_X1B), (const float*)(ws + WS_ROWSS), P.out};
        pg8::gemm_phase<pg8::EpiRes2, pg8::StaticOrder, true, true>(lds3, g, S, E, wave_s);
    }
#ifdef PROBE_A
    xcd_barrier(xbar, xcc, mk_tid(wave_s)); STAMP(8); __syncthreads();
    if (blockIdx.x == 0 && threadIdx.x == 0) { const unsigned long long* ts = (const unsigned long long*)(ws + WS_MISC + 32768);
        Pk->out[0] += (float)(ts[PROBE_A2] - ts[PROBE_A]) * 0.0001f; }
#endif
#undef IN
#undef SEAM
}

#ifndef MK_SPLIT
#define MK_SPLIT 0
#endif
extern "C" void kernel_launch(void* const* d_in, const int* in_sizes, int n_in, void* d_out, int out_size, void* d_ws, size_t ws_size, hipStream_t stream) {
    static int grid = 0;
    if (grid == 0) {
        if (n_in != 29 || in_sizes[0] != MTOK * DM || out_size != MTOK * DM || ws_size < WS_NEED) {
            fprintf(stderr, "kernel_launch: unexpected problem: n_in %d in0 %d out %d ws %zu (need %zu)\n", n_in, n_in > 0 ? in_sizes[0] : -1, out_size, ws_size, (size_t)WS_NEED); grid = -1; return; }
        int dev = 0, cus = 0, per_cu = 0;
        hipGetDevice(&dev); hipDeviceGetAttribute(&cus, hipDeviceAttributeMultiprocessorCount, dev);
        if (hipFuncSetAttribute((const void*)mega_fwd, hipFuncAttributeMaxDynamicSharedMemorySize, LDS_BYTES) != hipSuccess) { fprintf(stderr, "kernel_launch: hipFuncSetAttribute failed\n"); grid = -1; return; }
        if (hipOccupancyMaxActiveBlocksPerMultiprocessor(&per_cu, (const void*)mega_fwd, NTHR, LDS_BYTES) != hipSuccess || per_cu < 1) { fprintf(stderr, "kernel_launch: occupancy query says %d\n", per_cu); per_cu = 1; }
        (void)hipGetLastError();
        grid = cus * 1;
        fprintf(stderr, "kernel_launch: cus %d per_cu %d grid %d ws %zu\n", cus, per_cu, grid, ws_size);
    }
    if (grid < 0) return;
    Params p{};
    for (int i = 0; i < 29; ++i) p.in[i] = d_in[i];
    p.out = (float*)d_out; p.ws = (unsigned char*)d_ws;
#if MK_SPLIT
    for (int ph = 0; ph < NPHASE; ++ph) { p.lo = ph; p.hi = ph + 1; hipLaunchKernelGGL(mega_fwd, dim3(grid), dim3(NTHR), LDS_BYTES, stream, p); }
#else
    p.lo = 0; p.hi = NPHASE;
    void* args[] = { &p };
    hipError_t e = hipLaunchCooperativeKernel((const void*)mega_fwd, dim3(grid), dim3(NTHR), args, LDS_BYTES, stream);
    if (e != hipSuccess) fprintf(stderr, "kernel_launch: cooperative launch failed: %s (grid %d)\n", hipGetErrorString(e), grid);
#endif
}
```

```cpp
#include <hip/hip_runtime.h>
#include <hip/hip_cooperative_groups.h>
#include <cstdio>
#include <cstdint>
namespace cg = cooperative_groups;

constexpr int NB = 4, SEQ = 8192, DM = 1024, MTOK = NB * SEQ;
constexpr int NMEM = 256, MEMROWS = NB * NMEM;
constexpr int DIN = 5900, NGATE = 3072, DFF = 4096;
constexpr int NCOMB = 8960;
constexpr float EPS = 1e-6f;
constexpr float C2_DA = 0.125f * 1.4426950408889634f;
constexpr float C2_CA = 0.08838834764831845f * 1.4426950408889634f;
constexpr float LAM_INIT = 0.2f;

constexpr size_t MiB = (size_t)1 << 20;
constexpr size_t WS_W1T = 0, WS_WOD = 18 * MiB, WS_WODL = 19 * MiB + 512 * 1024, WS_WOC = 21 * MiB  , WS_WOUT = 23 * MiB, WS_WM1 = 25 * MiB, WS_WM2 = 33 * MiB, WS_WMEM = 41 * MiB;
constexpr size_t WS_ROPEC = 43 * MiB, WS_ROPES = 47 * MiB, WS_BT = 51 * MiB, WS_LA = 52 * MiB, WS_MN = 53 * MiB, WS_MKV = 55 * MiB, WS_HALO = 57 * MiB;
constexpr size_t WS_ROWSS = 63 * MiB + 768 * 1024, WS_MISC = 63 * MiB + 960 * 1024;
constexpr size_t WS_GATES = 64 * MiB;
constexpr size_t WS_DAQ = 160 * MiB, WS_SEC = 48 * MiB;
constexpr size_t WS_DAK = WS_DAQ + WS_SEC, WS_DAV = WS_DAQ + 2 * WS_SEC, WS_GQ = WS_DAQ + 3 * WS_SEC, WS_GK = WS_DAQ + 4 * WS_SEC, WS_GV = WS_DAQ + 5 * WS_SEC, WS_GZ = WS_DAQ + 6 * WS_SEC;
constexpr size_t WS_MIXF = 208 * MiB, WS_MIXED = 336 * MiB, WS_X1B = 416 * MiB, WS_HMID = 160 * MiB;
constexpr size_t WS_NEED = 496 * MiB;
constexpr size_t OUT_HB = 0, OUT_CAQ = 72 * MiB;

__device__ __forceinline__ int mk_tid(int wave_s) { int l; asm volatile("v_mbcnt_lo_u32_b32 %0, -1, 0\n\tv_mbcnt_hi_u32_b32 %0, -1, %0" : "=v"(l)); return wave_s * 64 + l; }
namespace pg8 {
#define PG8_LAS __attribute__((address_space(3)))
typedef unsigned short bf16_t;
typedef short bf16x8 __attribute__((ext_vector_type(8)));
typedef float f32x4 __attribute__((ext_vector_type(4)));
typedef unsigned u32x4 __attribute__((ext_vector_type(4)));
constexpr int BM = 256, BK = 64, HALF = 128, HTB = HALF * BK * 2  , STAGE_BYTES = 8 * HTB, NXCD = 8, WGM = 8;

__host__ __device__ __forceinline__ int lds_byte(int r, int c) { const int st = (r >> 4) * 2 + (c >> 5), rr = r & 15, cc = c & 31, ob = rr * 64 + cc * 2; return st * 1024 + (ob ^ (((ob >> 9) & 1) << 5)); }
__host__ __device__ __forceinline__ void stage_rc(int b, int& R, int& C) { const int st = b / 1024, sb = b % 1024, swz = sb ^ (((sb >> 9) & 1) << 5); R = (st >> 1) * 16 + swz / 64; C = (st & 1) * 32 + (swz % 64) / 2; }
__host__ __device__ __forceinline__ int perm32(int rho) { const int n = rho >> 4, i = rho & 15; return 8 * (i >> 2) + 4 * n + (i & 3); }

struct Unit { int pm, pn, seg; };
struct Gemm { const bf16_t* A; const bf16_t* Bt; int M, N, K; int a_tiled = 0; };

struct StaticOrder {
    int nM, nN, nwg, G, c; bool rev = false; int wgm = WGM;
    __host__ __device__ void init(int M, int N, int G_, int c_) { nM = M / BM; nN = N / BM; nwg = nM * nN; G = G_; c = c_; }
    __host__ __device__ bool next(int i, Unit& u) const {
        const long L = (long)i * G + c; if (L >= nwg) return false;
        int wgid = (int)L; { const int q = nwg / NXCD, r = nwg % NXCD, xcd = wgid % NXCD, off = wgid / NXCD; wgid = (xcd < r ? xcd * (q + 1) : r * (q + 1) + (xcd - r) * q) + off; }
        const int nig = wgm * nN, gid = wgid / nig, fm = gid * wgm, gsz = (nM - fm) < wgm ? (nM - fm) : wgm;
        u.pm = fm + ((wgid % nig) % gsz); u.pn = (wgid % nig) / gsz; u.seg = 0; if (rev) u.pm = nM - 1 - u.pm; return true;
    }
    __device__ __forceinline__ void a_ready(const Unit&) const {}
    __device__ __forceinline__ void done(const Unit&) const {}
};
struct ChainOrder : StaticOrder {
    __host__ __device__ bool next(int i, Unit& u) const { const int t = i / 3; if (!StaticOrder::next(t, u)) return false; u.seg = i - 3 * t; return true; }
};

__device__ __forceinline__ unsigned cvt_pk_bf16(float lo, float hi) { unsigned r; asm volatile("v_cvt_pk_bf16_f32 %0, %1, %2" : "=v"(r) : "v"(lo), "v"(hi)); return r; }
typedef unsigned u32x2 __attribute__((ext_vector_type(2)));
__device__ __forceinline__ u32x4 pack8(const f32x4 a, const f32x4 b) { u32x4 w; w.x = cvt_pk_bf16(a[0], a[1]); w.y = cvt_pk_bf16(a[2], a[3]); w.z = cvt_pk_bf16(b[0], b[1]); w.w = cvt_pk_bf16(b[2], b[3]); return w; }
__device__ __forceinline__ float sigm(float x) { return __builtin_amdgcn_rcpf(1.0f + __expf(-x)); }

struct EpiPlain {
    static constexpr bool PERM = true, AFTER_DRAIN = false, CHAIN = false;
    bf16_t* O; int ldc;
    __device__ __forceinline__ void operator()(const f32x4 (&acc)[2][2][4][2], const Unit& u, int wr, int wc, int fr, int fq) const {
        const int row0 = u.pm * BM + wr * 64 + fr, col0 = u.pn * BM + wc * 32 + 8 * fq;
#pragma unroll
        for (int ai = 0; ai < 2; ++ai)
#pragma unroll
            for (int m = 0; m < 4; ++m) { bf16_t* rowp = O + (size_t)(row0 + ai * HALF + m * 16) * ldc + col0;
#pragma unroll
                for (int bj = 0; bj < 2; ++bj) *(u32x4*)(rowp + bj * HALF) = pack8(acc[ai][bj][m][0], acc[ai][bj][m][1]); }
    }
};

struct EpiP1 {
    static constexpr bool PERM = true, AFTER_DRAIN = false, CHAIN = false;
    unsigned char* ws; unsigned char* outb; const float* bgate; const float* qng; const float* kng;
    __device__ __forceinline__ void operator()(const f32x4 (&acc)[2][2][4][2], const Unit& u, int wr, int wc, int fr, int fq) const {
        const int pn = u.pn, row0 = u.pm * BM + wr * 64 + fr, cl0 = wc * 32 + 8 * fq;
        if (pn < 6) {
            const bool isk = pn >= 3; bf16_t* base = (bf16_t*)(ws + (isk ? WS_DAK : WS_DAQ)); const float* g = isk ? kng : qng;
            const int hm = 4 * (pn - (isk ? 3 : 0)) + wc; const float osc = isk ? 1.0f : C2_DA;
            f32x4 g1[2], g2[2];
#pragma unroll
            for (int n = 0; n < 2; ++n) { g1[n] = *(const f32x4*)(g + 8 * fq + 4 * n); g2[n] = *(const f32x4*)(g + 32 + 8 * fq + 4 * n); }
            const float* RC = (const float*)(ws + WS_ROPEC); const float* RS = (const float*)(ws + WS_ROPES);
#pragma unroll
            for (int ai = 0; ai < 2; ++ai)
#pragma unroll
                for (int m = 0; m < 4; ++m) { const int row = row0 + ai * HALF + m * 16;
                    float ss = 0.f;
#pragma unroll
                    for (int bj = 0; bj < 2; ++bj)
#pragma unroll
                        for (int n = 0; n < 2; ++n) { const f32x4 v = acc[ai][bj][m][n]; ss += (v[0] * v[0] + v[1] * v[1]) + (v[2] * v[2] + v[3] * v[3]); }
                    ss += __shfl_xor(ss, 16); ss += __shfl_xor(ss, 32);
                    const float rs = __builtin_amdgcn_rsqf(ss * (1.0f / 64.0f) + EPS) * osc;
                    f32x4 o1[2], o2[2];
#pragma unroll
                    for (int n = 0; n < 2; ++n) { const f32x4 c = *(const f32x4*)(RC + (size_t)row * 32 + 8 * fq + 4 * n), sn = *(const f32x4*)(RS + (size_t)row * 32 + 8 * fq + 4 * n);
                        const f32x4 y1 = acc[ai][0][m][n] * rs * g1[n], y2 = acc[ai][1][m][n] * rs * g2[n];
                        o1[n] = y1 * c - y2 * sn; o2[n] = y2 * c + y1 * sn; }
                    bf16_t* rowp = isk ? base + ((size_t)((row >> 13) * 6 + (hm >> 1)) * SEQ + (row & (SEQ - 1))) * 128 + (hm & 1) * 64 + 8 * fq
                                       : base + (size_t)row * 768 + hm * 64 + 8 * fq;
                    *(u32x4*)rowp = pack8(o1[0], o1[1]); *(u32x4*)(rowp + 32) = pack8(o2[0], o2[1]); }
        } else if (pn < 23) {
            bf16_t* base; int ldc, colt;
            if (pn < 21) { const int bi = pn / 3; base = (bf16_t*)(ws + WS_DAQ + (size_t)bi * WS_SEC); ldc = 768; colt = (pn - 3 * bi) * 256; }
            else { base = (bf16_t*)(outb + OUT_CAQ); ldc = 768; colt = (pn - 21) * 256; }
            const bool halo = (pn >= 9 && pn < 18), isv = (pn >= 6 && pn < 9);
            bf16_t* hb = (bf16_t*)(ws + WS_HALO);
#pragma unroll
            for (int ai = 0; ai < 2; ++ai)
#pragma unroll
                for (int m = 0; m < 4; ++m) { const int row = row0 + ai * HALF + m * 16; bf16_t* rowp = base + (size_t)row * ldc + colt + cl0;
                    if (isv) rowp = base + ((size_t)((row >> 13) * 6 + (pn - 6) * 2) * SEQ + (row & (SEQ - 1))) * 128 + cl0;
#pragma unroll
                    for (int bj = 0; bj < 2; ++bj) { const u32x4 w = pack8(acc[ai][bj][m][0], acc[ai][bj][m][1]); *(u32x4*)(rowp + (isv ? (size_t)bj * SEQ * 128 : (size_t)bj * HALF)) = w;
                        if (halo && (row & 63) >= 61) *(u32x4*)(hb + ((size_t)(row >> 6) * 3 + ((row & 63) - 61)) * 2304 + (pn - 9) * 256 + bj * HALF + cl0) = w; } }
        } else {
            unsigned char* gb = ws + WS_GATES; const int colt = (pn - 23) * 256 + cl0;
            f32x4 bv[2][2];
#pragma unroll
            for (int bj = 0; bj < 2; ++bj)
#pragma unroll
                for (int n = 0; n < 2; ++n) bv[bj][n] = *(const f32x4*)(bgate + colt + bj * HALF + 4 * n);
#pragma unroll
            for (int ai = 0; ai < 2; ++ai)
#pragma unroll
                for (int m = 0; m < 4; ++m) { const int row = row0 + ai * HALF + m * 16; unsigned char* rowp = gb + (size_t)row * NGATE + colt;
#pragma unroll
                    for (int bj = 0; bj < 2; ++bj) { const f32x4 v0 = acc[ai][bj][m][0] + bv[bj][0], v1 = acc[ai][bj][m][1] + bv[bj][1];
                        unsigned q[8];
#pragma unroll
                        for (int i = 0; i < 4; ++i) { q[i] = (unsigned)__builtin_fmaxf(1.0f, __builtin_rintf(255.0f * sigm(v0[i]))); q[4 + i] = (unsigned)__builtin_fmaxf(1.0f, __builtin_rintf(255.0f * sigm(v1[i])));     }
                        u32x2 w; w.x = q[0] | (q[1] << 8) | (q[2] << 16) | (q[3] << 24); w.y = q[4] | (q[5] << 8) | (q[6] << 16) | (q[7] << 24);
                        *(u32x2*)(rowp + bj * HALF) = w; } }
        }
    }
};

template <int MODE> struct EpiGate {
    static constexpr bool PERM = true, AFTER_DRAIN = false, CHAIN = false;
    const unsigned char* gates; float* mixf; bf16_t* mixed; int br;
    __device__ __forceinline__ void operator()(const f32x4 (&acc)[2][2][4][2], const Unit& u, int wr, int wc, int fr, int fq) const {
        const int row0 = u.pm * BM + wr * 64 + fr, col0 = u.pn * BM + wc * 32 + 8 * fq;
#pragma unroll
        for (int ai = 0; ai < 2; ++ai)
#pragma unroll
            for (int m = 0; m < 4; ++m) { const int row = row0 + ai * HALF + m * 16;
#pragma unroll
                for (int bj = 0; bj < 2; ++bj) { const int col = col0 + bj * HALF;
                    const u32x2 gw = *(const u32x2*)(gates + (size_t)row * NGATE + br * 1024 + col);
                    f32x4 g0, g1;
#pragma unroll
                    for (int i = 0; i < 4; ++i) { g0[i] = (float)((gw.x >> (8 * i)) & 255u) * (1.0f / 255.0f); g1[i] = (float)((gw.y >> (8 * i)) & 255u) * (1.0f / 255.0f); }
                    f32x4 v0 = acc[ai][bj][m][0] * g0, v1 = acc[ai][bj][m][1] * g1;
                    float* mp = mixf + (size_t)row * DM + col;
                    if (MODE >= 1) { v0 = v0 + *(const f32x4*)mp; v1 = v1 + *(const f32x4*)(mp + 4); }
                    if (MODE <= 1) { *(f32x4*)mp = v0; *(f32x4*)(mp + 4) = v1; }
                    else *(u32x4*)(mixed + (size_t)row * DM + col) = pack8(v0, v1); } }
    }
};

struct EpiRes1 {
    static constexpr bool PERM = true, AFTER_DRAIN = false, CHAIN = false;
    const float* x; float* out; bf16_t* x1b; float* rowss;
    __device__ __forceinline__ void operator()(const f32x4 (&acc)[2][2][4][2], const Unit& u, int wr, int wc, int fr, int fq) const {
        const int row0 = u.pm * BM + wr * 64 + fr, col0 = u.pn * BM + wc * 32 + 8 * fq;
#pragma unroll
        for (int ai = 0; ai < 2; ++ai) {
            f32x4 xr[4][2][2];
#pragma unroll
            for (int m = 0; m < 4; ++m)
#pragma unroll
                for (int bj = 0; bj < 2; ++bj) { const float* xp = x + (size_t)(row0 + ai * HALF + m * 16) * DM + col0 + bj * HALF; xr[m][bj][0] = __builtin_nontemporal_load((const f32x4*)xp); xr[m][bj][1] = __builtin_nontemporal_load((const f32x4*)(xp + 4)); }
            asm volatile("" ::: "memory");
#pragma unroll
            for (int m = 0; m < 4; ++m) { const int row = row0 + ai * HALF + m * 16; float ss = 0.f;
#pragma unroll
                for (int bj = 0; bj < 2; ++bj) { const size_t off = (size_t)row * DM + col0 + bj * HALF;
                    const f32x4 v0 = acc[ai][bj][m][0] + xr[m][bj][0], v1 = acc[ai][bj][m][1] + xr[m][bj][1];
                    *(u32x4*)(x1b + off) = pack8(v0, v1);
                    ss += (v0[0] * v0[0] + v0[1] * v0[1]) + (v0[2] * v0[2] + v0[3] * v0[3]) + (v1[0] * v1[0] + v1[1] * v1[1]) + (v1[2] * v1[2] + v1[3] * v1[3]); }
                ss += __shfl_xor(ss, 16); ss += __shfl_xor(ss, 32);
                if (fq == 0) atomicAdd(rowss + row, ss); } }
    }
};

struct EpiMlp1 {
    static constexpr bool PERM = true, AFTER_DRAIN = false, CHAIN = false;
    bf16_t* O;
    __device__ __forceinline__ void operator()(const f32x4 (&acc)[2][2][4][2], const Unit& u, int wr, int wc, int fr, int fq) const {
        const int row0 = u.pm * BM + wr * 64 + fr, col0 = u.pn * BM + wc * 32 + 8 * fq;
#pragma unroll
        for (int ai = 0; ai < 2; ++ai)
#pragma unroll
            for (int m = 0; m < 4; ++m) { const int rr = wr * 64 + fr + ai * HALF + m * 16;
                bf16_t* rowp = O + ((size_t)u.pm * (DFF / BK) + 4 * u.pn + (wc >> 1)) * (BM * BK) + rr * BK + (wc & 1) * 32 + 8 * fq;
#pragma unroll
                for (int bj = 0; bj < 2; ++bj) { f32x4 v0 = acc[ai][bj][m][0], v1 = acc[ai][bj][m][1];
#pragma unroll
                    for (int i = 0; i < 4; ++i) { const float a = __builtin_fmaxf(v0[i], 0.f), b = __builtin_fmaxf(v1[i], 0.f); v0[i] = a * a; v1[i] = b * b; }
                    *(u32x4*)(rowp + (size_t)bj * 2 * (BM * BK)) = pack8(v0, v1); } }
    }
};
struct EpiRes2 {
    static constexpr bool PERM = true, AFTER_DRAIN = false, CHAIN = false;
    const bf16_t* x1b; const float* rowss; float* out;
    __device__ __forceinline__ void operator()(const f32x4 (&acc)[2][2][4][2], const Unit& u, int wr, int wc, int fr, int fq) const {
        const int row0 = u.pm * BM + wr * 64 + fr, col0 = u.pn * BM + wc * 32 + 8 * fq;
        u32x4 xr[2][4][2]; float rsv[2][4];
#pragma unroll
        for (int ai = 0; ai < 2; ++ai)
#pragma unroll
            for (int m = 0; m < 4; ++m) { rsv[ai][m] = rowss[row0 + ai * HALF + m * 16];
#pragma unroll
                for (int bj = 0; bj < 2; ++bj) xr[ai][m][bj] = *(const u32x4*)(x1b + (size_t)(row0 + ai * HALF + m * 16) * DM + col0 + bj * HALF); }
        asm volatile("" ::: "memory");
#pragma unroll
        for (int ai = 0; ai < 2; ++ai)
#pragma unroll
            for (int m = 0; m < 4; ++m) { const float r2 = __builtin_amdgcn_rcpf(rsv[ai][m] * (1.0f / 1024.0f) + EPS);
#pragma unroll
                for (int bj = 0; bj < 2; ++bj) { float* op = out + (size_t)(row0 + ai * HALF + m * 16) * DM + col0 + bj * HALF; const u32x4 w = xr[ai][m][bj];
                    const f32x4 r0 = {__builtin_bit_cast(float, w.x << 16), __builtin_bit_cast(float, w.x & 0xffff0000u), __builtin_bit_cast(float, w.y << 16), __builtin_bit_cast(float, w.y & 0xffff0000u)};
                    const f32x4 r1 = {__builtin_bit_cast(float, w.z << 16), __builtin_bit_cast(float, w.z & 0xffff0000u), __builtin_bit_cast(float, w.w << 16), __builtin_bit_cast(float, w.w & 0xffff0000u)};
                    *(f32x4*)op = acc[ai][bj][m][0] * r2 + r0; *(f32x4*)(op + 4) = acc[ai][bj][m][1] * r2 + r1; } }
    }
};

struct EpiChain {
    static constexpr bool PERM = true, AFTER_DRAIN = false, CHAIN = true;
    const bf16_t *A0, *A1, *A2, *B0, *B1, *B2; int k0, k1, k2;
    const unsigned char* gates; bf16_t* mixed;
    __device__ __forceinline__ const bf16_t* segA(int s) const { return (const bf16_t*)((unsigned long long)A0 + (unsigned long long)(s == 1) * ((unsigned long long)A1 - (unsigned long long)A0) + (unsigned long long)(s == 2) * ((unsigned long long)A2 - (unsigned long long)A0)); }
    __device__ __forceinline__ const bf16_t* segB(int s) const { return (const bf16_t*)((unsigned long long)B0 + (unsigned long long)(s == 1) * ((unsigned long long)B1 - (unsigned long long)B0) + (unsigned long long)(s == 2) * ((unsigned long long)B2 - (unsigned long long)B0)); }
    __device__ __forceinline__ int segK(int s) const { return k0 + (s == 1) * (k1 - k0) + (s == 2) * (k2 - k0); }
    __device__ __forceinline__ void chain(f32x4 (&acc)[2][2][4][2], const Unit& u, int wr, int wc, int fr, int fq) const {
        const int row0 = u.pm * BM + wr * 64 + fr, col0 = u.pn * BM + wc * 32 + 8 * fq; const int sg = u.seg; const int sd = sg < 2 ? sg + 1 : sg;
#pragma unroll
        for (int ai = 0; ai < 2; ++ai) {
            u32x2 gnv[4][2], gdv[4][2];
#pragma unroll
            for (int m = 0; m < 4; ++m)
#pragma unroll
                for (int bj = 0; bj < 2; ++bj) { const unsigned char* gp = gates + (size_t)(row0 + ai * HALF + m * 16) * NGATE + col0 + bj * HALF; gnv[m][bj] = *(const u32x2*)(gp + sg * 1024); gdv[m][bj] = *(const u32x2*)(gp + sd * 1024); }
            asm volatile("" ::: "memory");
#pragma unroll
            for (int m = 0; m < 4; ++m) { const int row = row0 + ai * HALF + m * 16;
#pragma unroll
                for (int bj = 0; bj < 2; ++bj) { const int col = col0 + bj * HALF; const u32x2 gn = gnv[m][bj], gd = gdv[m][bj];
                    f32x4 f0, f1;
                    if (sg < 2) {
#pragma unroll
                        for (int i = 0; i < 4; ++i) { f0[i] = (float)((gn.x >> (8 * i)) & 255u) * __builtin_amdgcn_rcpf((float)((gd.x >> (8 * i)) & 255u)); f1[i] = (float)((gn.y >> (8 * i)) & 255u) * __builtin_amdgcn_rcpf((float)((gd.y >> (8 * i)) & 255u)); }
                        acc[ai][bj][m][0] = acc[ai][bj][m][0] * f0; acc[ai][bj][m][1] = acc[ai][bj][m][1] * f1;
                    } else {
#pragma unroll
                        for (int i = 0; i < 4; ++i) { f0[i] = (float)((gn.x >> (8 * i)) & 255u) * (1.0f / 255.0f); f1[i] = (float)((gn.y >> (8 * i)) & 255u) * (1.0f / 255.0f); }
                        *(u32x4*)(mixed + (size_t)row * DM + col) = pack8(acc[ai][bj][m][0] * f0, acc[ai][bj][m][1] * f1); } } } }
    }
};

template <class Epi, class Sched, bool ALIGN_EPI = false, bool SP2 = false>
__device__ __forceinline__ void gemm_phase(PG8_LAS unsigned char* lds, const Gemm g, const Sched& S, const Epi& E, int wave_s) {
    int tid_ = mk_tid(wave_s); asm volatile("" : "+v"(tid_));
    const int tid = tid_, wid = __builtin_amdgcn_readfirstlane(tid >> 6), lane = tid & 63, wr = wid >> 2, wc = wid & 3, fr = lane & 15, fq = lane >> 4;
    const int K = g.K; int nt = K / BK;
    unsigned voffA[2], voffB[2];
#pragma unroll
    for (int i = 0; i < 2; ++i) { int R, C; stage_rc(tid * 16 + i * 8192, R, C); const int Rb = Epi::PERM ? ((R & ~31) + perm32(R & 31)) : R;
        voffA[i] = (unsigned)(R * (g.a_tiled ? BK : K) + C) * 2u; voffB[i] = (unsigned)(Rb * K + C) * 2u; }
    const size_t kstep = (size_t)(BK * 2);
    const size_t hstep = (size_t)HALF * K * 2;
    const size_t tstep = 2 * hstep;
    const size_t kstepA = g.a_tiled ? (size_t)BM * BK * 2 : kstep, hstepA = g.a_tiled ? (size_t)HALF * BK * 2 : hstep;
    const unsigned ldsw = (unsigned)wid * 1024u;
    const int aoff = lds_byte(wr * 64 + fr, fq * 8), boff = lds_byte(wc * 32 + fr, fq * 8);
#define PG8_SA(b, h) (((b) * 2 + (h)) * HTB)
#define PG8_SB(b, h) ((4 + (b) * 2 + (h)) * HTB)
#define PG8_STAGE(bufoff, gbase, voff) do { _Pragma("unroll") for (int _i = 0; _i < 2; ++_i) \
        __builtin_amdgcn_global_load_lds((const unsigned*)((const char*)(gbase) + (voff)[_i]), (PG8_LAS unsigned*)(lds + (bufoff) + ldsw + _i * 8192), 16, 0, 0); } while (0)
#define PG8_LDA(dst, b, h) do { _Pragma("unroll") for (int m = 0; m < 4; ++m) _Pragma("unroll") for (int k = 0; k < 2; ++k) dst[m][k] = *(const PG8_LAS bf16x8*)(lds + PG8_SA(b, h) + aoff + m * 2048 + k * 1024); } while (0)
#define PG8_LDB(dst, b, h) do { _Pragma("unroll") for (int n = 0; n < 2; ++n) _Pragma("unroll") for (int k = 0; k < 2; ++k) dst[n][k] = *(const PG8_LAS bf16x8*)(lds + PG8_SB(b, h) + boff + n * 2048 + k * 1024); } while (0)
#define PG8_MMA(ai, bj, At, Bt) do { __builtin_amdgcn_s_setprio(1); _Pragma("unroll") for (int m = 0; m < 4; ++m) _Pragma("unroll") for (int n = 0; n < 2; ++n) _Pragma("unroll") for (int k = 0; k < 2; ++k) \
        acc[ai][bj][m][n] = __builtin_amdgcn_mfma_f32_16x16x32_bf16(Bt[n][k], At[m][k], acc[ai][bj][m][n], 0, 0, 0); __builtin_amdgcn_s_setprio(0); } while (0)
#define PG8_WAIT_V(n) asm volatile("s_waitcnt vmcnt(" #n ")" ::: "memory")
#define PG8_WAIT_L(n) asm volatile("s_waitcnt lgkmcnt(" #n ")" ::: "memory")
#define PG8_BAR __builtin_amdgcn_s_barrier()
#define PG8_SCHED __builtin_amdgcn_sched_barrier(0)
    Unit cur, nxt; int ui = 0;
    if (!S.next(0, cur)) return;
    f32x4 acc[2][2][4][2];
#pragma unroll
    for (int a = 0; a < 2; ++a)
#pragma unroll
        for (int b = 0; b < 2; ++b)
#pragma unroll
            for (int m = 0; m < 4; ++m)
#pragma unroll
                for (int n = 0; n < 2; ++n) acc[a][b][m][n] = (f32x4){0.f, 0.f, 0.f, 0.f};
    bf16x8 At[4][2], B0[2][2], B1[2][2];
    const char* cA = (const char*)g.A + (size_t)cur.pm * tstep; const char* cB = (const char*)g.Bt + (size_t)cur.pn * tstep;
    if constexpr (Epi::CHAIN) { cA = (const char*)E.segA(cur.seg) + (size_t)cur.pm * tstep; cB = (const char*)E.segB(cur.seg) + (size_t)cur.pn * tstep; nt = E.segK(cur.seg) / BK; }
    S.a_ready(cur);
    if constexpr (SP2) {
        PG8_STAGE(PG8_SB(0, 0), cB, voffB); PG8_STAGE(PG8_SB(0, 1), cB + hstep, voffB); PG8_STAGE(PG8_SA(0, 0), cA, voffA); PG8_STAGE(PG8_SA(0, 1), cA + hstepA, voffA);
        if (wr == 1) PG8_BAR;
        PG8_WAIT_V(2); PG8_BAR;
        PG8_STAGE(PG8_SB(1, 0), cB + kstep, voffB); PG8_STAGE(PG8_SA(1, 0), cA + kstepA, voffA); PG8_STAGE(PG8_SB(1, 1), cB + hstep + kstep, voffB);
        PG8_WAIT_V(6); PG8_BAR;
    } else {
        PG8_STAGE(PG8_SB(0, 0), cB, voffB); PG8_STAGE(PG8_SA(0, 0), cA, voffA); PG8_STAGE(PG8_SB(0, 1), cB + hstep, voffB); PG8_STAGE(PG8_SA(0, 1), cA + hstepA, voffA);
        if (wr == 1) PG8_BAR;
        PG8_WAIT_V(4); PG8_BAR;
        PG8_STAGE(PG8_SB(1, 0), cB + kstep, voffB); PG8_STAGE(PG8_SA(1, 0), cA + kstepA, voffA); PG8_STAGE(PG8_SB(1, 1), cB + hstep + kstep, voffB);
        PG8_WAIT_V(6); PG8_BAR;
    }
    for (;;) {
        const bool has_next = S.next(ui + 1, nxt);
        const char* nA = has_next ? (const char*)g.A + (size_t)nxt.pm * tstep : cA; const char* nB = has_next ? (const char*)g.Bt + (size_t)nxt.pn * tstep : cB;
        int nt_next = nt;
        if constexpr (Epi::CHAIN) { if (has_next) { nA = (const char*)E.segA(nxt.seg) + (size_t)nxt.pm * tstep; nB = (const char*)E.segB(nxt.seg) + (size_t)nxt.pn * tstep; nt_next = E.segK(nxt.seg) / BK; } }
        for (int t = 0; t < nt; t += 2) {
            const bool last = (t == nt - 2);
            const char* a1 = cA + (size_t)(t + 1) * kstepA;
            const char* a2 = last ? nA : cA + (size_t)(t + 2) * kstepA; const char* b2 = last ? nB : cB + (size_t)(t + 2) * kstep;
            const char* a3 = a2 + kstepA; const char* b3 = b2 + kstep;
            if (last && has_next) S.a_ready(nxt);
            if constexpr (SP2) {
            PG8_LDB(B0, 0, 0); PG8_LDB(B1, 0, 1); PG8_SCHED; PG8_LDA(At, 0, 0); PG8_STAGE(PG8_SA(1, 1), a1 + hstepA, voffA);
            PG8_WAIT_V(8); PG8_WAIT_L(0); PG8_BAR; PG8_MMA(0, 0, At, B0); PG8_MMA(0, 1, At, B1); PG8_BAR; PG8_SCHED;
            PG8_LDA(At, 0, 1); PG8_STAGE(PG8_SB(0, 0), b2, voffB); PG8_STAGE(PG8_SB(0, 1), b2 + hstep, voffB); PG8_STAGE(PG8_SA(0, 0), a2, voffA);
            PG8_WAIT_V(8); PG8_WAIT_L(0); PG8_BAR; PG8_MMA(1, 0, At, B0); PG8_MMA(1, 1, At, B1); PG8_BAR; PG8_SCHED;
            PG8_LDB(B0, 1, 0); PG8_LDB(B1, 1, 1); PG8_SCHED; PG8_LDA(At, 1, 0); PG8_STAGE(PG8_SA(0, 1), a2 + hstepA, voffA);
            PG8_WAIT_V(8); PG8_WAIT_L(0); PG8_BAR; PG8_MMA(0, 0, At, B0); PG8_MMA(0, 1, At, B1); PG8_BAR; PG8_SCHED;
            PG8_LDA(At, 1, 1); PG8_STAGE(PG8_SB(1, 0), b3, voffB); PG8_STAGE(PG8_SB(1, 1), b3 + hstep, voffB); PG8_STAGE(PG8_SA(1, 0), a3, voffA);
            PG8_WAIT_V(8); PG8_WAIT_L(0); PG8_BAR; PG8_MMA(1, 0, At, B0); PG8_MMA(1, 1, At, B1); PG8_BAR; PG8_SCHED;
            } else {
            PG8_LDB(B0, 0, 0); PG8_SCHED; PG8_LDA(At, 0, 0); PG8_STAGE(PG8_SA(1, 1), a1 + hstepA, voffA);
            PG8_WAIT_L(8); PG8_BAR; PG8_WAIT_L(0); PG8_MMA(0, 0, At, B0); PG8_BAR; PG8_SCHED;
            PG8_LDB(B1, 0, 1); PG8_STAGE(PG8_SB(0, 0), b2, voffB);
            PG8_BAR; PG8_WAIT_L(0); PG8_MMA(0, 1, At, B1); PG8_BAR;
            PG8_LDA(At, 0, 1); PG8_STAGE(PG8_SA(0, 0), a2, voffA);
            PG8_BAR; PG8_WAIT_L(0); PG8_MMA(1, 0, At, B0); PG8_BAR; PG8_SCHED;
            PG8_STAGE(PG8_SB(0, 1), b2 + hstep, voffB);
            PG8_WAIT_V(6); PG8_BAR; PG8_MMA(1, 1, At, B1); PG8_BAR;
            PG8_LDB(B0, 1, 0); PG8_SCHED; PG8_LDA(At, 1, 0); PG8_STAGE(PG8_SA(0, 1), a2 + hstepA, voffA);
            PG8_WAIT_L(8); PG8_BAR; PG8_WAIT_L(0); PG8_MMA(0, 0, At, B0); PG8_BAR; PG8_SCHED;
            PG8_LDB(B1, 1, 1); PG8_STAGE(PG8_SB(1, 0), b3, voffB);
            PG8_BAR; PG8_WAIT_L(0); PG8_MMA(0, 1, At, B1); PG8_BAR;
            PG8_LDA(At, 1, 1); PG8_STAGE(PG8_SA(1, 0), a3, voffA);
            PG8_BAR; PG8_WAIT_L(0); PG8_MMA(1, 0, At, B0); PG8_BAR; PG8_SCHED;
            PG8_STAGE(PG8_SB(1, 1), b3 + hstep, voffB);
            PG8_WAIT_V(6); PG8_BAR; PG8_MMA(1, 1, At, B1); PG8_BAR;
            }
        }
        if constexpr (ALIGN_EPI) { if (wr == 0) PG8_BAR; }
        if constexpr (Epi::CHAIN) { E.chain(acc, cur, wr, wc, fr, fq); S.done(cur); }
        else if constexpr (!Epi::AFTER_DRAIN) { E(acc, cur, wr, wc, fr, fq); S.done(cur); }
        if (!has_next) break;
        if (!Epi::CHAIN || cur.seg == 2)
#pragma unroll
        for (int a = 0; a < 2; ++a)
#pragma unroll
            for (int b = 0; b < 2; ++b)
#pragma unroll
                for (int m = 0; m < 4; ++m)
#pragma unroll
                    for (int n = 0; n < 2; ++n) acc[a][b][m][n] = (f32x4){0.f, 0.f, 0.f, 0.f};
        cur = nxt; cA = nA; cB = nB; nt = nt_next; ++ui;
        if constexpr (ALIGN_EPI) { if (wr == 1) PG8_BAR; }
    }
    PG8_WAIT_V(0);
    if constexpr (!ALIGN_EPI) { if (wr == 0) PG8_BAR; }
    PG8_BAR;
    if constexpr (Epi::AFTER_DRAIN) { E.fused(acc, cur, wr, wc, fr, fq, lds, wid, lane); S.done(cur); }
#undef PG8_SA
#undef PG8_SB
#undef PG8_STAGE
#undef PG8_LDA
#undef PG8_LDB
#undef PG8_MMA
#undef PG8_WAIT_V
#undef PG8_WAIT_L
#undef PG8_BAR
#undef PG8_SCHED
}
}

#define LAS __attribute__((address_space(3)))
typedef unsigned short bf16;
typedef unsigned v4u __attribute__((ext_vector_type(4)));
typedef unsigned v2u __attribute__((ext_vector_type(2)));
typedef float f32x4 __attribute__((ext_vector_type(4)));
constexpr int NWAVES = 8, NTHR = 512;
constexpr int LDS_BYTES = 147456;

typedef __bf16 bf16x2_t __attribute__((ext_vector_type(2)));
typedef float f32x2_t __attribute__((ext_vector_type(2)));
__device__ __forceinline__ unsigned pk2(float lo, float hi) { f32x2_t v = {lo, hi}; bf16x2_t b = __builtin_convertvector(v, bf16x2_t); return __builtin_bit_cast(unsigned, b); }
__device__ __forceinline__ unsigned f2bf(float f) { return pk2(f, 0.f) & 0xffffu; }
__device__ __forceinline__ float bflo(unsigned w) { return __builtin_bit_cast(float, w << 16); }
__device__ __forceinline__ float bfhi(unsigned w) { return __builtin_bit_cast(float, w & 0xffff0000u); }
__device__ __forceinline__ float bf2f(bf16 h) { return __builtin_bit_cast(float, (unsigned)h << 16); }
__device__ __forceinline__ float wave_sum(float v) {
#pragma unroll
    for (int o = 1; o < 64; o <<= 1) v += __shfl_xor(v, o);
    return v;
}
__device__ __forceinline__ float siluf(float x) { return x * __builtin_amdgcn_rcpf(1.0f + __expf(-x)); }

struct Params { const void* in[29]; float* out; unsigned char* ws; int lo, hi; };
enum { I_X = 0, I_MEM, I_POS, I_LN1G, I_WIN, I_WGATE, I_BGATE, I_DAQN, I_DAKN, I_LQ1, I_LK1, I_LQ2, I_LK2, I_SUBLN, I_WODIFF, I_WCONV, I_ALOG, I_DTB, I_GDNN, I_WODELTA,
       I_MEMN, I_WMEMKV, I_CAQN, I_CAKN, I_WOCROSS, I_WOUT, I_LN2G, I_WMLP1, I_WMLP2 };

struct TrItem { const float* W; const float* kscale; bf16* WT; int ldw, K, src_col0, dst_row0, k0; };
__device__ __forceinline__ void p0_item_load(const TrItem& d, int lane, float (&v)[32]) {
    const float* src = d.W + (size_t)(d.k0 + (lane >> 5)) * d.ldw + d.src_col0 + (lane & 31);
#pragma unroll
    for (int i = 0; i < 32; ++i) v[i] = __builtin_nontemporal_load(src + (size_t)(2 * i) * d.ldw);
}
__device__ __forceinline__ void p0_item_finish(const TrItem& d, int lane, const float (&v)[32], float* scr) {
#pragma unroll
    for (int i = 0; i < 32; ++i) { const int kk = 2 * i + (lane >> 5); float x = v[i]; if (d.kscale) x *= d.kscale[d.k0 + kk]; scr[kk * 33 + (lane & 31)] = x; }
    __builtin_amdgcn_wave_barrier(); asm volatile("s_waitcnt lgkmcnt(0)" ::: "memory");
    const int c = lane & 7;
#pragma unroll
    for (int j = 0; j < 4; ++j) { const int n = (lane >> 3) + 8 * j; const float* s = scr + (8 * c) * 33 + n;
        v4u o; o.x = pk2(s[0 * 33], s[1 * 33]); o.y = pk2(s[2 * 33], s[3 * 33]); o.z = pk2(s[4 * 33], s[5 * 33]); o.w = pk2(s[6 * 33], s[7 * 33]);
        *(v4u*)(d.WT + (size_t)(d.dst_row0 + n) * d.K + d.k0 + 8 * c) = o; }
    asm volatile("s_waitcnt lgkmcnt(0)" ::: "memory"); __builtin_amdgcn_wave_barrier();
}
constexpr int P0_I1 = 16 * 280, P0_I2 = 12 * 32, P0_I3 = 12 * 32, P0_I4 = 8 * 32, P0_I5 = 16 * 32, P0_I6 = 16 * 128, P0_I7 = 64 * 32, P0_I8 = 16 * 32;
constexpr int P0_NITEMS = P0_I1 + P0_I2 + P0_I3 + P0_I4 + P0_I5 + P0_I6 + P0_I7 + P0_I8;
__device__ __forceinline__ TrItem p0_item_decode(const Params& P, int it) {
    unsigned char* ws = P.ws; TrItem d; d.kscale = nullptr; int r = it;
    if (r < P0_I1) { const int kb = r / 280, g = r % 280, p0 = 32 * g; d.K = 1024; d.k0 = 64 * kb; d.dst_row0 = p0; d.WT = (bf16*)(ws + WS_W1T);
        if (p0 < 1536) { const int gi = g & 7; d.W = (const float*)P.in[I_WIN]; d.ldw = DIN; d.src_col0 = (p0 & ~255) + 32 * (2 * (gi & 3) + (gi >> 2)); }
        else if (p0 < 5376) { d.W = (const float*)P.in[I_WIN]; d.ldw = DIN; d.src_col0 = p0; }
        else if (p0 < 5888) { d.W = (const float*)P.in[I_WIN]; d.ldw = DIN; d.src_col0 = 5388 + (p0 - 5376); }
        else { d.W = (const float*)P.in[I_WGATE]; d.ldw = NGATE; d.src_col0 = p0 - 5888; }
        return d; } r -= P0_I1;
    if (r < P0_I2) { d.W = (const float*)P.in[I_WODIFF]; d.ldw = 1024; d.K = 768; d.src_col0 = d.dst_row0 = 32 * (r % 32); d.k0 = 64 * (r / 32); d.WT = (bf16*)(ws + WS_WOD); return d; } r -= P0_I2;
    if (r < P0_I3) { d.W = (const float*)P.in[I_WODELTA]; d.ldw = 1024; d.K = 768; d.src_col0 = d.dst_row0 = 32 * (r % 32); d.k0 = 64 * (r / 32); d.WT = (bf16*)(ws + WS_WODL); return d; } r -= P0_I3;
    if (r < P0_I4) { d.W = (const float*)P.in[I_WOCROSS]; d.ldw = 1024; d.K = 768;     d.src_col0 = d.dst_row0 = 32 * (r % 32); d.k0 = 64 * (r / 32); d.WT = (bf16*)(ws + WS_WOC); return d; } r -= P0_I4;
    if (r < P0_I5) { d.W = (const float*)P.in[I_WOUT]; d.ldw = 1024; d.K = 1024; d.src_col0 = d.dst_row0 = 32 * (r % 32); d.k0 = 64 * (r / 32); d.WT = (bf16*)(ws + WS_WOUT); return d; } r -= P0_I5;
    if (r < P0_I6) { d.W = (const float*)P.in[I_WMLP1]; d.ldw = DFF; d.K = 1024; d.src_col0 = d.dst_row0 = 32 * (r % 128); d.k0 = 64 * (r / 128); d.WT = (bf16*)(ws + WS_WM1); d.kscale = (const float*)P.in[I_LN2G]; return d; } r -= P0_I6;
    if (r < P0_I7) { d.W = (const float*)P.in[I_WMLP2]; d.ldw = 1024; d.K = DFF; d.src_col0 = d.dst_row0 = 32 * (r % 32); d.k0 = 64 * (r / 32); d.WT = (bf16*)(ws + WS_WM2); return d; } r -= P0_I7;
    d.W = (const float*)P.in[I_WMEMKV]; d.ldw = 1024; d.K = 1024; d.src_col0 = d.dst_row0 = 32 * (r % 32); d.k0 = 64 * (r / 32); d.WT = (bf16*)(ws + WS_WMEM); return d;
}

constexpr int P0_NEARLY = P0_I1 + P0_I8, P0_NLATE = P0_NITEMS - P0_NEARLY;
template <bool EARLY>
__device__ __forceinline__ void p0_items(const Params& P, unsigned char* lds, int lane, int wave, int gw, int NGW) {
    float* scr = (float*)(lds + wave * 8448);
    constexpr int N = EARLY ? P0_NEARLY : P0_NLATE;
#pragma unroll 1
    for (int e = gw; e < N; e += 3 * NGW) {
        const bool two = e + NGW < N, three = e + 2 * NGW < N;
        const int e1 = two ? e + NGW : e, e2 = three ? e + 2 * NGW : e;
        const int ia = EARLY ? (e < P0_I1 ? e : e + P0_NLATE) : P0_I1 + e, ib = EARLY ? (e1 < P0_I1 ? e1 : e1 + P0_NLATE) : P0_I1 + e1, ic = EARLY ? (e2 < P0_I1 ? e2 : e2 + P0_NLATE) : P0_I1 + e2;
        float va[32], vb[32], vc[32];
        const TrItem da = p0_item_decode(P, ia); p0_item_load(da, lane, va);
        const TrItem db = p0_item_decode(P, ib); if (two) p0_item_load(db, lane, vb);
        const TrItem dc = p0_item_decode(P, ic); if (three) p0_item_load(dc, lane, vc);
        p0_item_finish(da, lane, va, scr);
        if (two) p0_item_finish(db, lane, vb, scr);
        if (three) p0_item_finish(dc, lane, vc, scr);
    }
}
__device__ __forceinline__ void p0_prologue(const Params& P, unsigned char* lds, int tid, int lane, int wave) {
    const int G = gridDim.x, gw = blockIdx.x * NWAVES + wave, NGW = G * NWAVES;
    unsigned char* ws = P.ws;
    float* scr = (float*)(lds + wave * 8448);
    float* w12t = (float*)(lds + 73728);
    const float* w_in = (const float*)P.in[I_WIN];
    float w12r[24];
#pragma unroll
    for (int q = 0; q < 24; ++q) { const int i = tid + q * NTHR, c = i >> 10, k = i & 1023; w12r[q] = w_in[(size_t)k * DIN + 5376 + c]; }
    p0_items<true>(P, lds, lane, wave, gw, NGW);
#pragma unroll
    for (int q = 0; q < 24; ++q) w12t[tid + q * NTHR] = w12r[q];
    __syncthreads();
#ifdef PROBE_A
    if (blockIdx.x == 0 && tid == 0) ((unsigned long long*)(ws + WS_MISC + 32768))[11] = __builtin_amdgcn_s_memrealtime();
#endif
    {
        const float* x = (const float*)P.in[I_X]; const float* g1 = (const float*)P.in[I_LN1G];
        const float* alog = (const float*)P.in[I_ALOG]; const float* dtb = (const float*)P.in[I_DTB];
        bf16* HB = (bf16*)((unsigned char*)P.out + OUT_HB); float* BT = (float*)(ws + WS_BT); float* LA = (float*)(ws + WS_LA);
        f32x4 gv[4];
#pragma unroll
        for (int j = 0; j < 4; ++j) gv[j] = ((const f32x4*)g1)[lane + 64 * j];
        f32x4 vn[2][4];
#pragma unroll
        for (int r = 0; r < 2; ++r) if (gw + r * NGW < MTOK) {
#pragma unroll
            for (int j = 0; j < 4; ++j) vn[r][j] = __builtin_nontemporal_load((const f32x4*)(x + (size_t)(gw + r * NGW) * DM) + lane + 64 * j); }
#pragma unroll 1
        for (int m = gw; m < MTOK; m += 2 * NGW) {
            const bool has1 = m + NGW < MTOK;
            f32x4 v[2][4]; float pd[2][13];
#pragma unroll
            for (int r = 0; r < 2; ++r)
#pragma unroll
                for (int j = 0; j < 4; ++j) v[r][j] = vn[r][j];
#pragma unroll
            for (int r = 0; r < 2; ++r) if (m + (2 + r) * NGW < MTOK) {
#pragma unroll
                for (int j = 0; j < 4; ++j) vn[r][j] = __builtin_nontemporal_load((const f32x4*)(x + (size_t)(m + (2 + r) * NGW) * DM) + lane + 64 * j); }
#pragma unroll
            for (int r = 0; r < 2; ++r) { float s = 0.f;
#pragma unroll
                for (int j = 0; j < 4; ++j) { s += (v[r][j].x * v[r][j].x + v[r][j].y * v[r][j].y) + (v[r][j].z * v[r][j].z + v[r][j].w * v[r][j].w); v[r][j] = v[r][j] * gv[j]; }
                pd[r][12] = s; }
#pragma unroll
            for (int c = 0; c < 12; ++c) { float p0 = 0.f, p1 = 0.f;
#pragma unroll
                for (int j = 0; j < 4; ++j) { const f32x4 w = *(const f32x4*)(w12t + c * 1024 + 4 * lane + 256 * j);
                    p0 += (v[0][j].x * w.x + v[0][j].y * w.y) + (v[0][j].z * w.z + v[0][j].w * w.w); p1 += (v[1][j].x * w.x + v[1][j].y * w.y) + (v[1][j].z * w.z + v[1][j].w * w.w); }
                pd[0][c] = p0; pd[1][c] = p1; }
            float q8[2][8], q4[2][4], q2[2][2], q1[2];
#pragma unroll
            for (int i = 0; i < 8; ++i)
#pragma unroll
                for (int r = 0; r < 2; ++r) { const float lo = pd[r][i], hi = (i + 8 < 13) ? pd[r][i + 8] : 0.f; const bool up = (lane & 32) != 0; q8[r][i] = (up ? hi : lo) + __shfl_xor(up ? lo : hi, 32); }
#pragma unroll
            for (int i = 0; i < 4; ++i)
#pragma unroll
                for (int r = 0; r < 2; ++r) { const bool up = (lane & 16) != 0; q4[r][i] = (up ? q8[r][i + 4] : q8[r][i]) + __shfl_xor(up ? q8[r][i] : q8[r][i + 4], 16); }
#pragma unroll
            for (int i = 0; i < 2; ++i)
#pragma unroll
                for (int r = 0; r < 2; ++r) { const bool up = (lane & 8) != 0; q2[r][i] = (up ? q4[r][i + 2] : q4[r][i]) + __shfl_xor(up ? q4[r][i] : q4[r][i + 2], 8); }
#pragma unroll
            for (int r = 0; r < 2; ++r) { const bool up = (lane & 4) != 0; q1[r] = (up ? q2[r][1] : q2[r][0]) + __shfl_xor(up ? q2[r][0] : q2[r][1], 4); }
#pragma unroll
            for (int r = 0; r < 2; ++r) q1[r] += __shfl_xor(q1[r], 1);
#pragma unroll
            for (int r = 0; r < 2; ++r) q1[r] += __shfl_xor(q1[r], 2);
            const int slot = ((lane >> 5) & 1) * 8 + ((lane >> 4) & 1) * 4 + ((lane >> 3) & 1) * 2 + ((lane >> 2) & 1);
#pragma unroll
            for (int r = 0; r < 2; ++r) if (r == 0 || has1) { const int mr = m + r * NGW;
                const float rstd = 1.0f / sqrtf(__shfl(q1[r], 48) * (1.0f / DM) + EPS);
                unsigned long long* o8 = (unsigned long long*)(HB + (size_t)mr * DM) + lane;
#pragma unroll
                for (int j = 0; j < 4; ++j) { const f32x4 hv = v[r][j] * rstd; o8[64 * j] = (unsigned long long)pk2(hv.x, hv.y) | ((unsigned long long)pk2(hv.z, hv.w) << 32); }
                if ((lane & 3) == 0) { const float dot = q1[r] * rstd;
                    if (slot < 6) BT[(size_t)mr * 6 + slot] = 1.0f / (1.0f + expf(-dot));
                    else if (slot < 12) { const int hh = slot - 6; const float z = dot + dtb[hh]; const float sp = (z > 20.f) ? z : log1pf(expf(z)); LA[(size_t)mr * 6 + hh] = -expf(alog[hh]) * sp; }
                } }
        }
    }
    {
        const float* mem = (const float*)P.in[I_MEM]; const float* g = (const float*)P.in[I_MEMN]; bf16* MN = (bf16*)(ws + WS_MN);
        for (int m = gw; m < MEMROWS; m += NGW) {
            const f32x4* xr = (const f32x4*)(mem + (size_t)m * DM) + lane;
            f32x4 v[4]; float s = 0.f;
#pragma unroll
            for (int j = 0; j < 4; ++j) { v[j] = xr[64 * j]; s += (v[j].x * v[j].x + v[j].y * v[j].y) + (v[j].z * v[j].z + v[j].w * v[j].w); }
            const float rstd = 1.0f / sqrtf(wave_sum(s) * (1.0f / DM) + EPS);
            unsigned long long* o8 = (unsigned long long*)(MN + (size_t)m * DM) + lane;
#pragma unroll
            for (int j = 0; j < 4; ++j) { const f32x4 gg = ((const f32x4*)g)[lane + 64 * j]; const f32x4 y = (v[j] * rstd) * gg; o8[64 * j] = (unsigned long long)pk2(y.x, y.y) | ((unsigned long long)pk2(y.z, y.w) << 32); }
        }
    }
    {
        const int* pos = (const int*)P.in[I_POS]; float* RC = (float*)(ws + WS_ROPEC); float* RS = (float*)(ws + WS_ROPES); float* rowss = (float*)(ws + WS_ROWSS);
        const int gt = blockIdx.x * NTHR + tid, NGT = G * NTHR;
        for (int i = gt; i < MTOK * 32; i += NGT) { const int row = i >> 5, j = i & 31;
            const float inv = expf((-9.210340371976184f * (float)j) / 32.0f); const float ang = (float)pos[row] * inv;
            double rev = (double)ang * 0.15915494309189535; rev -= rint(rev); const float rf = (float)rev;
            RC[i] = __builtin_amdgcn_cosf(rf); RS[i] = __builtin_amdgcn_sinf(rf); }
        for (int i = gt; i < MTOK; i += NGT) rowss[i] = 0.f;
        if (blockIdx.x == 0 && wave == 0) {
            const float a = ((const float*)P.in[I_LQ1])[lane] * ((const float*)P.in[I_LK1])[lane], b = ((const float*)P.in[I_LQ2])[lane] * ((const float*)P.in[I_LK2])[lane];
            const float sa = wave_sum(a), sb = wave_sum(b);
            if (lane == 0) { ((float*)(ws + WS_MISC))[0] = expf(sa) - expf(sb) + LAM_INIT; ((int*)(ws + WS_MISC))[1] = 0; }
        }
    }
}

__device__ __forceinline__ void p2a_qknorm_rope(const Params& P, int lane, int wave) {
    const int gw = blockIdx.x * NWAVES + wave, NGW = gridDim.x * NWAVES;
    unsigned char* ws = P.ws; const float* RC = (const float*)(ws + WS_ROPEC); const float* RS = (const float*)(ws + WS_ROPES);
    const float* qg = (const float*)P.in[I_DAQN]; const float* kg = (const float*)P.in[I_DAKN];
    {
        const float* g = (const float*)P.in[I_CAKN];
        for (int it = gw; it < MEMROWS * 4; it += NGW) { unsigned* p = (unsigned*)((bf16*)(ws + WS_MKV) + (size_t)(it >> 2) * 1024 + (it & 3) * 128) + lane;
            const unsigned w = *p; float a = bflo(w), c = bfhi(w); const float ss = wave_sum(a * a + c * c); const float sc = 1.0f / sqrtf(ss * (1.0f / 128.0f) + EPS);
            *p = pk2(a * sc * g[2 * lane], c * sc * g[2 * lane + 1]); }
    }
}

typedef short bf16x8 __attribute__((ext_vector_type(8)));
typedef short s16x4 __attribute__((ext_vector_type(4)));
typedef float f32x16 __attribute__((ext_vector_type(16)));
#define MFMA32(a, b, c) __builtin_amdgcn_mfma_f32_32x32x16_bf16((a), (b), (c), 0, 0, 0)
__device__ __forceinline__ float max3f(float a, float b, float c) { float r; asm("v_max3_f32 %0, %1, %2, %3" : "=v"(r) : "v"(a), "v"(b), "v"(c)); return r; }
__device__ __forceinline__ unsigned cvtpk(float lo, float hi) { f32x2_t v = {lo, hi}; bf16x2_t b = __builtin_convertvector(v, bf16x2_t); return __builtin_bit_cast(unsigned, b); }
__device__ __forceinline__ unsigned off_b(unsigned row, unsigned ch) { return 256u * row + 16u * (ch ^ (((row & 3u) << 2) | ((row >> 2) & 3u))); }
__device__ __forceinline__ s16x4 vtr(const unsigned char* p) { typedef short v4i16_t __attribute__((ext_vector_type(4))); return __builtin_bit_cast(s16x4, __builtin_amdgcn_ds_read_tr16_b64_v4i16((LAS v4i16_t*)p)); }
__device__ __forceinline__ bf16x8 pack8f(const f32x16& x, int s2) { v4u w; w.x = cvtpk(x[8 * s2], x[8 * s2 + 1]); w.y = cvtpk(x[8 * s2 + 2], x[8 * s2 + 3]); w.z = cvtpk(x[8 * s2 + 4], x[8 * s2 + 5]); w.w = cvtpk(x[8 * s2 + 6], x[8 * s2 + 7]); return __builtin_bit_cast(bf16x8, w); }

__device__ __forceinline__ void mk_kx(int lane, unsigned (&kx)[8]) { const unsigned r = lane & 31, h5 = lane >> 5, X = ((r & 3u) << 2) | ((r >> 2) & 3u);
#pragma unroll
    for (int k = 0; k < 8; ++k) kx[k] = 256u * r + 16u * ((unsigned)(2 * k + h5) ^ X); }
__device__ __forceinline__ void mk_qkx(int lane, unsigned (&qkx)[4]) { const unsigned r = lane & 31, h5 = lane >> 5, ir = r >> 1, X2 = ((ir & 3u) << 2) | ((ir >> 2) & 3u);
#pragma unroll
    for (int k = 0; k < 4; ++k) qkx[k] = 256u * ir + 16u * ((unsigned)(8 * (r & 1) + 2 * k + h5) ^ X2); }
__device__ __forceinline__ void mk_vaddr(int lane, unsigned (&vaddr)[2][4]) { const unsigned h5 = lane >> 5, blk = (lane >> 4) & 1, q = (lane & 15) >> 2, p = lane & 3;
#pragma unroll
    for (int t = 0; t < 2; ++t)
#pragma unroll
        for (int db = 0; db < 4; ++db) vaddr[t][db] = 256u * (8 * t + 4 * h5 + q) + 16u * ((((unsigned)db ^ q) << 2) | ((2 * blk + (p >> 1)) ^ ((2 * t + h5) & 3u))) + 8u * (p & 1); }
template <bool CROSS>
__device__ __forceinline__ void attn_mfma_unit(const Params& P, unsigned char* lds, int tid_in, int b, int h, int qb) {
    int tid = mk_tid(tid_in); asm volatile("" : "+v"(tid)); const int lane = tid & 63, wave = __builtin_amdgcn_readfirstlane(tid >> 6);
    constexpr int NKS = CROSS ? 8 : 4;
    unsigned char* ws = P.ws;
    LAS unsigned char* lds3 = (LAS unsigned char*)lds;
    const int r = lane & 31, hh = lane >> 5;
    const int mp = CROSS ? 0 : (wave & 1), qsub = CROSS ? wave : (wave >> 1);
    const int nt = CROSS ? 4 : 2 * qb + 2;
    const int my_nt = (!CROSS && qsub < 2) ? nt - 1 : nt;
    const bf16* Kg; const bf16* Vg; bf16* Qg; int ldk, ldq;
    if (CROSS) { Kg = (const bf16*)(ws + WS_MKV) + (size_t)b * NMEM * 1024 + h * 128; Vg = Kg + 512; ldk = 1024; Qg = (bf16*)((unsigned char*)P.out + OUT_CAQ) + ((size_t)b * SEQ + (size_t)qb * 256) * 768 + h * 128; ldq = 768; }
    else { Kg = (const bf16*)(ws + WS_DAK) + (size_t)(b * 6 + h) * SEQ * 128; Vg = (const bf16*)(ws + WS_DAV) + (size_t)(b * 6 + h) * SEQ * 128; ldk = 128; Qg = (bf16*)(ws + WS_DAQ) + ((size_t)b * SEQ + (size_t)qb * 128) * 768 + h * 128; ldq = 768; }
    unsigned gsrc[2];
#pragma unroll
    for (int i = 0; i < 2; ++i) { const unsigned p = i * 512 + tid, row = p >> 4, ch = (p & 15u) ^ (((row & 3u) << 2) | ((row >> 2) & 3u)); gsrc[i] = (row * ldk + ch * 8) * 2; }
    const unsigned ldsw = (unsigned)wave * 1024u;
#define ATT_DMA(t_) do { const size_t go_ = (size_t)(t_) * 64 * ldk * 2; const unsigned sl_ = ((unsigned)(t_) & 3u) * 32768u; \
        _Pragma("unroll") for (int i_ = 0; i_ < 2; ++i_) { \
            __builtin_amdgcn_global_load_lds((const unsigned*)((const char*)Kg + go_ + gsrc[i_]), (LAS unsigned*)(lds3 + sl_ + i_ * 8192 + ldsw), 16, 0, 0); \
            __builtin_amdgcn_global_load_lds((const unsigned*)((const char*)Vg + go_ + gsrc[i_]), (LAS unsigned*)(lds3 + sl_ + 16384 + i_ * 8192 + ldsw), 16, 0, 0); } } while (0)
    __syncthreads();
    ATT_DMA(0); if (nt > 1) ATT_DMA(1);
    bf16x8 qf[NKS];
    {
        const bf16* qp = Qg + (size_t)(qsub * 32 + r) * ldq + mp * 64 + 8 * hh;
#pragma unroll
        for (int s = 0; s < NKS; ++s) qf[s] = *(const bf16x8*)(qp + 16 * s);
        if (CROSS) {
            float ss = 0.f;
#pragma unroll
            for (int s = 0; s < NKS; ++s)
#pragma unroll
                for (int j = 0; j < 8; ++j) { const float v = bf2f((bf16)qf[s][j]); ss += v * v; }
            ss += __shfl_xor(ss, 32);
            const float scl = C2_CA / sqrtf(ss * (1.0f / 128.0f) + EPS); const float* g = (const float*)P.in[I_CAQN] + 8 * hh;
#pragma unroll
            for (int s = 0; s < NKS; ++s) { v4u w;
                float t[8];
#pragma unroll
                for (int j = 0; j < 8; ++j) t[j] = bf2f((bf16)qf[s][j]) * scl * g[16 * s + j];
                w.x = cvtpk(t[0], t[1]); w.y = cvtpk(t[2], t[3]); w.z = cvtpk(t[4], t[5]); w.w = cvtpk(t[6], t[7]); qf[s] = __builtin_bit_cast(bf16x8, w); }
        }
#pragma unroll
        for (int s = 0; s < NKS; ++s) asm volatile("" : "+v"(qf[s]));
    }
    f32x16 ot[4];
#pragma unroll
    for (int db = 0; db < 4; ++db)
#pragma unroll
        for (int i = 0; i < 16; ++i) ot[db][i] = 0.f;
    float m_run = 0.f, l_run = 0.f;
    f32x16 negm;
#pragma unroll
    for (int i = 0; i < 16; ++i) negm[i] = 0.f;
    const unsigned lbase = (unsigned)(uintptr_t)lds;
    unsigned kaddr[NKS], vaddr[2][4];
    { const unsigned X = ((r & 3u) << 2) | ((r >> 2) & 3u);
#pragma unroll
      for (int s = 0; s < NKS; ++s) kaddr[s] = 256u * r + 16u * ((unsigned)(8 * mp + 2 * s + hh) ^ X);
      mk_vaddr(lane, vaddr); }
    bf16x8 pf[4];
#define ATT_H1(kt_) do { \
            const unsigned char* kb_ = lds + ((kt_) & 3) * 32768; \
            f32x16 st0 = negm, st1 = negm;                      \
            if (ATT_EXP == 1) { f32x16 d0 = negm, d1 = negm; _Pragma("unroll") for (int s = 0; s < NKS; ++s) { const bf16x8 a0 = *(const bf16x8*)(kb_ + kaddr[s]), a1 = *(const bf16x8*)(kb_ + 8192 + kaddr[s]); d0 = MFMA32(a0, qf[s], d0); d1 = MFMA32(a1, qf[s], d1); } asm volatile("" :: "v"(d0), "v"(d1)); } \
            _Pragma("unroll") for (int s = 0; s < NKS; ++s) { const bf16x8 a0 = *(const bf16x8*)(kb_ + kaddr[s]), a1 = *(const bf16x8*)(kb_ + 8192 + kaddr[s]); st0 = MFMA32(a0, qf[s], st0); st1 = MFMA32(a1, qf[s], st1); } \
            float tm = max3f(st0[0], st1[0], st0[1]); \
            _Pragma("unroll") for (int i = 1; i < 15; i += 2) { tm = max3f(tm, st1[i], st0[i + 1]); tm = max3f(tm, st1[i + 1], st0[i + 2]); } \
            tm = max3f(tm, st1[15], st0[15]); \
            tm = max3f(tm, __shfl_xor(tm, 32), tm); \
            if (__any(tm > 0.f)) {                              \
                const float dl = fmaxf(tm, 0.f), alpha = __builtin_amdgcn_exp2f(-dl); m_run += dl; l_run *= alpha; \
                _Pragma("unroll") for (int i = 0; i < 16; ++i) { st0[i] -= dl; st1[i] -= dl; negm[i] = -m_run; } \
                _Pragma("unroll") for (int db = 0; db < 4; ++db) _Pragma("unroll") for (int i = 0; i < 16; ++i) ot[db][i] *= alpha; } \
            float ps = 0.f; \
            _Pragma("unroll") for (int i = 0; i < 16; ++i) { st0[i] = __builtin_amdgcn_exp2f(st0[i]); st1[i] = __builtin_amdgcn_exp2f(st1[i]); ps += st0[i] + st1[i]; } \
            l_run += ps; \
            if (ATT_EXP == 2) { float dd = 0.f; _Pragma("unroll") for (int i = 0; i < 16; ++i) { float a_ = st0[i] * 1.5f, b_ = st1[i] * 1.5f; asm volatile("" : "+v"(a_), "+v"(b_)); dd += __builtin_amdgcn_exp2f(a_) + __builtin_amdgcn_exp2f(b_); } asm volatile("" :: "v"(dd)); } \
            pf[0] = pack8f(st0, 0); pf[1] = pack8f(st0, 1); pf[2] = pack8f(st1, 0); pf[3] = pack8f(st1, 1); } while (0)
#define TRR(dst, addr, off) asm volatile("ds_read_b64_tr_b16 %0, %1 offset:%c2" : "=&v"(dst) : "v"(addr), "i"(off) : "memory")
#define TRR8(tl, th, db_) do { const unsigned a0_ = vbase + vaddr[0][db_], a1_ = vbase + vaddr[1][db_]; \
                TRR(tl[0], a0_, 0); TRR(th[0], a1_, 0); TRR(tl[1], a0_, 4096); TRR(th[1], a1_, 4096); TRR(tl[2], a0_, 8192); TRR(th[2], a1_, 8192); TRR(tl[3], a0_, 12288); TRR(th[3], a1_, 12288); } while (0)
#define TRWAIT(n_, tl, th) do { asm volatile("s_waitcnt lgkmcnt(" #n_ ")" : "+v"(tl[0]), "+v"(th[0]), "+v"(tl[1]), "+v"(th[1]), "+v"(tl[2]), "+v"(th[2]), "+v"(tl[3]), "+v"(th[3]) :: "memory"); __builtin_amdgcn_sched_barrier(0); } while (0)
#define PVMM(tl, th, db_) do { __builtin_amdgcn_s_setprio(1); _Pragma("unroll") for (int ks = 0; ks < 4; ++ks) { const bf16x8 vf = __builtin_shufflevector(tl[ks], th[ks], 0, 1, 2, 3, 4, 5, 6, 7); ot[db_] = MFMA32(vf, pf[ks], ot[db_]); } __builtin_amdgcn_s_setprio(0); } while (0)
#define PVMM2(tl, th, acc_) do { _Pragma("unroll") for (int ks = 0; ks < 4; ++ks) { const bf16x8 vf = __builtin_shufflevector(tl[ks], th[ks], 0, 1, 2, 3, 4, 5, 6, 7); acc_ = MFMA32(vf, pf[ks], acc_); } } while (0)
#ifndef ATT_EXP
#define ATT_EXP 0
#endif
#define ATT_H2(kt_) do { \
            const unsigned vbase = lbase + ((kt_) & 3) * 32768 + 16384; \
            s16x4 tlA[4], thA[4], tlB[4], thB[4]; \
            TRR8(tlA, thA, 0); \
            TRR8(tlB, thB, 1); TRWAIT(8, tlA, thA); PVMM(tlA, thA, 0); \
            TRR8(tlA, thA, 2); TRWAIT(8, tlB, thB); PVMM(tlB, thB, 1); \
            TRR8(tlB, thB, 3); TRWAIT(8, tlA, thA); PVMM(tlA, thA, 2); \
            TRWAIT(0, tlB, thB); PVMM(tlB, thB, 3); \
            if (ATT_EXP == 3) { f32x16 dz; _Pragma("unroll") for (int i = 0; i < 16; ++i) dz[i] = 0.f; _Pragma("unroll") for (int rep = 0; rep < 4; ++rep) { PVMM2(tlA, thA, dz); } asm volatile("" :: "v"(dz)); } } while (0)
#ifndef ATT_STAGGER
#define ATT_STAGGER 0
#endif
    const bool late = ATT_STAGGER == 1 ? wave >= 4 : ATT_STAGGER == 2 ? (wave & 1) != 0 : ATT_STAGGER == 3 ? (wave & 2) != 0 : false;
#pragma unroll 1
    for (int kt = 0; kt < nt; ++kt) {
        if (kt + 1 < nt) asm volatile("s_waitcnt vmcnt(4)\n\ts_barrier" ::: "memory");
        else asm volatile("s_waitcnt vmcnt(0)\n\ts_barrier" ::: "memory");
        if (kt + 2 < nt) ATT_DMA(kt + 2);
        if (!late) { if (kt < my_nt) { ATT_H1(kt); ATT_H2(kt); } }
        else { if (kt >= 1 && kt - 1 < my_nt) ATT_H2(kt - 1); if (kt < my_nt) ATT_H1(kt); }
    }
    if (late && nt - 1 < my_nt) ATT_H2(nt - 1);
#undef ATT_H1
#undef ATT_H2
#undef TRR
#undef TRR8
#undef TRWAIT
#undef PVMM
#undef ATT_DMA
    __syncthreads();
    l_run += __shfl_xor(l_run, 32);
    const float rl = 1.0f / l_run;
    bf16* Og = Qg + (size_t)(qsub * 32 + r) * ldq;
    if (CROSS) {
#pragma unroll
        for (int db = 0; db < 4; ++db)
#pragma unroll
            for (int g = 0; g < 4; ++g) { v2u w; w.x = cvtpk(ot[db][4 * g] * rl, ot[db][4 * g + 1] * rl); w.y = cvtpk(ot[db][4 * g + 2] * rl, ot[db][4 * g + 3] * rl);
                *(v2u*)(Og + 32 * db + 8 * g + 4 * hh) = w; }
    } else {
        float* xch = (float*)lds + (wave >> 1) * 4096;
        const float lam = ((const float*)(ws + WS_MISC))[0];
        if (mp == 1) {
            const float f = rl * lam;
#pragma unroll
            for (int db = 0; db < 4; ++db)
#pragma unroll
                for (int i = 0; i < 16; ++i) xch[(db * 16 + i) * 64 + lane] = ot[db][i] * f;
        }
        __syncthreads();
        if (mp == 0) {
            float ss = 0.f;
#pragma unroll
            for (int db = 0; db < 4; ++db)
#pragma unroll
                for (int i = 0; i < 16; ++i) { const float v = ot[db][i] * rl - xch[(db * 16 + i) * 64 + lane]; ot[db][i] = v; ss += v * v; }
            ss += __shfl_xor(ss, 32);
            const float scl = (1.0f - LAM_INIT) / sqrtf(ss * (1.0f / 128.0f) + EPS); const float* gp = (const float*)P.in[I_SUBLN] + 4 * hh;
#pragma unroll
            for (int db = 0; db < 4; ++db)
#pragma unroll
                for (int g = 0; g < 4; ++g) { const f32x4 gg = *(const f32x4*)(gp + 32 * db + 8 * g);
                    v2u w; w.x = cvtpk(ot[db][4 * g] * scl * gg.x, ot[db][4 * g + 1] * scl * gg.y); w.y = cvtpk(ot[db][4 * g + 2] * scl * gg.z, ot[db][4 * g + 3] * scl * gg.w);
                    *(v2u*)(Og + 32 * db + 8 * g + 4 * hh) = w; }
        }
    }
}

#ifndef PIPE_PIN
#define PIPE_PIN 0
#endif
#ifndef PIPE_XBAR
#define PIPE_XBAR 0
#endif
__device__ __forceinline__ void attn_pipe_unit(const Params& P, unsigned char* lds, int wave_s, int b, int h, int qb) {
    int tid = mk_tid(wave_s); asm volatile("" : "+v"(tid)); const int lane = tid & 63, wave = __builtin_amdgcn_readfirstlane(tid >> 6);
    unsigned char* ws = P.ws;
    LAS unsigned char* lds3 = (LAS unsigned char*)lds;
    const int r = lane & 31, hh = lane >> 5;
    const int mp = wave & 1, qsub = wave >> 1;
    const int nt = 2 * qb + 2, my_nt = (qsub < 2) ? nt - 1 : nt;
    const bf16* Kg = (const bf16*)(ws + WS_DAK) + (size_t)(b * 6 + h) * SEQ * 128; const bf16* Vg = (const bf16*)(ws + WS_DAV) + (size_t)(b * 6 + h) * SEQ * 128;
    bf16* Qg = (bf16*)(ws + WS_DAQ) + ((size_t)b * SEQ + (size_t)qb * 128) * 768 + h * 128;
    unsigned gsrc[2];
#pragma unroll
    for (int i = 0; i < 2; ++i) { const unsigned p = i * 512 + tid, row = p >> 4, ch = (p & 15u) ^ (((row & 3u) << 2) | ((row >> 2) & 3u)); gsrc[i] = (row * 128 + ch * 8) * 2; }
    const unsigned ldsw = (unsigned)wave * 1024u;
#define ATT_DMA(t_) do { const size_t go_ = (size_t)(t_) * 64 * 128 * 2; const unsigned sl_ = ((unsigned)(t_) & 3u) * 32768u; \
        _Pragma("unroll") for (int i_ = 0; i_ < 2; ++i_) { \
            __builtin_amdgcn_global_load_lds((const unsigned*)((const char*)Kg + go_ + gsrc[i_]), (LAS unsigned*)(lds3 + sl_ + i_ * 8192 + ldsw), 16, 0, 0); \
            __builtin_amdgcn_global_load_lds((const unsigned*)((const char*)Vg + go_ + gsrc[i_]), (LAS unsigned*)(lds3 + sl_ + 16384 + i_ * 8192 + ldsw), 16, 0, 0); } } while (0)
#define ATT_DMA1(t_, w_) do { const size_t go_ = (size_t)(t_) * 64 * 128 * 2; const unsigned sl_ = ((unsigned)(t_) & 3u) * 32768u; \
        if ((w_) < 2) __builtin_amdgcn_global_load_lds((const unsigned*)((const char*)Kg + go_ + gsrc[(w_) & 1]), (LAS unsigned*)(lds3 + sl_ + ((w_) & 1) * 8192 + ldsw), 16, 0, 0); \
        else __builtin_amdgcn_global_load_lds((const unsigned*)((const char*)Vg + go_ + gsrc[(w_) & 1]), (LAS unsigned*)(lds3 + sl_ + 16384 + ((w_) & 1) * 8192 + ldsw), 16, 0, 0); } while (0)
    __syncthreads();
    ATT_DMA(0); ATT_DMA(1); if (nt > 2) ATT_DMA(2);
    bf16x8 qf[4];
    { const bf16* qp = Qg + (size_t)(qsub * 32 + r) * 768 + mp * 64 + 8 * hh;
#pragma unroll
      for (int s = 0; s < 4; ++s) qf[s] = *(const bf16x8*)(qp + 16 * s);
#pragma unroll
      for (int s = 0; s < 4; ++s) asm volatile("" : "+v"(qf[s])); }
    f32x16 ot[4];
#pragma unroll
    for (int db = 0; db < 4; ++db)
#pragma unroll
        for (int i = 0; i < 16; ++i) ot[db][i] = 0.f;
    float m_run = 0.f, l_run = 0.f;
    const unsigned lbase = (unsigned)(uintptr_t)lds;
    unsigned kaddr[4], vaddr[2][4];
    { const unsigned X = ((r & 3u) << 2) | ((r >> 2) & 3u);
#pragma unroll
      for (int s = 0; s < 4; ++s) kaddr[s] = 256u * r + 16u * ((unsigned)(8 * mp + 2 * s + hh) ^ X);
      mk_vaddr(lane, vaddr); }
#define PIPE_S(t_, sA_, sB_, dl_, alpha_, grow_) do { \
        const unsigned char* kb_ = lds + ((t_) & 3) * 32768; { const float nm_ = -m_run; _Pragma("unroll") for (int i = 0; i < 16; ++i) { sA_[i] = nm_; sB_[i] = nm_; } } \
        __builtin_amdgcn_s_setprio(1); \
        { bf16x8 kf_[8]; _Pragma("unroll") for (int s = 0; s < 4; ++s) { kf_[2 * s] = *(const bf16x8*)(kb_ + kaddr[s]); kf_[2 * s + 1] = *(const bf16x8*)(kb_ + 8192 + kaddr[s]); } \
          asm volatile("" ::: "memory");     \
          _Pragma("unroll") for (int s = 0; s < 4; ++s) { sA_ = MFMA32(kf_[2 * s], qf[s], sA_); sB_ = MFMA32(kf_[2 * s + 1], qf[s], sB_); } } \
        __builtin_amdgcn_s_setprio(0); \
        float tm = max3f(sA_[0], sA_[1], sA_[2]), tn = max3f(sB_[0], sB_[1], sB_[2]); \
        _Pragma("unroll") for (int i = 3; i < 15; i += 2) { tm = max3f(tm, sA_[i], sA_[i + 1]); tn = max3f(tn, sB_[i], sB_[i + 1]); } \
        tm = max3f(tm, sA_[15], tn); tm = max3f(tm, sB_[15], tm); tm = max3f(tm, __shfl_xor(tm, 32), tm); \
        grow_ = __any(tm > 0.f) != 0; dl_ = 0.f; alpha_ = 1.f; \
        if (grow_) { dl_ = fmaxf(tm, 0.f); alpha_ = __builtin_amdgcn_exp2f(-dl_); \
            _Pragma("unroll") for (int i = 0; i < 16; ++i) { sA_[i] -= dl_; sB_[i] -= dl_; } } } while (0)
#define PIPE_FILL(p_, sA_, sB_, PN_) do { { \
        float e0, e1; if ((p_) < 8) { e0 = __builtin_amdgcn_exp2f(sA_[2 * ((p_) & 7)]); e1 = __builtin_amdgcn_exp2f(sA_[2 * ((p_) & 7) + 1]); } else { e0 = __builtin_amdgcn_exp2f(sB_[2 * ((p_) & 7)]); e1 = __builtin_amdgcn_exp2f(sB_[2 * ((p_) & 7) + 1]); } \
        psn += e0 + e1; PN_[(p_) >> 2][(p_) & 3] = cvtpk(e0, e1); } } while (0)
#define TRR(dst, addr, off) asm volatile("ds_read_b64_tr_b16 %0, %1 offset:%c2" : "=&v"(dst) : "v"(addr), "i"(off) : "memory")
#define TRR8(tl, th, db_) do { const unsigned a0_ = vbase + vaddr[0][db_], a1_ = vbase + vaddr[1][db_]; \
                TRR(tl[0], a0_, 0); TRR(th[0], a1_, 0); TRR(tl[1], a0_, 4096); TRR(th[1], a1_, 4096); TRR(tl[2], a0_, 8192); TRR(th[2], a1_, 8192); TRR(tl[3], a0_, 12288); TRR(th[3], a1_, 12288); } while (0)
#define TRWAIT(n_, tl, th) do { asm volatile("s_waitcnt lgkmcnt(" #n_ ")" : "+v"(tl[0]), "+v"(th[0]), "+v"(tl[1]), "+v"(th[1]), "+v"(tl[2]), "+v"(th[2]), "+v"(tl[3]), "+v"(th[3]) :: "memory"); __builtin_amdgcn_sched_barrier(0); } while (0)
#define PIPE_PV4(FILL_, tl, th, db_, PC_, sA_, sB_, PN_) do { _Pragma("unroll") for (int ks = 0; ks < 4; ++ks) { const bf16x8 vf = __builtin_shufflevector(tl[ks], th[ks], 0, 1, 2, 3, 4, 5, 6, 7); \
            ot[db_] = MFMA32(vf, __builtin_bit_cast(bf16x8, PC_[ks]), ot[db_]); if (FILL_) PIPE_FILL(4 * (db_) + ks, sA_, sB_, PN_); if (PIPE_PIN) __builtin_amdgcn_sched_barrier(0); } } while (0)
#define PIPE_STEP(kt_, PC_, PN_) do { \
        if ((kt_) + 2 < nt) { if (PIPE_XBAR == 2) asm volatile("s_waitcnt vmcnt(8)\n\ts_barrier" ::: "memory"); else asm volatile("s_waitcnt vmcnt(4)\n\ts_barrier" ::: "memory"); } else asm volatile("s_waitcnt vmcnt(0)\n\ts_barrier" ::: "memory");     \
        if (PIPE_XBAR == 1) asm volatile("s_barrier" ::: "memory"); \
        if ((kt_) >= my_nt) { if ((kt_) + 3 < nt) ATT_DMA((kt_) + 3); } \
        if ((kt_) < my_nt) { \
            const bool fill = (kt_) + 1 < my_nt; f32x16 sA, sB; float dl = 0.f, alpha = 1.f, psn = 0.f; bool grow = false; \
            if (fill) PIPE_S((kt_) + 1, sA, sB, dl, alpha, grow); \
            const bool dma_ = (kt_) + 3 < nt;                                 \
            const unsigned vbase = lbase + ((kt_) & 3) * 32768 + 16384; \
            s16x4 tlA[4], thA[4], tlB[4], thB[4]; \
            TRR8(tlA, thA, 0); \
            TRR8(tlB, thB, 1); TRWAIT(8, tlA, thA); PIPE_PV4(fill, tlA, thA, 0, PC_, sA, sB, PN_); if (dma_) ATT_DMA1((kt_) + 3, 0); \
            TRR8(tlA, thA, 2); TRWAIT(8, tlB, thB); PIPE_PV4(fill, tlB, thB, 1, PC_, sA, sB, PN_); if (dma_) ATT_DMA1((kt_) + 3, 1); \
            TRR8(tlB, thB, 3); TRWAIT(8, tlA, thA); PIPE_PV4(fill, tlA, thA, 2, PC_, sA, sB, PN_); if (dma_) ATT_DMA1((kt_) + 3, 2); \
            TRWAIT(0, tlB, thB); PIPE_PV4(fill, tlB, thB, 3, PC_, sA, sB, PN_); if (dma_) ATT_DMA1((kt_) + 3, 3); \
            if (grow) { m_run += dl; l_run *= alpha; \
                _Pragma("unroll") for (int db = 0; db < 4; ++db) _Pragma("unroll") for (int i = 0; i < 16; ++i) ot[db][i] *= alpha; } \
            l_run += psn; } } while (0)
    v4u pfa[4], pfb[4];
    {
        asm volatile("s_waitcnt vmcnt(0)\n\ts_barrier" ::: "memory");
        f32x16 sA, sB; float dl, alpha; bool grow; PIPE_S(0, sA, sB, dl, alpha, grow);
        float ps = 0.f;
#pragma unroll
        for (int i = 0; i < 16; ++i) { sA[i] = __builtin_amdgcn_exp2f(sA[i]); sB[i] = __builtin_amdgcn_exp2f(sB[i]); ps += sA[i] + sB[i]; }
        m_run = dl; l_run = ps;
        pfa[0] = __builtin_bit_cast(v4u, pack8f(sA, 0)); pfa[1] = __builtin_bit_cast(v4u, pack8f(sA, 1)); pfa[2] = __builtin_bit_cast(v4u, pack8f(sB, 0)); pfa[3] = __builtin_bit_cast(v4u, pack8f(sB, 1));
    }
#pragma unroll 1
    for (int kt = 0; kt < nt; kt += 2) { PIPE_STEP(kt, pfa, pfb); PIPE_STEP(kt + 1, pfb, pfa); }
#undef ATT_DMA
#undef ATT_DMA1
#undef PIPE_S
#undef PIPE_FILL
#undef PIPE_PV4
#undef PIPE_STEP
#undef TRR
#undef TRR8
#undef TRWAIT
    __syncthreads();
    l_run += __shfl_xor(l_run, 32);
    const float rl = 1.0f / l_run;
    int l9 = lane; asm volatile("" : "+v"(l9));
    bf16* Og = (bf16*)(ws + WS_DAQ) + ((size_t)b * SEQ + (size_t)qb * 128 + qsub * 32 + (l9 & 31)) * 768 + h * 128;
    {
        float* xch = (float*)lds + (wave >> 1) * 4096;
        const float lam = ((const float*)(ws + WS_MISC))[0];
        if (mp == 1) {
            const float f = rl * lam;
#pragma unroll
            for (int db = 0; db < 4; ++db)
#pragma unroll
                for (int i = 0; i < 16; ++i) xch[(db * 16 + i) * 64 + lane] = ot[db][i] * f;
        }
        __syncthreads();
        if (mp == 0) {
            float ss = 0.f;
#pragma unroll
            for (int db = 0; db < 4; ++db)
#pragma unroll
                for (int i = 0; i < 16; ++i) { const float v = ot[db][i] * rl - xch[(db * 16 + i) * 64 + lane]; ot[db][i] = v; ss += v * v; }
            ss += __shfl_xor(ss, 32);
            const float scl = (1.0f - LAM_INIT) / sqrtf(ss * (1.0f / 128.0f) + EPS); const float* gp = (const float*)P.in[I_SUBLN] + 4 * hh;
#pragma unroll
            for (int db = 0; db < 4; ++db)
#pragma unroll
                for (int g = 0; g < 4; ++g) { const f32x4 gg = *(const f32x4*)(gp + 32 * db + 8 * g);
                    v2u w; w.x = cvtpk(ot[db][4 * g] * scl * gg.x, ot[db][4 * g + 1] * scl * gg.y); w.y = cvtpk(ot[db][4 * g + 2] * scl * gg.z, ot[db][4 * g + 3] * scl * gg.w);
                    *(v2u*)(Og + 32 * db + 8 * g + 4 * (l9 >> 5)) = w; }
        }
    }
}

constexpr size_t OUT_NW = 0, OUT_QKM = 48 * MiB;
__device__ __forceinline__ int kperm16(int d) { return (d & ~12) | ((d & 4) << 1) | ((d & 8) >> 1); }
constexpr int I_RAW2A = 66560, I_RAW2B = 123392;
template <int NT>
__device__ __forceinline__ void gdn_intra_fetch(const Params& P, unsigned char* lds, int t, int u) {
    unsigned char* ws = P.ws; const int n = u & 127, bh = u >> 7, b = bh / 6, hh = bh - 6 * b;
    const size_t row0 = (size_t)b * SEQ + n * 64; const int gci = b * (SEQ / 64) + n;
    constexpr int K = (67 * 48 + NT - 1) / NT;
    v4u v[K];
#pragma unroll
    for (int k = 0; k < K; ++k) { const int it = t + k * NT; const int i = it / 48, ch = it - i * 48, sec = ch >> 4, c16 = ch & 15; v[k] = (v4u){0u, 0u, 0u, 0u};
        if (it < 67 * 48) {
            if (i >= 3) v[k] = *(const v4u*)((const bf16*)(ws + WS_GQ + (size_t)sec * WS_SEC) + (row0 + i - 3) * 768 + hh * 128 + c16 * 8);
            else if (n > 0) v[k] = *(const v4u*)((const bf16*)(ws + WS_HALO) + ((size_t)(gci - 1) * 3 + i) * 2304 + sec * 768 + hh * 128 + c16 * 8); } }
#pragma unroll
    for (int k = 0; k < K; ++k) { const int it = t + k * NT;
        if (it < 67 * 48) *(v4u*)(lds + (it < 2048 ? I_RAW2A + it * 16 : I_RAW2B + (it - 2048) * 16)) = v[k]; }
}
template <int N> __device__ __forceinline__ void fmac_bc(float& d, float a, float x) { asm("v_fmac_f32_dpp %0, -%1, %2 row_newbcast:%3 row_mask:0xf bank_mask:0xf" : "+v"(d) : "v"(a), "v"(x), "n"(N)); }
template <int J, int I> __device__ __forceinline__ void solve_row(float (&x)[64], const float (&va)[4]) {
    if constexpr (I < 64) { fmac_bc<(I & 15)>(x[I], va[I >> 4], x[J]); solve_row<J, I + 1>(x, va); }
}
template <int J> __device__ __forceinline__ void solve_steps(float (&x)[64], float (&va)[4], float (&vb)[4], const float* AMl) {
    if constexpr (J < 63) {
        if constexpr (J + 1 < 63) {
#pragma unroll
            for (int g = (J + 2) >> 4; g < 4; ++g) vb[g] = AMl[(J + 1) * 68 + 16 * g];
        }
        solve_row<J, J + 1>(x, va);
        solve_steps<J + 1>(x, vb, va, AMl);
    }
}
__device__ __forceinline__ void gdn_intra_block(const Params& P, unsigned char* lds, int tid_in, int u_begin_, int u_end_) {
    const int u_begin = __builtin_amdgcn_readfirstlane(u_begin_), u_end = __builtin_amdgcn_readfirstlane(u_end_);
    if (u_begin >= u_end) return;
    float* GB2 = (float*)(lds + 142080);
    __syncthreads();
    { int t0_ = mk_tid(tid_in); asm volatile("" : "+v"(t0_)); gdn_intra_fetch<NTHR>(P, lds, t0_, u_begin);
      if ((t0_ >> 6) == 7) { const int n = u_begin & 127, bh = u_begin >> 7, b = bh / 6, hh = bh - 6 * b; const size_t r_ = ((size_t)b * SEQ + n * 64 + (t0_ & 63)) * 6 + hh;
          GB2[t0_ & 63] = ((const float*)(P.ws + WS_LA))[r_]; GB2[64 + (t0_ & 63)] = ((const float*)(P.ws + WS_BT))[r_]; } }
  int wc_hh = -1;
#pragma unroll 1
  for (int u = u_begin; u < u_end; ++u) {
    int tid = mk_tid(tid_in); asm volatile("" : "+v"(tid)); const int lane = tid & 63, wave = __builtin_amdgcn_readfirstlane(tid >> 6);
    const int n = u & 127, bh = u >> 7, b = bh / 6, hh = bh - 6 * b;
    unsigned char* ws = P.ws; unsigned char* outb = (unsigned char*)P.out; asm volatile("" : "+v"(ws), "+v"(outb));
    bf16* RAW = (bf16*)lds;
    float* RHS = (float*)lds;
    unsigned char* QS = lds + 66560;
    unsigned char* KS = lds + 82944;
    float* AM = (float*)(lds + 99328);
    float* WC = (float*)(lds + 116736);
    float* GB = (float*)(lds + 122880);
    const int t0 = n * 64; const size_t row0 = (size_t)b * SEQ + t0; const int gci = b * (SEQ / 64) + n;
    float* LA = (float*)(ws + WS_LA);
    __syncthreads();
#ifdef PROBE_A
    if (blockIdx.x == 0 && tid == 0 && u == u_begin + 2) ((unsigned long long*)(ws + WS_MISC + 32768))[20] = __builtin_amdgcn_s_memrealtime();
#endif
#pragma unroll
    for (int k = 0; k < 7; ++k) { const int it = tid + k * NTHR;
        if (it < 67 * 48) { const int i = it / 48, ch = it - i * 48; *(v4u*)(lds + i * 784 + ch * 16) = *(const v4u*)(lds + (it < 2048 ? I_RAW2A + it * 16 : I_RAW2B + (it - 2048) * 16)); } }
    if (hh != wc_hh) { wc_hh = hh;
#pragma unroll
        for (int k = 0; k < 3; ++k) { const int i = tid + k * NTHR, tap = i / 384, c = i - tap * 384; WC[i] = ((const float*)P.in[I_WCONV])[tap * 2304 + (c >> 7) * 768 + hh * 128 + (c & 127)]; } }
    if (wave == 7) { float g = GB2[lane]; const float pbt = GB2[64 + lane];
#pragma unroll
        for (int o = 1; o < 64; o <<= 1) { const float t = __shfl_up(g, o); if (lane >= o) g += t; }
        GB[lane] = g; GB[64 + lane] = pbt; LA[(row0 + lane) * 6 + hh] = g;
        if (lane == 63) ((float*)(ws + WS_MISC))[64 + gci * 6 + hh] = __expf(g); }
    __syncthreads();
#ifdef PROBE_A
    if (blockIdx.x == 0 && tid == 0 && u == u_begin + 2) ((unsigned long long*)(ws + WS_MISC + 32768))[21] = __builtin_amdgcn_s_memrealtime();
#endif
    int tid2 = tid; asm volatile("" : "+v"(tid2)); const int tk = tid2 >> 3, c8 = tid2 & 7;
    float xq[16], xk[16], xv[16];
    {
#pragma unroll
        for (int sec = 0; sec < 3; ++sec) { float acc[16];
#pragma unroll
            for (int i = 0; i < 16; ++i) acc[i] = 0.f;
#pragma unroll
            for (int tap = 0; tap < 4; ++tap) { const bf16* rp = RAW + (tk + tap) * 392 + sec * 128 + c8 * 16; const float* wp = WC + tap * 384 + sec * 128 + c8 * 16;
                const v4u a = *(const v4u*)rp, c = *(const v4u*)(rp + 8);
                const float xr[16] = { bflo(a.x), bfhi(a.x), bflo(a.y), bfhi(a.y), bflo(a.z), bfhi(a.z), bflo(a.w), bfhi(a.w), bflo(c.x), bfhi(c.x), bflo(c.y), bfhi(c.y), bflo(c.z), bfhi(c.z), bflo(c.w), bfhi(c.w) };
#pragma unroll
                for (int i = 0; i < 16; ++i) acc[i] += wp[i] * xr[i]; }
#pragma unroll
            for (int i = 0; i < 16; ++i) { const float y = siluf(acc[i]); if (sec == 0) xq[i] = y; else if (sec == 1) xk[i] = y; else xv[i] = y; } }
        float sq = 0.f, sk = 0.f;
#pragma unroll
        for (int i = 0; i < 16; ++i) { sq += xq[i] * xq[i]; sk += xk[i] * xk[i]; }
        sq += __shfl_xor(sq, 1); sq += __shfl_xor(sq, 2); sq += __shfl_xor(sq, 4); sk += __shfl_xor(sk, 1); sk += __shfl_xor(sk, 2); sk += __shfl_xor(sk, 4);
        const float scq = 0.08838834764831845f / sqrtf(sq + EPS), sck = 1.0f / sqrtf(sk + EPS);
#pragma unroll
        for (int i = 0; i < 16; ++i) { xq[i] *= scq; xk[i] *= sck; }
    }
    const float g_c = GB[tk], g_l = GB[63], bt_c = GB[64 + tk];
    const float eg = __expf(g_c), ekd = __expf(g_l - g_c);
    {
        v4u w0, w1;
        w0.x = pk2(xq[0], xq[1]); w0.y = pk2(xq[2], xq[3]); w0.z = pk2(xq[4], xq[5]); w0.w = pk2(xq[6], xq[7]); w1.x = pk2(xq[8], xq[9]); w1.y = pk2(xq[10], xq[11]); w1.z = pk2(xq[12], xq[13]); w1.w = pk2(xq[14], xq[15]);
        *(v4u*)(QS + off_b(tk, 2 * c8)) = w0; *(v4u*)(QS + off_b(tk, 2 * c8 + 1)) = w1;
        w0.x = pk2(xk[0], xk[1]); w0.y = pk2(xk[2], xk[3]); w0.z = pk2(xk[4], xk[5]); w0.w = pk2(xk[6], xk[7]); w1.x = pk2(xk[8], xk[9]); w1.y = pk2(xk[10], xk[11]); w1.z = pk2(xk[12], xk[13]); w1.w = pk2(xk[14], xk[15]);
        *(v4u*)(KS + off_b(tk, 2 * c8)) = w0; *(v4u*)(KS + off_b(tk, 2 * c8 + 1)) = w1;
        bf16* gq = (bf16*)(ws + WS_GQ) + (row0 + tk) * 768 + hh * 128 + c8 * 16; bf16* gk = (bf16*)(ws + WS_GK) + (row0 + tk) * 768 + hh * 128 + c8 * 16;
        w0.x = pk2(xq[0] * eg, xq[1] * eg); w0.y = pk2(xq[2] * eg, xq[3] * eg); w0.z = pk2(xq[8] * eg, xq[9] * eg); w0.w = pk2(xq[10] * eg, xq[11] * eg);
        w1.x = pk2(xq[4] * eg, xq[5] * eg); w1.y = pk2(xq[6] * eg, xq[7] * eg); w1.z = pk2(xq[12] * eg, xq[13] * eg); w1.w = pk2(xq[14] * eg, xq[15] * eg);
        *(v4u*)gq = w0; *(v4u*)(gq + 8) = w1;
        w0.x = pk2(xk[0] * ekd, xk[1] * ekd); w0.y = pk2(xk[2] * ekd, xk[3] * ekd); w0.z = pk2(xk[4] * ekd, xk[5] * ekd); w0.w = pk2(xk[6] * ekd, xk[7] * ekd);
        w1.x = pk2(xk[8] * ekd, xk[9] * ekd); w1.y = pk2(xk[10] * ekd, xk[11] * ekd); w1.z = pk2(xk[12] * ekd, xk[13] * ekd); w1.w = pk2(xk[14] * ekd, xk[15] * ekd);
        *(v4u*)gk = w0; *(v4u*)(gk + 8) = w1;
    }
    __syncthreads();
#ifdef PROBE_A
    if (blockIdx.x == 0 && tid == 0 && u == u_begin + 2) ((unsigned long long*)(ws + WS_MISC + 32768))[22] = __builtin_amdgcn_s_memrealtime();
#endif
    {
        float* rp = RHS + tk * 260 + c8 * 16; const float kb = bt_c * eg;
#pragma unroll
        for (int i = 0; i < 16; i += 4) { *(f32x4*)(rp + i) = (f32x4){xv[i] * bt_c, xv[i + 1] * bt_c, xv[i + 2] * bt_c, xv[i + 3] * bt_c};
            *(f32x4*)(rp + 128 + i) = (f32x4){xk[i] * kb, xk[i + 1] * kb, xk[i + 2] * kb, xk[i + 3] * kb}; }
    }
#ifdef PROBE_A
    if (blockIdx.x == 0 && tid == 0 && u == u_begin + 2) ((unsigned long long*)(ws + WS_MISC + 32768))[23] = __builtin_amdgcn_s_memrealtime();
#endif
    {
        const int which = wave >> 2, ti = (wave >> 1) & 1, tj = wave & 1, r = lane & 31, h5 = lane >> 5;
        f32x16 acc;
#pragma unroll
        for (int i = 0; i < 16; ++i) acc[i] = 0.f;
        if (ti >= tj) {
            const unsigned char* Ab = (which ? QS : KS) + 8192 * ti; const unsigned char* Bb = KS + 8192 * tj;
            const unsigned X = ((r & 3u) << 2) | ((r >> 2) & 3u);
#pragma unroll
            for (int s = 0; s < 8; ++s) { const unsigned o = 256u * r + 16u * ((unsigned)(2 * s + h5) ^ X); acc = MFMA32(*(const bf16x8*)(Ab + o), *(const bf16x8*)(Bb + o), acc); }
        }
        const int j = 32 * tj + r; const float g_j = GB[j];
        if (which == 0) {
            if (ti >= tj) {
#pragma unroll
                for (int i = 0; i < 16; ++i) { const int c = 32 * ti + (i & 3) + 8 * (i >> 2) + 4 * h5; AM[j * 68 + c] = (c > j) ? GB[64 + c] * acc[i] * __expf(GB[c] - g_j) : 0.f; }
            }
        } else {
            bf16* qkm = (bf16*)(outb + OUT_QKM) + ((size_t)gci * 6 + hh) * 4096; const int jp = (j & ~15) | kperm16(j & 15);
#pragma unroll
            for (int i = 0; i < 16; ++i) { const int c = 32 * ti + (i & 3) + 8 * (i >> 2) + 4 * h5; const float v = (c >= j) ? acc[i] * __expf(GB[c] - g_j) : 0.f; qkm[c * 64 + jp] = (bf16)f2bf(v); }
        }
    }
    __syncthreads();
#ifdef PROBE_A
    if (blockIdx.x == 0 && tid == 0 && u == u_begin + 2) ((unsigned long long*)(ws + WS_MISC + 32768))[24] = __builtin_amdgcn_s_memrealtime();
#endif
    if (wave >= 4) {
        if (u + 1 < u_end) { gdn_intra_fetch<256>(P, lds, tid - 256, u + 1);
            if (wave == 7) { const int n1 = (u + 1) & 127, bh1 = (u + 1) >> 7, b1 = bh1 / 6, hh1 = bh1 - 6 * b1; const size_t r_ = ((size_t)b1 * SEQ + n1 * 64 + lane) * 6 + hh1;
                GB2[lane] = ((const float*)(ws + WS_LA))[r_]; GB2[64 + lane] = ((const float*)(ws + WS_BT))[r_]; } }
    } else {
        int tid4 = tid; asm volatile("" : "+v"(tid4)); const int lane = tid4 & 63;
        const int col = 64 * wave + lane;
        const float* AMl = AM + (lane & 15);
        float x[64];
#pragma unroll
        for (int i = 0; i < 64; ++i) x[i] = RHS[i * 260 + col];
        float va[4], vb[4];
#pragma unroll
        for (int g = 0; g < 4; ++g) va[g] = AMl[16 * g];
        solve_steps<0>(x, va, vb, AMl);
        int l5 = lane; asm volatile("" : "+v"(l5)); const int col5 = 64 * wave + l5; asm volatile("" : "+v"(ws), "+v"(outb));
        if (wave < 2) {
            const int e = col5, ew = e >> 5, r = e & 31;
            bf16* gv = (bf16*)(ws + WS_GV) + row0 * 768 + hh * 128;
#pragma unroll
            for (int i4 = 0; i4 < 16; ++i4) { const int i = 4 * i4, cb = i >> 5, g = (i & 31) >> 3, h = (i >> 2) & 1;
                const int idx = ((((ew * 2 + cb) * 4 + g) * 64) + h * 32 + r) * 4;
                v2u w; w.x = pk2(x[i], x[i + 1]); w.y = pk2(x[i + 2], x[i + 3]);
                *(v2u*)(gv + (size_t)(idx >> 7) * 768 + (idx & 127)) = w; }
        } else {
            const int d = col5 - 128; bf16* nw = (bf16*)(outb + OUT_NW) + row0 * 768 + hh * 128 + ((d & ~15) | kperm16(d & 15));
#pragma unroll
            for (int i = 0; i < 64; ++i) nw[(size_t)i * 768] = (bf16)(cvtpk(-x[i], 0.f) & 0xffffu);
        }
    }
  }
}

__device__ __forceinline__ void gdn_scan_unit(const Params& P, unsigned char* lds, int tid_in, int b, int hh) {
    int tid = mk_tid(tid_in); asm volatile("" : "+v"(tid)); const int lane = tid & 63, wave = __builtin_amdgcn_readfirstlane(tid >> 6);
    unsigned char* ws = P.ws; unsigned char* outb = (unsigned char*)P.out;
    constexpr int BUFB = 57344, O_NW = 0, O_QD = 16384, O_KD = 32768, O_QK = 49152;
    LAS unsigned char* lds3 = (LAS unsigned char*)lds;
    const size_t rowb = (size_t)b * SEQ;
    const bf16* gNW = (const bf16*)(outb + OUT_NW) + rowb * 768 + hh * 128; const bf16* gQD = (const bf16*)(ws + WS_GQ) + rowb * 768 + hh * 128; const bf16* gKD = (const bf16*)(ws + WS_GK) + rowb * 768 + hh * 128;
    const bf16* gU = (const bf16*)(ws + WS_GV) + rowb * 768 + hh * 128; const bf16* gQK = (const bf16*)(outb + OUT_QKM) + ((size_t)(b * (SEQ / 64)) * 6 + hh) * 4096;
    const float* CD = (const float*)(ws + WS_MISC) + 64 + (size_t)(b * (SEQ / 64)) * 6 + hh;
    bf16* gZ = (bf16*)(ws + WS_GZ) + rowb * 768 + hh * 128;
    unsigned gsrc[4], gsrcq[2];
    const unsigned st_ = tid & 255;
#pragma unroll
    for (int i = 0; i < 4; ++i) { const unsigned p = i * 256 + st_, row = p >> 4, ch = (p & 15u) ^ (((row & 3u) << 2) | ((row >> 2) & 3u)); gsrc[i] = (row * 768 + ch * 8) * 2; }
#pragma unroll
    for (int i = 0; i < 2; ++i) { const unsigned p = i * 256 + st_, ir = p >> 4, c16 = (p & 15u) ^ (((ir & 3u) << 2) | ((ir >> 2) & 3u)); gsrcq[i] = ((2 * ir + (c16 >> 3)) * 64 + (c16 & 7) * 8) * 2; }
    const unsigned ldsw = (unsigned)(wave & 3) * 1024u;
#define GDN_DMA(bufoff, n_) do { const size_t go_ = (size_t)(n_) * 64 * 768 * 2; \
        _Pragma("unroll") for (int i_ = 0; i_ < 4; ++i_) { \
            __builtin_amdgcn_global_load_lds((const unsigned*)((const char*)gNW + go_ + gsrc[i_]), (LAS unsigned*)(lds3 + (bufoff) + O_NW + i_ * 4096 + ldsw), 16, 0, 2); \
            __builtin_amdgcn_global_load_lds((const unsigned*)((const char*)gQD + go_ + gsrc[i_]), (LAS unsigned*)(lds3 + (bufoff) + O_QD + i_ * 4096 + ldsw), 16, 0, 2); \
            __builtin_amdgcn_global_load_lds((const unsigned*)((const char*)gKD + go_ + gsrc[i_]), (LAS unsigned*)(lds3 + (bufoff) + O_KD + i_ * 4096 + ldsw), 16, 0, 2); } \
        _Pragma("unroll") for (int i_ = 0; i_ < 2; ++i_) \
            __builtin_amdgcn_global_load_lds((const unsigned*)((const char*)gQK + (size_t)(n_) * 6 * 4096 * 2 + gsrcq[i_]), (LAS unsigned*)(lds3 + (bufoff) + O_QK + i_ * 4096 + ldsw), 16, 0, 2); } while (0)
    const int r = lane & 31, h5 = lane >> 5;
    __syncthreads();
    if (wave < 4) GDN_DMA(0, 0);
    const float cdv0 = CD[(size_t)lane * 6], cdv1 = CD[(size_t)(64 + lane) * 6];
    f32x16 S[4];
#pragma unroll
    for (int db = 0; db < 4; ++db)
#pragma unroll
        for (int i = 0; i < 16; ++i) S[db][i] = 0.f;
    const int ew = wave & 3;
    bf16* Ob = (bf16*)(lds + 2 * BUFB);
    unsigned char* Ub = lds + 2 * BUFB + 16384;
    const int ht = tid & 255, hr = ht >> 2, c4 = ht & 3;
    const bf16* gUh = gU + (size_t)(ht >> 2) * 768 + (ht & 3) * 32;
    if (wave >= 4) {
#pragma unroll
        for (int i = 0; i < 4; ++i) *(v4u*)(Ub + ht * 64 + 16 * i) = __builtin_nontemporal_load((const v4u*)(gUh + 8 * i));
    }
    __syncthreads();
#define SYNC_B() asm volatile("s_waitcnt lgkmcnt(0)\n\ts_barrier" ::: "memory")
#define SYNC_A() asm volatile("s_waitcnt vmcnt(0) lgkmcnt(0)\n\ts_barrier" ::: "memory")
    if (wave < 4) {
#pragma unroll 1
        for (int n = 0; n <= SEQ / 64; ++n) {
            const int cur = n & 1; const bool more = n + 1 < SEQ / 64, act = n < SEQ / 64;
            unsigned char* cb_ = lds + cur * BUFB;
            if (more) { if (cur) GDN_DMA(0, n + 1); else GDN_DMA(BUFB, n + 1); }
            bf16x8 vb[2][2];
            if (act) {
                int l1 = lane; asm volatile("" : "+v"(l1)); unsigned kx[8]; mk_kx(l1, kx);
                f32x16 vn0, vn1;
#pragma unroll
                for (int g = 0; g < 4; ++g) { const v2u w0 = *(const v2u*)(Ub + (((ew * 8 + g) * 64) + lane) * 8), w1 = *(const v2u*)(Ub + (((ew * 8 + 4 + g) * 64) + lane) * 8);
                    vn0[4 * g] = bflo(w0.x); vn0[4 * g + 1] = bfhi(w0.x); vn0[4 * g + 2] = bflo(w0.y); vn0[4 * g + 3] = bfhi(w0.y);
                    vn1[4 * g] = bflo(w1.x); vn1[4 * g + 1] = bfhi(w1.x); vn1[4 * g + 2] = bflo(w1.y); vn1[4 * g + 3] = bfhi(w1.y); }
#pragma unroll
                for (int db = 0; db < 4; ++db)
#pragma unroll
                    for (int s = 0; s < 2; ++s) { const bf16x8 sb = pack8f(S[db], s);
                        vn0 = MFMA32(*(const bf16x8*)(cb_ + O_NW + kx[2 * db + s]), sb, vn0); vn1 = MFMA32(*(const bf16x8*)(cb_ + O_NW + 8192 + kx[2 * db + s]), sb, vn1); }
                vb[0][0] = pack8f(vn0, 0); vb[0][1] = pack8f(vn0, 1); vb[1][0] = pack8f(vn1, 0); vb[1][1] = pack8f(vn1, 1);
            }
            SYNC_B();
            if (act) {
                const float cd = __builtin_bit_cast(float, __builtin_amdgcn_readlane(__builtin_bit_cast(int, (n & 64) ? cdv1 : cdv0), n & 63));
                int l2 = lane; asm volatile("" : "+v"(l2)); unsigned kx[8], qkx[4]; mk_kx(l2, kx); mk_qkx(l2, qkx);
                f32x16 o0, o1;
#pragma unroll
                for (int i = 0; i < 16; ++i) { o0[i] = 0.f; o1[i] = 0.f; }
#pragma unroll
                for (int db = 0; db < 4; ++db)
#pragma unroll
                    for (int s = 0; s < 2; ++s) { const bf16x8 sb = pack8f(S[db], s);
                        o0 = MFMA32(*(const bf16x8*)(cb_ + O_QD + kx[2 * db + s]), sb, o0); o1 = MFMA32(*(const bf16x8*)(cb_ + O_QD + 8192 + kx[2 * db + s]), sb, o1); }
#pragma unroll
                for (int jb = 0; jb < 2; ++jb)
#pragma unroll
                    for (int s = 0; s < 2; ++s) { o0 = MFMA32(*(const bf16x8*)(cb_ + O_QK + qkx[2 * jb + s]), vb[jb][s], o0); o1 = MFMA32(*(const bf16x8*)(cb_ + O_QK + 4096 + qkx[2 * jb + s]), vb[jb][s], o1); }
#pragma unroll
                for (int i = 0; i < 16; ++i) { Ob[((i & 3) + 8 * (i >> 2) + 4 * h5) * 128 + 32 * ew + r] = (bf16)f2bf(o0[i]); Ob[(32 + (i & 3) + 8 * (i >> 2) + 4 * h5) * 128 + 32 * ew + r] = (bf16)f2bf(o1[i]); }
                int l3 = lane; asm volatile("" : "+v"(l3)); unsigned vaddr[2][4]; mk_vaddr(l3, vaddr); const unsigned cbase = (unsigned)(uintptr_t)cb_;
#pragma unroll
                for (int db = 0; db < 4; ++db) {
#pragma unroll
                    for (int i = 0; i < 16; ++i) S[db][i] *= cd;
                    s16x4 tl[4], th[4]; const unsigned a0 = cbase + vaddr[0][db], a1 = cbase + vaddr[1][db];
#define TRR(dst, addr, off) asm volatile("ds_read_b64_tr_b16 %0, %1 offset:%c2" : "=&v"(dst) : "v"(addr), "i"(off) : "memory")
                    TRR(tl[0], a0, O_KD); TRR(th[0], a1, O_KD); TRR(tl[1], a0, O_KD + 4096); TRR(th[1], a1, O_KD + 4096);
                    TRR(tl[2], a0, O_KD + 8192); TRR(th[2], a1, O_KD + 8192); TRR(tl[3], a0, O_KD + 12288); TRR(th[3], a1, O_KD + 12288);
#undef TRR
                    asm volatile("s_waitcnt lgkmcnt(0)" : "+v"(tl[0]), "+v"(th[0]), "+v"(tl[1]), "+v"(th[1]), "+v"(tl[2]), "+v"(th[2]), "+v"(tl[3]), "+v"(th[3]) :: "memory");
                    __builtin_amdgcn_sched_barrier(0);
#pragma unroll
                    for (int cs = 0; cs < 4; ++cs) { const bf16x8 kf = __builtin_shufflevector(tl[cs], th[cs], 0, 1, 2, 3, 4, 5, 6, 7); S[db] = MFMA32(kf, vb[cs >> 1][cs & 1], S[db]); } }
            }
            SYNC_A();
        }
    } else {
#define SYNC_AH() asm volatile("s_waitcnt lgkmcnt(0)\n\ts_barrier" ::: "memory")
        v4u un[4], zc[4];
        unsigned pfacc = 0u, pfp0 = 0u, pfp1 = 0u;
#pragma unroll
        for (int i = 0; i < 4; ++i) { un[i] = __builtin_nontemporal_load((const v4u*)(gUh + (size_t)64 * 768 + 8 * i)); zc[i] = (v4u){0u, 0u, 0u, 0u}; }
        const int li0 = ht, li1 = ht + 256;
        const char* pfa0 = (li0 < 128 ? (const char*)gNW : li0 < 256 ? (const char*)gQD : (const char*)gKD) + (size_t)((li0 & 127) >> 1) * 1536 + (li0 & 1) * 128;
        const char* pfa1 = (li1 < 384) ? (const char*)gKD + (size_t)((li1 & 127) >> 1) * 1536 + (li1 & 1) * 128 : (const char*)gQK + (size_t)(li1 - 384) * 128;
        const size_t pfs1 = (li1 < 384) ? (size_t)64 * 1536 : (size_t)6 * 8192;
#pragma unroll 1
        for (int n = 0; n <= SEQ / 64; ++n) {
            const bool more = n + 1 < SEQ / 64;
            v4u ovr[4], zn[4]; unsigned pf0 = 0u, pf1 = 0u;
            if (n > 0) {
                const bf16* op = Ob + hr * 128 + c4 * 32;
#pragma unroll
                for (int i = 0; i < 4; ++i) ovr[i] = *(const v4u*)(op + 8 * i);
            }
            if (n < SEQ / 64) { const bf16* zp = gZ + ((size_t)n * 64 + hr) * 768 + c4 * 32;
#pragma unroll
                for (int i = 0; i < 4; ++i) zn[i] = *(const v4u*)(zp + 8 * i); }
            if (n + 2 < SEQ / 64) { pf0 = *(const unsigned*)(pfa0 + (size_t)(n + 2) * 64 * 1536); if (li1 < 448) pf1 = *(const unsigned*)(pfa1 + (size_t)(n + 2) * pfs1); }
            SYNC_B();
            if (more) {
#pragma unroll
                for (int i = 0; i < 4; ++i) *(v4u*)(Ub + ht * 64 + 16 * i) = un[i];
                if (n + 2 < SEQ / 64) {
#pragma unroll
                    for (int i = 0; i < 4; ++i) un[i] = __builtin_nontemporal_load((const v4u*)(gUh + (size_t)(n + 2) * 64 * 768 + 8 * i)); }
            }
            if (n > 0) {
                float ov[32];
#pragma unroll
                for (int i = 0; i < 4; ++i) { const v4u t = ovr[i]; ov[8 * i] = bflo(t.x); ov[8 * i + 1] = bfhi(t.x); ov[8 * i + 2] = bflo(t.y); ov[8 * i + 3] = bfhi(t.y); ov[8 * i + 4] = bflo(t.z); ov[8 * i + 5] = bfhi(t.z); ov[8 * i + 6] = bflo(t.w); ov[8 * i + 7] = bfhi(t.w); }
                float ss = 0.f;
#pragma unroll
                for (int i = 0; i < 32; ++i) ss += ov[i] * ov[i];
                ss += __shfl_xor(ss, 1); ss += __shfl_xor(ss, 2);
                const float sc = 1.0f / sqrtf(ss * (1.0f / 128.0f) + EPS); const float* gn = (const float*)P.in[I_GDNN] + c4 * 32;
                bf16* zp = gZ + ((size_t)(n - 1) * 64 + hr) * 768 + c4 * 32;
#pragma unroll
                for (int i = 0; i < 4; ++i) { const v4u z = zc[i]; const float zz[8] = { bflo(z.x), bfhi(z.x), bflo(z.y), bfhi(z.y), bflo(z.z), bfhi(z.z), bflo(z.w), bfhi(z.w) };
                    float y[8];
#pragma unroll
                    for (int k = 0; k < 8; ++k) y[k] = ov[8 * i + k] * sc * gn[8 * i + k] * siluf(zz[k]);
                    v4u w; w.x = pk2(y[0], y[1]); w.y = pk2(y[2], y[3]); w.z = pk2(y[4], y[5]); w.w = pk2(y[6], y[7]); *(v4u*)(zp + 8 * i) = w; }
            }
#pragma unroll
            for (int i = 0; i < 4; ++i) zc[i] = zn[i];
            pfacc ^= pfp0 ^ pfp1; pfp0 = pf0; pfp1 = pf1;
            SYNC_AH();
        }
        if ((pfacc ^ pfp0 ^ pfp1) == 0x9e3779b9u && hr == 777) gZ[0] = 0;
#undef SYNC_AH
    }
#undef SYNC_A
#undef SYNC_B
#undef GDN_DMA
}


constexpr size_t WS_BAR = WS_MISC + 16384;
#define XB_TMO      128
#define XB_XCNT(j)  (256  + 64 * (j))
#define XB_XSUB(j)  (1280 + 64 * (j))
#define XB_XGEN(j)  (2304 + 64 * (j))
#define XB_TOP      3328
#define XB_TOPGEN   3392
#define XB_QUEUE    3456
#define XCD_BAR_WORDS 3968
#define XB_SPIN_CAP (1u << 20)
__device__ __forceinline__ unsigned xb_ld(unsigned* p)              { return __hip_atomic_load(p, __ATOMIC_RELAXED, __HIP_MEMORY_SCOPE_AGENT); }
__device__ __forceinline__ unsigned xb_add(unsigned* p, unsigned v) { return __hip_atomic_fetch_add(p, v, __ATOMIC_RELAXED, __HIP_MEMORY_SCOPE_AGENT); }
__device__ __forceinline__ unsigned xb_xcc_id() { return (unsigned)__builtin_amdgcn_s_getreg((3 << 11) | 20) & 0xFu; }
#define XB_SPIN(cond, bar) do { unsigned _sp = 0; while (cond) { __builtin_amdgcn_s_sleep(1); \
    if ((++_sp & 255u) == 0u) { if (xb_ld(&(bar)[XB_TMO])) break; if (_sp > XB_SPIN_CAP) { atomicAdd(&(bar)[XB_TMO], 1u); break; } } } } while (0)
__device__ __forceinline__ void xcd_barrier_census(unsigned* bar, unsigned x, unsigned G, unsigned& nloc, unsigned& nx) {
    unsigned sum, cnt, mine, sp = 0u;
    for (;;) {
        sum = 0u; cnt = 0u; mine = 0u;
#pragma unroll
        for (unsigned j = 0; j < 16; ++j) { const unsigned c = xb_ld(&bar[XB_XCNT(j)]); sum += c; cnt += (c > 0u) ? 1u : 0u; mine = (j == x) ? c : mine; }
        if (sum == G) break;
        __builtin_amdgcn_s_sleep(1);
        if ((++sp & 255u) == 0u) { if (xb_ld(&bar[XB_TMO])) break; if (sp > XB_SPIN_CAP) { atomicAdd(&bar[XB_TMO], 1u); break; } }
    }
    nloc = mine > 0u ? mine : 1u; nx = cnt > 0u ? cnt : 1u;
}
__device__ __forceinline__ void xcd_barrier(unsigned* bar, unsigned x, int tid) {
    asm volatile("s_waitcnt vmcnt(0)" ::: "memory");
    __syncthreads();
    if (tid == 0) {
        __builtin_amdgcn_s_waitcnt(0);
        unsigned nloc, nx; xcd_barrier_census(bar, x, gridDim.x, nloc, nx);
        const unsigned old = xb_add(&bar[XB_XSUB(x)], 1u);
        const unsigned gen = old / nloc;
        if (old + 1u == (gen + 1u) * nloc) {
            __builtin_amdgcn_fence(__ATOMIC_RELEASE, "agent");
            asm volatile("s_waitcnt vmcnt(0)" ::: "memory");
            const unsigned og = xb_add(&bar[XB_TOP], 1u);
            const unsigned tg = og / nx;
            if (og + 1u == (tg + 1u) * nx) xb_add(&bar[XB_TOPGEN], 1u);
            else XB_SPIN(xb_ld(&bar[XB_TOPGEN]) == tg, bar);
            __builtin_amdgcn_fence(__ATOMIC_ACQUIRE, "agent");
            xb_add(&bar[XB_XGEN(x)], 1u);
            asm volatile("s_waitcnt vmcnt(0)" ::: "memory");
        } else {
            XB_SPIN(xb_ld(&bar[XB_XGEN(x)]) == gen, bar);
            __builtin_amdgcn_fence(__ATOMIC_ACQUIRE, "agent");
            asm volatile("s_waitcnt vmcnt(0)" ::: "memory");
        }
    }
    __syncthreads();
}

constexpr int NPHASE = 8;
__global__ void __launch_bounds__(NTHR, 2) mega_fwd(Params P_by_value) {
    (void)P_by_value;
    extern __shared__ __attribute__((aligned(16))) unsigned char lds[];
    cg::grid_group grid = cg::this_grid();
    const Params* Pk = (const Params*)__builtin_amdgcn_kernarg_segment_ptr();
#define PHASE_P() const Params* Pp_ = Pk; asm volatile("" : "+s"(Pp_)); const Params& P = *Pp_
    const int G = gridDim.x;
    const int wave_s = __builtin_amdgcn_readfirstlane((int)threadIdx.x >> 6);
    unsigned char* ws = Pk->ws; unsigned char* outb = (unsigned char*)Pk->out;
    PG8_LAS unsigned char* lds3 = (PG8_LAS unsigned char*)lds;
    const int lo = Pk->lo, hi = Pk->hi;
#define IN(k) (lo <= (k) && (k) < hi)
#ifdef PROBE_A
#define STAMP(k) do { if (blockIdx.x == 0 && threadIdx.x == 0) ((unsigned long long*)(ws + WS_MISC + 32768))[k] = __builtin_amdgcn_s_memrealtime(); } while (0)
#else
#define STAMP(k) do { } while (0)
#endif
#define SEAM(k) do { if (IN(k) && IN((k) + 1)) { xcd_barrier(xbar, xcc, mk_tid(wave_s)); } STAMP((k) + 1); } while (0)

#define LAUNDER() int tid = mk_tid(wave_s); asm volatile("" : "+v"(tid)); const int lane = tid & 63, wave = __builtin_amdgcn_readfirstlane(tid >> 6); (void)lane; (void)wave
    unsigned* xbar = (unsigned*)(ws + WS_BAR); const unsigned xcc = xb_xcc_id();
    if (hi - lo > 1) {
        if (blockIdx.x == 0) { for (int i = (int)threadIdx.x; i < XCD_BAR_WORDS; i += NTHR) __hip_atomic_store(&xbar[i], 0u, __ATOMIC_RELAXED, __HIP_MEMORY_SCOPE_AGENT); }
        grid.sync();
        if (threadIdx.x == 0) (void)xb_add(&xbar[XB_XCNT(xcc)], 1u); }
    STAMP(0);
    if (IN(0)) { PHASE_P(); LAUNDER(); p0_prologue(P, lds, tid, lane, wave); __syncthreads(); }
    SEAM(0);
    if (IN(1)) { PHASE_P();
        { pg8::Gemm g{(const pg8::bf16_t*)(outb + OUT_HB), (const pg8::bf16_t*)(ws + WS_W1T), MTOK, NCOMB, DM}; pg8::StaticOrder S; S.init(MTOK, NCOMB, G, (int)blockIdx.x); S.wgm = 4;
          pg8::EpiP1 E{ws, outb, (const float*)P.in[I_BGATE], (const float*)P.in[I_DAQN], (const float*)P.in[I_DAKN]};
          pg8::gemm_phase<pg8::EpiP1, pg8::StaticOrder, true, true>(lds3, g, S, E, wave_s); }
        { pg8::Gemm g{(const pg8::bf16_t*)(ws + WS_MN), (const pg8::bf16_t*)(ws + WS_WMEM), MEMROWS, 1024, DM}; pg8::StaticOrder S; S.init(MEMROWS, 1024, G, ((int)blockIdx.x + G / 2) % G);
          pg8::EpiPlain E{(pg8::bf16_t*)(ws + WS_MKV), 1024};
          pg8::gemm_phase<pg8::EpiPlain, pg8::StaticOrder, true, true>(lds3, g, S, E, wave_s); }
        {
            const int lo = (G >= 64) ? G / 2 + 16 : 0;
            if ((int)blockIdx.x >= lo) { LAUNDER(); __syncthreads(); p0_items<false>(P, lds, lane, wave, ((int)blockIdx.x - lo) * NWAVES + wave, (G - lo) * NWAVES); } }
    }
    SEAM(1);
    if (IN(2)) { PHASE_P();
        { LAUNDER(); p2a_qknorm_rope(P, lane, wave); }
        { const int NU = NB * 6 * (SEQ / 64), per = (NU + G - 1) / G; const int ub = (int)blockIdx.x * per; gdn_intra_block(P, lds, wave_s, ub, ub + per < NU ? ub + per : NU); }
        STAMP(9);
    }
    SEAM(2);
    if (IN(3)) { PHASE_P();
        LAUNDER();
        if ((int)blockIdx.x < 24) gdn_scan_unit(P, lds, wave_s, (int)blockIdx.x / 6, (int)blockIdx.x % 6);
        STAMP(10);
        unsigned* qx = xbar + XB_QUEUE; const int myx = (int)(xcc & 7u);
        int qi = 0;
        for (;;) {
            __syncthreads();
            if (tid == 0) { int u = -1, q = qi;
                while (q < 8) { const int x = (myx + q) & 7; const int t = (int)xb_add(&qx[64 * x], 1u); if (t < 256) { u = x * 256 + t; break; } ++q; }
                *(volatile int*)(lds + LDS_BYTES - 16) = u; *(volatile int*)(lds + LDS_BYTES - 12) = q; }
            __syncthreads();
            const int u = *(volatile int*)(lds + LDS_BYTES - 16); qi = *(volatile int*)(lds + LDS_BYTES - 12);
            if (u < 0) break;
            const int x = u >> 8, t = u & 255;
            if (t < 192) { const int bh = 3 * x + (t >> 6), qb = 63 - (t & 63); attn_pipe_unit(P, lds, wave_s, bh / 6, bh % 6, qb); }
            else { const int v = x * 64 + (t - 192), qb = v & 31, bh = v >> 5; attn_mfma_unit<true>(P, lds, wave_s, bh >> 2, bh & 3, qb); }
        }
        __syncthreads();
    }
    SEAM(3);
    if (IN(4)) { PHASE_P();
        pg8::ChainOrder S; S.init(MTOK, DM, G, (int)blockIdx.x);
        pg8::Gemm g{(const pg8::bf16_t*)(ws + WS_DAQ), (const pg8::bf16_t*)(ws + WS_WOD), MTOK, DM, 768};
        pg8::EpiChain E{(const pg8::bf16_t*)(ws + WS_DAQ), (const pg8::bf16_t*)(ws + WS_GZ), (const pg8::bf16_t*)(outb + OUT_CAQ),
                        (const pg8::bf16_t*)(ws + WS_WOD), (const pg8::bf16_t*)(ws + WS_WODL), (const pg8::bf16_t*)(ws + WS_WOC), 768, 768, 512,
                        ws + WS_GATES, (pg8::bf16_t*)(ws + WS_MIXED)};
        pg8::gemm_phase<pg8::EpiChain, pg8::ChainOrder, true, true>(lds3, g, S, E, wave_s);
    }
    SEAM(4);
    if (IN(5)) { PHASE_P();
        pg8::Gemm g{(const pg8::bf16_t*)(ws + WS_MIXED), (const pg8::bf16_t*)(ws + WS_WOUT), MTOK, DM, DM}; pg8::StaticOrder S; S.init(MTOK, DM, G, (int)blockIdx.x);
        pg8::EpiRes1 E{(const float*)P.in[I_X], P.out, (pg8::bf16_t*)(ws + WS_X1B), (float*)(ws + WS_ROWSS)};
        pg8::gemm_phase<pg8::EpiRes1, pg8::StaticOrder, true, true>(lds3, g, S, E, wave_s);
    }
    SEAM(5);
    if (IN(6)) { PHASE_P();
        pg8::Gemm g{(const pg8::bf16_t*)(ws + WS_X1B), (const pg8::bf16_t*)(ws + WS_WM1), MTOK, DFF, DM}; pg8::StaticOrder S; S.init(MTOK, DFF, G, (int)blockIdx.x); S.wgm = 4;
        pg8::EpiMlp1 E{(pg8::bf16_t*)(ws + WS_HMID)};
        pg8::gemm_phase<pg8::EpiMlp1, pg8::StaticOrder, true, true>(lds3, g, S, E, wave_s);
    }
    SEAM(6);
    if (IN(7)) { PHASE_P();
        pg8::Gemm g{(const pg8::bf16_t*)(ws + WS_HMID), (const pg8::bf16_t*)(ws + WS_WM2), MTOK, DM, DFF, 1}; pg8::StaticOrder S; S.init(MTOK, DM, G, (int)blockIdx.x); S.rev = true;
        pg8::EpiRes2 E{(const pg8::bf16_t*)(ws + WS_X1B), (const float*)(ws + WS_ROWSS), P.out};
        pg8::gemm_phase<pg8::EpiRes2, pg8::StaticOrder, true, true>(lds3, g, S, E, wave_s);
    }
#ifdef PROBE_A
    xcd_barrier(xbar, xcc, mk_tid(wave_s)); STAMP(8); __syncthreads();
    if (blockIdx.x == 0 && threadIdx.x == 0) { const unsigned long long* ts = (const unsigned long long*)(ws + WS_MISC + 32768);
        Pk->out[0] += (float)(ts[PROBE_A2] - ts[PROBE_A]) * 0.0001f; }
#endif
#undef IN
#undef SEAM
}

#ifndef MK_SPLIT
#define MK_SPLIT 0
#endif
extern "C" void kernel_launch(void* const* d_in, const int* in_sizes, int n_in, void* d_out, int out_size, void* d_ws, size_t ws_size, hipStream_t stream) {
    static int grid = 0;
    if (grid == 0) {
        if (n_in != 29 || in_sizes[0] != MTOK * DM || out_size != MTOK * DM || ws_size < WS_NEED) {
            fprintf(stderr, "kernel_launch: unexpected problem: n_in %d in0 %d out %d ws %zu (need %zu)\n", n_in, n_in > 0 ? in_sizes[0] : -1, out_size, ws_size, (size_t)WS_NEED); grid = -1; return; }
        int dev = 0, cus = 0, per_cu = 0;
        hipGetDevice(&dev); hipDeviceGetAttribute(&cus, hipDeviceAttributeMultiprocessorCount, dev);
        if (hipFuncSetAttribute((const void*)mega_fwd, hipFuncAttributeMaxDynamicSharedMemorySize, LDS_BYTES) != hipSuccess) { fprintf(stderr, "kernel_launch: hipFuncSetAttribute failed\n"); grid = -1; return; }
        if (hipOccupancyMaxActiveBlocksPerMultiprocessor(&per_cu, (const void*)mega_fwd, NTHR, LDS_BYTES) != hipSuccess || per_cu < 1) { fprintf(stderr, "kernel_launch: occupancy query says %d\n", per_cu); per_cu = 1; }
        (void)hipGetLastError();
        grid = cus * 1;
        fprintf(stderr, "kernel_launch: cus %d per_cu %d grid %d ws %zu\n", cus, per_cu, grid, ws_size);
    }
    if (grid < 0) return;
    Params p{};
    for (int i = 0; i < 29; ++i) p.in[i] = d_in[i];
    p.out = (float*)d_out; p.ws = (unsigned char*)d_ws;
#if MK_SPLIT
    for (int ph = 0; ph < NPHASE; ++ph) { p.lo = ph; p.hi = ph + 1; hipLaunchKernelGGL(mega_fwd, dim3(grid), dim3(NTHR), LDS_BYTES, stream, p); }
#else
    p.lo = 0; p.hi = NPHASE;
    void* args[] = { &p };
    hipError_t e = hipLaunchCooperativeKernel((const void*)mega_fwd, dim3(grid), dim3(NTHR), args, LDS_BYTES, stream);
    if (e != hipSuccess) fprintf(stderr, "kernel_launch: cooperative launch failed: %s (grid %d)\n", hipGetErrorString(e), grid);
#endif
}
```
